# Optimizing an MI355X kernel written in HIP

```python
import jax
import jax.numpy as jnp
from jax import lax
import numpy as np

D_MODEL = 4096
BATCH = 4
SEQ = 2048
DEPTH = 2

SWA_HEADS = 16
SWA_KV_HEADS = 2
SWA_HEAD_DIM = 64
SWA_WINDOW = 128
SWA_BLOCK = 128
MLSTM_HEADS = 8
MLSTM_QK_DIM = 64
MLSTM_V_DIM = 128
MLSTM_CHUNK = 64
FOX_HEADS = 8
FOX_HEAD_DIM = 128
FOX_BLOCK = 128
D_FF = 4 * D_MODEL
LN_EPS = 1e-5
DN_ALPHA = (2 * DEPTH) ** 0.25
DN_BETA = (8 * DEPTH) ** -0.25

A_Q = SWA_HEADS * SWA_HEAD_DIM
A_KV = SWA_KV_HEADS * SWA_HEAD_DIM
B_QK = MLSTM_HEADS * MLSTM_QK_DIM
B_V = MLSTM_HEADS * MLSTM_V_DIM
C_W = FOX_HEADS * FOX_HEAD_DIM
SEG_WIDTHS = (A_Q, A_KV, A_KV,
              B_QK, B_QK, B_V, MLSTM_HEADS, MLSTM_HEADS, B_V,
              C_W, C_W, C_W, FOX_HEADS,
              D_MODEL, D_MODEL, D_MODEL)
VALUE_SEGS = (2, 5, 11)
D_IN = sum(SEG_WIDTHS)

kernel_name = 'hybrid_swa_mlstm_fox_deepnorm'


def split_columns(z):
    parts, off = [], 0
    for w in SEG_WIDTHS:
        parts.append(z[..., off:off + w])
        off += w
    return parts


def layer_norm(x, g, b):
    xf = x.astype(jnp.float32)
    mu = jnp.mean(xf, axis=-1, keepdims=True)
    var = jnp.mean(jnp.square(xf - mu), axis=-1, keepdims=True)
    y = (xf - mu) * lax.rsqrt(var + LN_EPS) * g.astype(jnp.float32) + b.astype(jnp.float32)
    return y.astype(x.dtype)


def alibi_slopes(n_heads):
    return 2.0 ** (-8.0 * jnp.arange(1, n_heads + 1, dtype=jnp.float32) / n_heads)


def swa_sink_attention(q, k, v, sinks):
    bsz, seq, _, dh = q.shape
    blk = SWA_BLOCK
    nb = seq // blk
    grp = SWA_HEADS // SWA_KV_HEADS
    f32 = jnp.float32
    qb = q.reshape(bsz, nb, blk, SWA_KV_HEADS, grp, dh)
    pad = jnp.zeros((bsz, blk, SWA_KV_HEADS, dh), k.dtype)
    kp = jnp.concatenate([pad, k], axis=1).reshape(bsz, nb + 1, blk, SWA_KV_HEADS, dh)
    vp = jnp.concatenate([pad.astype(v.dtype), v], axis=1).reshape(bsz, nb + 1, blk, SWA_KV_HEADS, dh)
    kb = jnp.concatenate([kp[:, :-1], kp[:, 1:]], axis=2)
    vb = jnp.concatenate([vp[:, :-1], vp[:, 1:]], axis=2)
    s = jnp.einsum('bnqhgd,bnkhd->bnhgqk', qb, kb, preferred_element_type=f32) * (dh ** -0.5)
    q_pos = jnp.arange(nb)[:, None] * blk + jnp.arange(blk)[None, :]
    k_pos = jnp.arange(nb)[:, None] * blk - blk + jnp.arange(2 * blk)[None, :]
    dist = q_pos[:, :, None] - k_pos[:, None, :]
    valid = (dist >= 0) & (dist < SWA_WINDOW) & (k_pos[:, None, :] >= 0)
    slopes = alibi_slopes(SWA_HEADS).reshape(SWA_KV_HEADS, grp)
    s = s - slopes[None, None, :, :, None, None] * dist.astype(f32)[None, :, None, None, :, :]
    s = jnp.where(valid[None, :, None, None, :, :], s, -jnp.inf)
    sink = sinks.astype(f32).reshape(SWA_KV_HEADS, grp)[None, None, :, :, None, None]
    m = jnp.maximum(jnp.max(s, axis=-1, keepdims=True), sink)
    p = jnp.exp(s - m)
    p = p / (jnp.sum(p, axis=-1, keepdims=True) + jnp.exp(sink - m))
    o = jnp.einsum('bnhgqk,bnkhd->bnqhgd', p.astype(v.dtype), vb)
    return o.reshape(bsz, seq, SWA_HEADS * dh)


def mlstm_chunkwise(q, k, v, i_pre, f_pre):
    bsz, seq, nh, dk = q.shape
    dv = v.shape[-1]
    L = MLSTM_CHUNK
    nc = seq // L
    f32 = jnp.float32

    def chunks(t):
        t = t.astype(f32).reshape((bsz, nc, L, nh) + t.shape[3:])
        return jnp.moveaxis(t, (1, 3), (0, 2))

    qc = chunks(q)
    kc = chunks(k) * (dk ** -0.5)
    vc = chunks(v)
    ic = chunks(i_pre)
    lfc = chunks(jax.nn.log_sigmoid(f_pre.astype(f32)))
    causal = jnp.tril(jnp.ones((L, L), dtype=bool))

    def step(carry, inp):
        C, n, m = carry
        qq, kk, vv, ig, lf = inp
        b = jnp.cumsum(lf, axis=-1)
        D = b[..., :, None] - b[..., None, :] + ig[..., None, :]
        D = jnp.where(causal, D, -jnp.inf)
        inter = b + m[..., None]
        m_t = jnp.maximum(inter, jnp.max(D, axis=-1))
        w_inter = jnp.exp(inter - m_t)
        S = jnp.einsum('bhtd,bhsd->bhts', qq, kk) * jnp.exp(D - m_t[..., None])
        num = w_inter[..., None] * jnp.einsum('bhtd,bhde->bhte', qq, C) + jnp.einsum('bhts,bhse->bhte', S, vv)
        den = w_inter * jnp.einsum('bhtd,bhd->bht', qq, n) + jnp.sum(S, axis=-1)
        h = num / jnp.maximum(jnp.abs(den), jnp.exp(-m_t))[..., None]
        m_new = m_t[..., -1]
        decay = jnp.exp(b[..., -1] + m - m_new)
        wk = jnp.exp(b[..., -1:] - b + ig - m_new[..., None])
        kw = kk * wk[..., None]
        C_new = decay[..., None, None] * C + jnp.einsum('bhsd,bhse->bhde', kw, vv)
        n_new = decay[..., None] * n + jnp.sum(kw, axis=2)
        return (C_new, n_new, m_new), h

    init = (jnp.zeros((bsz, nh, dk, dv), f32), jnp.zeros((bsz, nh, dk), f32), jnp.zeros((bsz, nh), f32))
    _, h = lax.scan(step, init, (qc, kc, vc, ic, lfc))
    return jnp.moveaxis(h, (0, 2), (1, 3)).reshape(bsz, seq, nh * dv)


def forgetting_attention(q, k, v, f_pre):
    bsz, seq, nh, dh = q.shape
    blk = FOX_BLOCK
    nb = seq // blk
    f32 = jnp.float32
    cum = jnp.cumsum(jax.nn.log_sigmoid(f_pre.astype(f32)), axis=1)
    cum_k = jnp.transpose(cum, (0, 2, 1))
    kh = jnp.transpose(k, (0, 2, 1, 3))
    vh = jnp.transpose(v, (0, 2, 1, 3))
    qb = jnp.transpose(q.reshape(bsz, nb, blk, nh, dh), (1, 0, 3, 2, 4))
    cq = jnp.transpose(cum.reshape(bsz, nb, blk, nh), (1, 0, 3, 2))
    k_pos = jnp.arange(seq)

    def block(args):
        qi, ci, idx = args
        q_pos = idx * blk + jnp.arange(blk)
        s = jnp.einsum('bhqd,bhkd->bhqk', qi, kh, preferred_element_type=f32) * (dh ** -0.5)
        s = s + ci[..., :, None] - cum_k[..., None, :]
        s = jnp.where(k_pos[None, :] <= q_pos[:, None], s, -jnp.inf)
        p = jax.nn.softmax(s, axis=-1)
        return jnp.einsum('bhqk,bhkd->bhqd', p.astype(v.dtype), vh)

    o = lax.map(block, (qb, cq, jnp.arange(nb)))
    return jnp.transpose(o, (1, 0, 3, 2, 4)).reshape(bsz, seq, nh * dh)


def setup_inputs(seed: int = 0) -> dict:
    key = jax.random.key(seed)
    ks = jax.random.split(key, 16)
    f32 = jnp.float32
    nrm = jax.random.normal
    x = nrm(ks[0], (BATCH, SEQ, D_MODEL), f32)
    col_scale = jnp.concatenate([jnp.full((w,), DN_BETA if i in VALUE_SEGS else 1.0, f32)
                                 for i, w in enumerate(SEG_WIDTHS)])
    w_in = nrm(ks[1], (DEPTH, D_MODEL, D_IN), f32) * (D_MODEL ** -0.5) * col_scale
    b_mlstm_i = 0.1 * nrm(ks[2], (DEPTH, MLSTM_HEADS), f32)
    b_mlstm_f = 3.0 + 0.5 * nrm(ks[3], (DEPTH, MLSTM_HEADS), f32)
    b_fox_f = 3.0 + 0.5 * nrm(ks[4], (DEPTH, FOX_HEADS), f32)
    attn_sinks = 0.5 * nrm(ks[5], (DEPTH, SWA_HEADS), f32)
    w_up_swa = nrm(ks[6], (DEPTH, A_Q, D_MODEL), f32) * (A_Q ** -0.5) * DN_BETA
    w_up_mlstm = nrm(ks[7], (DEPTH, B_V, D_MODEL), f32) * (B_V ** -0.5) * DN_BETA
    w_up_fox = nrm(ks[8], (DEPTH, C_W, D_MODEL), f32) * (C_W ** -0.5) * DN_BETA
    w_o = nrm(ks[9], (DEPTH, D_MODEL, D_MODEL), f32) * (D_MODEL ** -0.5) * DN_BETA
    ln1_g = 1.0 + 0.02 * nrm(ks[10], (DEPTH, D_MODEL), f32)
    ln1_b = 0.02 * nrm(ks[11], (DEPTH, D_MODEL), f32)
    w_ff1 = nrm(ks[12], (DEPTH, D_MODEL, D_FF), f32) * (D_MODEL ** -0.5)
    w_ff2 = nrm(ks[13], (DEPTH, D_FF, D_MODEL), f32) * (D_FF ** -0.5) * DN_BETA
    ln2_g = 1.0 + 0.02 * nrm(ks[14], (DEPTH, D_MODEL), f32)
    ln2_b = 0.02 * nrm(ks[15], (DEPTH, D_MODEL), f32)
    return {'x': x, 'w_in': w_in, 'b_mlstm_i': b_mlstm_i, 'b_mlstm_f': b_mlstm_f,
            'b_fox_f': b_fox_f, 'attn_sinks': attn_sinks, 'w_up_swa': w_up_swa,
            'w_up_mlstm': w_up_mlstm, 'w_up_fox': w_up_fox, 'w_o': w_o,
            'ln1_g': ln1_g, 'ln1_b': ln1_b, 'w_ff1': w_ff1, 'w_ff2': w_ff2,
            'ln2_g': ln2_g, 'ln2_b': ln2_b}


def reference(x, w_in, b_mlstm_i, b_mlstm_f, b_fox_f, attn_sinks, w_up_swa, w_up_mlstm,
              w_up_fox, w_o, ln1_g, ln1_b, w_ff1, w_ff2, ln2_g, ln2_b):
    bsz, seq, _ = x.shape
    f32 = jnp.float32
    for l in range(DEPTH):
        z = x @ w_in[l]
        (a_q, a_k, a_v, m_q, m_k, m_v, m_i, m_f, m_o,
         c_q, c_k, c_v, c_f, g_a, g_b, g_c) = split_columns(z)
        y_a = swa_sink_attention(a_q.reshape(bsz, seq, SWA_HEADS, SWA_HEAD_DIM),
                                 a_k.reshape(bsz, seq, SWA_KV_HEADS, SWA_HEAD_DIM),
                                 a_v.reshape(bsz, seq, SWA_KV_HEADS, SWA_HEAD_DIM),
                                 attn_sinks[l])
        h_b = mlstm_chunkwise(m_q.reshape(bsz, seq, MLSTM_HEADS, MLSTM_QK_DIM),
                              m_k.reshape(bsz, seq, MLSTM_HEADS, MLSTM_QK_DIM),
                              m_v.reshape(bsz, seq, MLSTM_HEADS, MLSTM_V_DIM),
                              m_i + b_mlstm_i[l], m_f + b_mlstm_f[l])
        y_b = (jax.nn.sigmoid(m_o.astype(f32)) * h_b).astype(x.dtype)
        y_c = forgetting_attention(c_q.reshape(bsz, seq, FOX_HEADS, FOX_HEAD_DIM),
                                   c_k.reshape(bsz, seq, FOX_HEADS, FOX_HEAD_DIM),
                                   c_v.reshape(bsz, seq, FOX_HEADS, FOX_HEAD_DIM),
                                   c_f + b_fox_f[l])
        mix = (jax.nn.sigmoid(g_a) * (y_a @ w_up_swa[l])
               + jax.nn.sigmoid(g_b) * (y_b @ w_up_mlstm[l])
               + jax.nn.sigmoid(g_c) * (y_c @ w_up_fox[l]))
        x = layer_norm(DN_ALPHA * x + mix @ w_o[l], ln1_g[l], ln1_b[l])
        hid = jnp.square(jax.nn.relu(x @ w_ff1[l]))
        x = layer_norm(DN_ALPHA * x + hid @ w_ff2[l], ln2_g[l], ln2_b[l])
    return x
```

```cpp
#include <hip/hip_runtime.h>
#include <cstdio>
#include <cstdint>

#define OPQ_V(x) asm volatile("" : "+v"(x))
#define OPQ_S(x) asm volatile("" : "+s"(x))
__device__ __forceinline__ int lane_id() { unsigned z = 0u; asm volatile("" : "+v"(z)); return (int)__builtin_amdgcn_mbcnt_hi(~0u, __builtin_amdgcn_mbcnt_lo(~0u, z)); }
__device__ __forceinline__ int pk4_e4m3(float a, float b, float c, float d) {
    a = __builtin_amdgcn_fmed3f(a, -448.f, 448.f); b = __builtin_amdgcn_fmed3f(b, -448.f, 448.f); c = __builtin_amdgcn_fmed3f(c, -448.f, 448.f); d = __builtin_amdgcn_fmed3f(d, -448.f, 448.f);
    int p = __builtin_amdgcn_cvt_pk_fp8_f32(a, b, 0, false); return __builtin_amdgcn_cvt_pk_fp8_f32(c, d, p, true);
}
__device__ __forceinline__ unsigned q_e2m3(float x) {
    const float a = fminf(fabsf(x), 7.5f); const float s = a < 2.f ? 8.f : (a < 4.f ? 4.f : 2.f); const unsigned o = a < 2.f ? 0u : (a < 4.f ? 8u : 16u);
    return ((unsigned)(int)__builtin_rintf(a * s) + o) | (x < 0.f ? 32u : 0u);
}
__device__ __forceinline__ float v_e2m3(float x) {
    const float a = fminf(fabsf(x), 7.5f); const float s = a < 2.f ? 8.f : (a < 4.f ? 4.f : 2.f), si = a < 2.f ? 0.125f : (a < 4.f ? 0.25f : 0.5f);
    return __builtin_copysignf(__builtin_rintf(a * s) * si, x);
}
typedef unsigned pk6x4_t __attribute__((ext_vector_type(4)));
__device__ __forceinline__ pk6x4_t pack16_e2m3(const unsigned (&c)[16]) {
    pk6x4_t d;
    d.x = c[0] | (c[1] << 6) | (c[2] << 12) | (c[3] << 18) | (c[4] << 24) | (c[5] << 30);
    d.y = (c[5] >> 2) | (c[6] << 4) | (c[7] << 10) | (c[8] << 16) | (c[9] << 22) | (c[10] << 28);
    d.z = (c[10] >> 4) | (c[11] << 2) | (c[12] << 8) | (c[13] << 14) | (c[14] << 20) | (c[15] << 26);
    d.w = 0u; return d;
}
__device__ __forceinline__ unsigned char* e2m3_ktile(unsigned char* img, int row, int kt, bool perm) {
    int rin = row & 255; if (perm) { const int w = rin & 31; rin = (rin & ~31) + 16 * ((w >> 2) & 1) + 4 * (w >> 3) + (w & 3); }
    return img + ((size_t)((row >> 8) * 32 + kt) * 256 + rin) * 96;
}
__device__ __forceinline__ void store_e2m3_group(unsigned char* ktile, int c16, pk6x4_t d) { unsigned* p = (unsigned*)(ktile + 12 * c16); p[0] = d.x; p[1] = d.y; p[2] = d.z; }
#ifndef MK_N_LAUNCHES
#define MK_N_LAUNCHES 1
#endif

namespace pg8 {
#define PG8_LAS __attribute__((address_space(3)))
typedef unsigned short bf16_t;
typedef short bf16x8 __attribute__((ext_vector_type(8)));
typedef float f32x4 __attribute__((ext_vector_type(4)));
typedef unsigned u32x4 __attribute__((ext_vector_type(4)));
constexpr int BM = 256, BK = 64, HALF = 128, HTB = HALF * BK * 2, STAGE_BYTES = 8 * HTB, NXCD = 8, WGM = 8;

__host__ __device__ __forceinline__ int lds_byte(int r, int c) { const int st = (r >> 4) * 2 + (c >> 5), rr = r & 15, cc = c & 31, ob = rr * 64 + cc * 2; return st * 1024 + (ob ^ (((ob >> 9) & 1) << 5)); }
__host__ __device__ __forceinline__ void stage_rc(int b, int& R, int& C) { const int st = b / 1024, sb = b % 1024, swz = sb ^ (((sb >> 9) & 1) << 5); R = (st >> 1) * 16 + swz / 64; C = (st & 1) * 32 + (swz % 64) / 2; }
__host__ __device__ __forceinline__ int perm32(int rho) { const int n = rho >> 4, i = rho & 15; return 8 * (i >> 2) + 4 * n + (i & 3); }

struct Unit { int pm, pn; };
struct Gemm { const bf16_t* A; const bf16_t* Bt; int M, N, K; };

struct StaticOrder {
    int nM, nN, nwg, G, c;
    __host__ __device__ void init(int M, int N, int G_, int c_) { nM = M / BM; nN = N / BM; nwg = nM * nN; G = G_; c = c_; }
    __host__ __device__ bool next(int i, Unit& u) const {
        const long L = (long)i * G + c; if (L >= nwg) return false;
        int wgid = (int)L; { const int q = nwg / NXCD, r = nwg % NXCD, xcd = wgid % NXCD, off = wgid / NXCD; wgid = (xcd < r ? xcd * (q + 1) : r * (q + 1) + (xcd - r) * q) + off; }
        const int nig = WGM * nN, gid = wgid / nig, fm = gid * WGM, gsz = (nM - fm) < WGM ? (nM - fm) : WGM;
        u.pm = fm + ((wgid % nig) % gsz); u.pn = (wgid % nig) / gsz; return true;
    }
    __device__ __forceinline__ void a_ready(const Unit&) const {}
    __device__ __forceinline__ void done(const Unit&) const {}
};

struct ExtraOrder : StaticOrder {
    int n_full, n_extra, c_min;
    __host__ __device__ bool next(int i, Unit& u) const {
        long L;
        if (i < n_full) L = (long)i * G + c;
        else if (c >= c_min && i < n_full + n_extra) L = (long)n_full * G + (long)(i - n_full) * (G - c_min) + (c - c_min);
        else return false;
        if (L >= nwg) return false;
        int wgid = (int)L; { const int q = nwg / NXCD, r = nwg % NXCD, xcd = wgid % NXCD, off = wgid / NXCD; wgid = (xcd < r ? xcd * (q + 1) : r * (q + 1) + (xcd - r) * q) + off; }
        const int nig = WGM * nN, gid = wgid / nig, fm = gid * WGM, gsz = (nM - fm) < WGM ? (nM - fm) : WGM;
        u.pm = fm + ((wgid % nig) % gsz); u.pn = (wgid % nig) / gsz; return true;
    }
};

__device__ __forceinline__ unsigned cvt_pk_bf16(float lo, float hi) { unsigned r; asm volatile("v_cvt_pk_bf16_f32 %0, %1, %2" : "=v"(r) : "v"(lo), "v"(hi)); return r; }
__device__ __forceinline__ float bf_lo(unsigned w) { return __uint_as_float(w << 16); }
__device__ __forceinline__ float bf_hi(unsigned w) { return __uint_as_float(w & 0xffff0000u); }


typedef float f32x2 __attribute__((ext_vector_type(2)));
typedef long long fx64;
__device__ __forceinline__ void fx_add(fx64* p, float v, float scale) { __hip_atomic_fetch_add(p, (fx64)__float2ll_rn(v * scale), __ATOMIC_RELAXED, __HIP_MEMORY_SCOPE_AGENT); }
struct LnFold {
    const fx64* st; const float* c1; const float* c2; int on;
    static constexpr float INV_D = 1.f / 4096.f, EPS = 1e-5f;
    __device__ __forceinline__ void row(int r, float& rr, float& rm) const {
        if (on) { const fx64 a = st[2 * (size_t)r], b = st[2 * (size_t)r + 1]; const float mu = (float)a * (INV_D / 16777216.f), var = fmaxf((float)b * (INV_D / 1048576.f) - mu * mu, 0.f); rr = __builtin_amdgcn_rsqf(var + EPS); rm = rr * mu; }
        else { rr = 1.f; rm = 0.f; }
    }
    __device__ __forceinline__ void cols(int c0, f32x4 (&k1)[2][2], f32x4 (&k2)[2][2]) const {
#pragma unroll
        for (int bj = 0; bj < 2; ++bj)
#pragma unroll
            for (int n = 0; n < 2; ++n) { k1[bj][n] = *(const f32x4*)(c1 + c0 + bj * HALF + 4 * n); k2[bj][n] = *(const f32x4*)(c2 + c0 + bj * HALF + 4 * n); }
    }
};
constexpr float A6_SCALE = 2.f, A6_SCALE1 = 1.f, W6_SCALE = 128.f;
template <bool F8, int PN0 = 0, int F6 = 0> struct EpiZ {
    static constexpr bool PERM = true, AFTER_DRAIN = false, HAS_MID = false, WAIT_AFTER_EPI = !F8;
    bf16_t* Z; float* G; int ldz, Mrows; LnFold ln;
    static constexpr int gate_pn = F8 ? -1 : 9, seg_pn = F8 ? 4 : 9, off_lo = F8 ? 0 : 1024, off_hi = F8 ? 2304 : 1024, gate_coff = 19712 - 9 * 256; static constexpr float ascale = F6 == 1 ? 1.f / (A6_SCALE * W6_SCALE) : F6 == 2 ? 1.f / (A6_SCALE1 * W6_SCALE) : F8 ? 1.f / 64.f : 1.f;
    __device__ __forceinline__ void operator()(const f32x4 (&acc)[2][2][4][2], const Unit& u, int wr, int wc, int fr, int fq) const {
        OPQ_V(fr); OPQ_V(fq);
        const int pn = u.pn + PN0;
        const int row0 = u.pm * BM + wr * 64 + fr, col0 = pn * BM + wc * 32 + 8 * fq + (pn == gate_pn ? gate_coff : (pn < seg_pn ? off_lo : off_hi));
        f32x4 k1[2][2], k2[2][2]; ln.cols(col0, k1, k2);
        const float asc = F6 ? (F6 == 1 ? 1.f / A6_SCALE : 1.f / A6_SCALE1) * (pn < 4 ? 1.f / 512.f : pn < 8 ? 1.f / 128.f : pn < 12 ? 1.f / 1024.f : pn < 16 ? 1.f / 128.f : pn < 20 ? 1.f / 256.f : 1.f / 128.f) : ascale;
        if (pn == gate_pn) {
#pragma unroll
            for (int bj = 0; bj < 2; ++bj)
#pragma unroll
                for (int n = 0; n < 2; ++n) asm volatile("" :: "v"(k1[bj][n]), "v"(k2[bj][n]));
            if (wc == 0 && fq < 3) {
#pragma unroll
                for (int ai = 0; ai < 2; ++ai)
#pragma unroll
                    for (int m = 0; m < 4; ++m) { const int r = row0 + ai * HALF + m * 16; float rr, rm; ln.row(r, rr, rm); rr *= asc;
#pragma unroll
                        for (int n = 0; n < 2; ++n)
#pragma unroll
                            for (int j = 0; j < 4; ++j) G[(size_t)(8 * fq + 4 * n + j) * Mrows + r] = rr * acc[ai][0][m][n][j] - rm * k1[0][n][j] + k2[0][n][j]; }
            }
            return;
        }
#pragma unroll
        for (int ai = 0; ai < 2; ++ai)
#pragma unroll
            for (int m = 0; m < 4; ++m) { const int r = row0 + ai * HALF + m * 16; float rr, rm; ln.row(r, rr, rm); rr *= asc; bf16_t* rowp = Z + (size_t)r * ldz + col0;
#pragma unroll
                for (int bj = 0; bj < 2; ++bj) { f32x4 v0 = acc[ai][bj][m][0] * rr - k1[bj][0] * rm + k2[bj][0], v1 = acc[ai][bj][m][1] * rr - k1[bj][1] * rm + k2[bj][1];
                    if (F8 && pn >= 20) {
#pragma unroll
                        for (int j = 0; j < 4; ++j) { v0[j] = __builtin_amdgcn_exp2f(__builtin_amdgcn_fmed3f(v0[j], -40.f, 40.f) * -1.4426950408889634f); v1[j] = __builtin_amdgcn_exp2f(__builtin_amdgcn_fmed3f(v1[j], -40.f, 40.f) * -1.4426950408889634f); } }
                    u32x4 w; w.x = cvt_pk_bf16(v0[0], v0[1]); w.y = cvt_pk_bf16(v0[2], v0[3]); w.z = cvt_pk_bf16(v1[0], v1[1]); w.w = cvt_pk_bf16(v1[2], v1[3]);
                    *(u32x4*)(rowp + bj * HALF) = w; } }
    }
};
struct EpiRelu2 {
    static constexpr bool PERM = true, AFTER_DRAIN = false, HAS_MID = false, WAIT_AFTER_EPI = false;
    bf16_t* O; int ldc; LnFold ln;
    __device__ __forceinline__ void operator()(const f32x4 (&acc)[2][2][4][2], const Unit& u, int wr, int wc, int fr, int fq) const {
        OPQ_V(fr); OPQ_V(fq);
        const int row0 = u.pm * BM + wr * 64 + fr, col0 = u.pn * BM + wc * 32 + 8 * fq;
        f32x4 k1[2][2], k2[2][2]; ln.cols(col0, k1, k2);
#pragma unroll
        for (int ai = 0; ai < 2; ++ai)
#pragma unroll
            for (int m = 0; m < 4; ++m) { const int r = row0 + ai * HALF + m * 16; float rr, rm; ln.row(r, rr, rm); bf16_t* rowp = O + (size_t)r * ldc + col0;
#pragma unroll
                for (int bj = 0; bj < 2; ++bj) { f32x4 v0 = acc[ai][bj][m][0] * rr - k1[bj][0] * rm + k2[bj][0], v1 = acc[ai][bj][m][1] * rr - k1[bj][1] * rm + k2[bj][1];
#pragma unroll
                    for (int j = 0; j < 4; ++j) { const float a = fmaxf(v0[j], 0.f), b = fmaxf(v1[j], 0.f); v0[j] = a * a; v1[j] = b * b; }
                    u32x4 w; w.x = cvt_pk_bf16(v0[0], v0[1]); w.y = cvt_pk_bf16(v0[2], v0[3]); w.z = cvt_pk_bf16(v1[0], v1[1]); w.w = cvt_pk_bf16(v1[2], v1[3]);
                    *(u32x4*)(rowp + bj * HALF) = w; } }
    }
};
template <int mode, bool F8> struct EpiRes {
    static constexpr bool PERM = true, AFTER_DRAIN = false, HAS_MID = false, WAIT_AFTER_EPI = false;
    const float* X; const bf16_t* Tp; const fx64* stp; const float* g; const float* b; bf16_t* T; fx64* sto; unsigned char* T8; unsigned char* T6; int ldc; static constexpr float alpha = 1.41421356237309515f  , ascale = F8 ? 1.f / 2048.f : 1.f;
    __device__ __forceinline__ void operator()(const f32x4 (&acc)[2][2][4][2], const Unit& u, int wr, int wc, int fr, int fq) const {
        OPQ_V(fr); OPQ_V(fq);
        const int row0 = u.pm * BM + wr * 64 + fr, col0 = u.pn * BM + wc * 32 + 8 * fq;
        f32x4 gv[2][2], bv[2][2];
#pragma unroll
        for (int bj = 0; bj < 2; ++bj)
#pragma unroll
            for (int n = 0; n < 2; ++n) { if (mode) { gv[bj][n] = *(const f32x4*)(g + col0 + bj * HALF + 4 * n); bv[bj][n] = *(const f32x4*)(b + col0 + bj * HALF + 4 * n); } }
        LnFold lp{stp, nullptr, nullptr, mode};
        const int lane = fr + 16 * fq;
#pragma unroll
        for (int ai = 0; ai < 2; ++ai) {
            u32x4 tw[4][2];
            if (mode) {
#pragma unroll
                for (int m = 0; m < 4; ++m)
#pragma unroll
                    for (int bj = 0; bj < 2; ++bj) tw[m][bj] = *(const u32x4*)(Tp + (size_t)(row0 + ai * HALF + m * 16) * ldc + col0 + bj * HALF);
            }
#pragma unroll
            for (int mp = 0; mp < 2; ++mp) {
                f32x4 xf[2][2][2];
                if (!mode) {
#pragma unroll
                    for (int mm = 0; mm < 2; ++mm)
#pragma unroll
                        for (int bj = 0; bj < 2; ++bj)
#pragma unroll
                            for (int n = 0; n < 2; ++n) xf[mm][bj][n] = *(const f32x4*)(X + (size_t)(row0 + ai * HALF + (2 * mp + mm) * 16) * ldc + col0 + bj * HALF + 4 * n);
                }
#pragma unroll
                for (int mm = 0; mm < 2; ++mm) { const int m = 2 * mp + mm, r = row0 + ai * HALF + m * 16; bf16_t* rowp = T + (size_t)r * ldc + col0; float s1 = 0.f, s2 = 0.f;
                    float rr = 1.f, rm = 0.f; if (mode) lp.row(r, rr, rm);
                    unsigned p6lo[2], p6hi[2];
#pragma unroll
                    for (int bj = 0; bj < 2; ++bj) { f32x4 x0, x1;
                        if (mode) { const u32x4 w = tw[m][bj];
                            x0 = ((f32x4){bf_lo(w.x), bf_hi(w.x), bf_lo(w.y), bf_hi(w.y)} * rr - rm) * gv[bj][0] + bv[bj][0];
                            x1 = ((f32x4){bf_lo(w.z), bf_hi(w.z), bf_lo(w.w), bf_hi(w.w)} * rr - rm) * gv[bj][1] + bv[bj][1]; }
                        else { x0 = xf[mm][bj][0]; x1 = xf[mm][bj][1]; }
                        const f32x4 v0 = x0 * alpha + acc[ai][bj][m][0] * ascale, v1 = x1 * alpha + acc[ai][bj][m][1] * ascale;
                        u32x4 w; w.x = cvt_pk_bf16(v0[0], v0[1]); w.y = cvt_pk_bf16(v0[2], v0[3]); w.z = cvt_pk_bf16(v1[0], v1[1]); w.w = cvt_pk_bf16(v1[2], v1[3]);
                        *(u32x4*)(rowp + bj * HALF) = w;
                        if (T6) { unsigned cd[8];
#pragma unroll
                            for (int e = 0; e < 4; ++e) { cd[e] = q_e2m3(v0[e] * A6_SCALE1); cd[4 + e] = q_e2m3(v1[e] * A6_SCALE1); }
                            p6lo[bj] = cd[0] | (cd[1] << 6) | (cd[2] << 12) | (cd[3] << 18) | (cd[4] << 24) | (cd[5] << 30); p6hi[bj] = (cd[5] >> 2) | (cd[6] << 4) | (cd[7] << 10); }
#pragma unroll
                        for (int d = 0; d < 4; ++d) { const float a = bf_lo(w[d]), c = bf_hi(w[d]); s1 += a + c; s2 += a * a + c * c; } }
                    if (T6) {
                        const bool odd = (fq & 1) != 0;
                        const unsigned rlo = (unsigned)__builtin_amdgcn_ds_bpermute((lane ^ 16) << 2, (int)(odd ? p6lo[0] : p6lo[1])), rhi = (unsigned)__builtin_amdgcn_ds_bpermute((lane ^ 16) << 2, (int)(odd ? p6hi[0] : p6hi[1]));
                        const unsigned flo = odd ? rlo : p6lo[0], fhi = odd ? rhi : p6hi[0], slo = odd ? p6lo[1] : rlo, shi = odd ? p6hi[1] : rhi;
                        pk6x4_t d6; d6.x = flo; d6.y = fhi | (slo << 16); d6.z = (slo >> 16) | (shi << 16); d6.w = 0u;
                        store_e2m3_group(e2m3_ktile(T6, r, 2 * u.pn + (odd ? 1 : 0), false), 2 * wc + (fq >> 1), d6); }
                    s1 += __int_as_float(__builtin_amdgcn_ds_bpermute((lane ^ 16) << 2, __float_as_int(s1))); s2 += __int_as_float(__builtin_amdgcn_ds_bpermute((lane ^ 16) << 2, __float_as_int(s2)));
                    s1 += __int_as_float(__builtin_amdgcn_ds_bpermute((lane ^ 32) << 2, __float_as_int(s1))); s2 += __int_as_float(__builtin_amdgcn_ds_bpermute((lane ^ 32) << 2, __float_as_int(s2)));
                    if (fq == 0) { fx_add(sto + 2 * (size_t)r, s1, 16777216.f); fx_add(sto + 2 * (size_t)r + 1, s2, 1048576.f); } }
                asm volatile("" ::: "memory");
            }
        }
    }
};
template <bool F8> struct EpiMix {
    static constexpr bool PERM = true, AFTER_DRAIN = false, HAS_MID = true, WAIT_AFTER_EPI = false; static constexpr int MID_T = F8 ? 8 : 16;
    const bf16_t* Zg; bf16_t* O; int ldz, ldc; float ascale;
    static __device__ __forceinline__ float e_neg(float e) { return e; }
    __device__ __forceinline__ void mid(f32x4 (&acc)[2][2][4][2], const Unit& u, int wr, int wc, int fr, int fq, int seg) const {
        OPQ_V(fr); OPQ_V(fq);
        const int row0 = u.pm * BM + wr * 64 + fr, col0 = u.pn * BM + wc * 32 + 8 * fq;
#pragma unroll
        for (int ai = 0; ai < 2; ++ai) {
            u32x4 gx[4][2], gy[4][2];
#pragma unroll
            for (int m = 0; m < 4; ++m) { const bf16_t* zr = Zg + (size_t)(row0 + ai * HALF + m * 16) * ldz + col0 + seg * 4096;
#pragma unroll
                for (int bj = 0; bj < 2; ++bj) { gx[m][bj] = *(const u32x4*)(zr + bj * HALF); gy[m][bj] = *(const u32x4*)(zr + bj * HALF + 4096); } }
#pragma unroll
            for (int m = 0; m < 4; ++m)
#pragma unroll
                for (int bj = 0; bj < 2; ++bj)
#pragma unroll
                    for (int d = 0; d < 4; ++d) { const int n = d >> 1, j = (d & 1) * 2;
                        const float r0 = (1.f + e_neg(bf_lo(gy[m][bj][d]))) * __builtin_amdgcn_rcpf(1.f + e_neg(bf_lo(gx[m][bj][d])));
                        const float r1 = (1.f + e_neg(bf_hi(gy[m][bj][d]))) * __builtin_amdgcn_rcpf(1.f + e_neg(bf_hi(gx[m][bj][d])));
                        acc[ai][bj][m][n][j] *= r0; acc[ai][bj][m][n][j + 1] *= r1; }
            asm volatile("" ::: "memory"); }
    }
    __device__ __forceinline__ void operator()(const f32x4 (&acc)[2][2][4][2], const Unit& u, int wr, int wc, int fr, int fq) const {
        OPQ_V(fr); OPQ_V(fq);
        const int row0 = u.pm * BM + wr * 64 + fr, col0 = u.pn * BM + wc * 32 + 8 * fq;
#pragma unroll
        for (int ai = 0; ai < 2; ++ai) {
            u32x4 gcv[4][2];
#pragma unroll
            for (int m = 0; m < 4; ++m) { const bf16_t* zr = Zg + (size_t)(row0 + ai * HALF + m * 16) * ldz + col0 + 8192; gcv[m][0] = *(const u32x4*)(zr); gcv[m][1] = *(const u32x4*)(zr + HALF); }
#pragma unroll
            for (int m = 0; m < 4; ++m) { bf16_t* rowp = O + (size_t)(row0 + ai * HALF + m * 16) * ldc + col0;
#pragma unroll
                for (int bj = 0; bj < 2; ++bj) { const u32x4 gc = gcv[m][bj]; const f32x4 v0 = acc[ai][bj][m][0], v1 = acc[ai][bj][m][1]; float o[8];
                    o[0] = v0[0] * __builtin_amdgcn_rcpf(1.f + e_neg(bf_lo(gc[0]))); o[1] = v0[1] * __builtin_amdgcn_rcpf(1.f + e_neg(bf_hi(gc[0])));
                    o[2] = v0[2] * __builtin_amdgcn_rcpf(1.f + e_neg(bf_lo(gc[1]))); o[3] = v0[3] * __builtin_amdgcn_rcpf(1.f + e_neg(bf_hi(gc[1])));
                    o[4] = v1[0] * __builtin_amdgcn_rcpf(1.f + e_neg(bf_lo(gc[2]))); o[5] = v1[1] * __builtin_amdgcn_rcpf(1.f + e_neg(bf_hi(gc[2])));
                    o[6] = v1[2] * __builtin_amdgcn_rcpf(1.f + e_neg(bf_lo(gc[3]))); o[7] = v1[3] * __builtin_amdgcn_rcpf(1.f + e_neg(bf_hi(gc[3])));
                    if constexpr (F8) {
#pragma unroll
                        for (int e = 0; e < 8; ++e) o[e] *= ascale;
                        const int p0 = pk4_e4m3(o[0], o[1], o[2], o[3]), p1 = pk4_e4m3(o[4], o[5], o[6], o[7]);
                        typedef int v2i_t __attribute__((ext_vector_type(2))); *(v2i_t*)((unsigned char*)O + (size_t)(row0 + ai * HALF + m * 16) * ldc + col0 + bj * HALF) = (v2i_t){p0, p1};
                    } else {
                    u32x4 w; w.x = cvt_pk_bf16(o[0], o[1]); w.y = cvt_pk_bf16(o[2], o[3]); w.z = cvt_pk_bf16(o[4], o[5]); w.w = cvt_pk_bf16(o[6], o[7]);
                    *(u32x4*)(rowp + bj * HALF) = w; } } }
            asm volatile("" ::: "memory"); }
    }
};

typedef int v4i_t __attribute__((ext_vector_type(4)));
typedef int v8i_t __attribute__((ext_vector_type(8)));
typedef int v6i_t __attribute__((ext_vector_type(6)));
template <class Epi, class Sched, bool ALIGN_EPI = false, bool SP2 = false, bool FP8 = false, bool FP6 = false>
__device__ __forceinline__ void gemm_phase(PG8_LAS unsigned char* lds, const Gemm g, const Sched& S, const Epi& E, int wave) {
    int tid_ = wave * 64 + lane_id(); OPQ_V(tid_);
    const int tid = tid_, wid = __builtin_amdgcn_readfirstlane(tid >> 6), lane = tid & 63, wr = wid >> 2, wc = wid & 3, fr = lane & 15, fq = lane >> 4;
    int K_ = g.K; OPQ_S(K_); const int K = K_, nt = K / BK;
    unsigned voffA[2], voffB[2];
#pragma unroll
    for (int i = 0; i < 2; ++i) { int R, C; stage_rc(tid * 16 + i * 8192, R, C); const int Rb = Epi::PERM ? ((R & ~31) + perm32(R & 31)) : R;
        voffA[i] = (unsigned)(R * K + C) * 2u; voffB[i] = (unsigned)(Rb * K + C) * 2u; }
    const size_t kstep = (size_t)(BK * 2);
    const size_t hstep = (size_t)HALF * K * 2;
    const size_t tstep = 2 * hstep;
    const unsigned ldsw = (unsigned)wid * 1024u;
    const int aoff = lds_byte(wr * 64 + fr, fq * 8), boff = lds_byte(wc * 32 + fr, fq * 8);
#define PG8_SA(b, h) (((b) * 2 + (h)) * HTB)
#define PG8_SB(b, h) ((4 + (b) * 2 + (h)) * HTB)
#define PG8_STAGE(bufoff, gbase, voff) do { _Pragma("unroll") for (int _i = 0; _i < 2; ++_i) \
        __builtin_amdgcn_global_load_lds((const unsigned*)((const char*)(gbase) + (voff)[_i]), (PG8_LAS unsigned*)(lds + (bufoff) + ldsw + _i * 8192), 16, 0, 0); } while (0)
#define PG8_LDF(p) ([&](const PG8_LAS unsigned char* p_, int k_) -> bf16x8 { if constexpr (FP6) { if (k_ == 1) { typedef short s4_t __attribute__((ext_vector_type(4))); const s4_t h_ = *(const volatile PG8_LAS s4_t*)p_;   return __builtin_shufflevector(h_, h_, 0, 1, 2, 3, -1, -1, -1, -1); } } return *(const PG8_LAS bf16x8*)p_; })
#define PG8_LDA(dst, b, h) do { _Pragma("unroll") for (int m = 0; m < 4; ++m) _Pragma("unroll") for (int k = 0; k < 2; ++k) dst[m][k] = PG8_LDF(0)(lds + PG8_SA(b, h) + aoff + m * 2048 + k * 1024, k); } while (0)
#define PG8_LDB(dst, b, h) do { _Pragma("unroll") for (int n = 0; n < 2; ++n) _Pragma("unroll") for (int k = 0; k < 2; ++k) dst[n][k] = PG8_LDF(0)(lds + PG8_SB(b, h) + boff + n * 2048 + k * 1024, k); } while (0)
#define PG8_CAT(x) __builtin_shufflevector(__builtin_bit_cast(v4i_t, (x)[0]), __builtin_bit_cast(v4i_t, (x)[1]), 0, 1, 2, 3, 4, 5, 6, 7)
#define PG8_CAT6(x) __builtin_shufflevector(__builtin_bit_cast(v4i_t, (x)[0]), __builtin_bit_cast(v4i_t, (x)[1]), 0, 1, 2, 3, 4, 5)
#define PG8_MMA(ai, bj, At, Bt) do { __builtin_amdgcn_s_setprio(1); if constexpr (FP6) { v6i_t a6_[4], b6_[2]; _Pragma("unroll") for (int m = 0; m < 4; ++m) a6_[m] = PG8_CAT6(At[m]); _Pragma("unroll") for (int n = 0; n < 2; ++n) b6_[n] = PG8_CAT6(Bt[n]); \
        _Pragma("unroll") for (int m = 0; m < 4; ++m) _Pragma("unroll") for (int n = 0; n < 2; ++n) \
        asm volatile("v_mfma_f32_16x16x128_f8f6f4 %0, %1, %2, %0 cbsz:2 blgp:2" : "+v"(acc[ai][bj][m][n]) : "v"(b6_[n]), "v"(a6_[m])); } \
        else if constexpr (FP8) { _Pragma("unroll") for (int m = 0; m < 4; ++m) _Pragma("unroll") for (int n = 0; n < 2; ++n) \
        asm volatile("v_mfma_f32_16x16x128_f8f6f4 %0, %1, %2, %0" : "+v"(acc[ai][bj][m][n]) : "v"(PG8_CAT(Bt[n])), "v"(PG8_CAT(At[m]))); } \
        else { _Pragma("unroll") for (int m = 0; m < 4; ++m) _Pragma("unroll") for (int n = 0; n < 2; ++n) _Pragma("unroll") for (int k = 0; k < 2; ++k) \
        acc[ai][bj][m][n] = __builtin_amdgcn_mfma_f32_16x16x32_bf16(Bt[n][k], At[m][k], acc[ai][bj][m][n], 0, 0, 0); } __builtin_amdgcn_s_setprio(0); } while (0)
#define PG8_WAIT_V(n) asm volatile("s_waitcnt vmcnt(" #n ")" ::: "memory")
#define PG8_WAIT_L(n) asm volatile("s_waitcnt lgkmcnt(" #n ")" ::: "memory")
#define PG8_BAR __builtin_amdgcn_s_barrier()
#define PG8_SCHED __builtin_amdgcn_sched_barrier(0)
    Unit cur, nxt; int ui = 0;
    __builtin_amdgcn_s_waitcnt(0x0F70);
    if (!S.next(0, cur)) return;
    f32x4 acc[2][2][4][2];
#pragma unroll
    for (int a = 0; a < 2; ++a)
#pragma unroll
        for (int b = 0; b < 2; ++b)
#pragma unroll
            for (int m = 0; m < 4; ++m)
#pragma unroll
                for (int n = 0; n < 2; ++n) acc[a][b][m][n] = (f32x4){0.f, 0.f, 0.f, 0.f};
    bf16x8 At[4][2], B0[2][2], B1[2][2];
    const char* cA = (const char*)g.A + (size_t)cur.pm * tstep; const char* cB = (const char*)g.Bt + (size_t)cur.pn * tstep;
    S.a_ready(cur);
    if constexpr (SP2) {
        PG8_STAGE(PG8_SB(0, 0), cB, voffB); PG8_STAGE(PG8_SB(0, 1), cB + hstep, voffB); PG8_STAGE(PG8_SA(0, 0), cA, voffA); PG8_STAGE(PG8_SA(0, 1), cA + hstep, voffA);
        if (wr == 1) PG8_BAR;
        PG8_WAIT_V(2); PG8_BAR;
        PG8_STAGE(PG8_SB(1, 0), cB + kstep, voffB); PG8_STAGE(PG8_SA(1, 0), cA + kstep, voffA); PG8_STAGE(PG8_SB(1, 1), cB + hstep + kstep, voffB);
        PG8_WAIT_V(6); PG8_BAR;
    } else {
        PG8_STAGE(PG8_SB(0, 0), cB, voffB); PG8_STAGE(PG8_SA(0, 0), cA, voffA); PG8_STAGE(PG8_SB(0, 1), cB + hstep, voffB); PG8_STAGE(PG8_SA(0, 1), cA + hstep, voffA);
        if (wr == 1) PG8_BAR;
        PG8_WAIT_V(4); PG8_BAR;
        PG8_STAGE(PG8_SB(1, 0), cB + kstep, voffB); PG8_STAGE(PG8_SA(1, 0), cA + kstep, voffA); PG8_STAGE(PG8_SB(1, 1), cB + hstep + kstep, voffB);
        PG8_WAIT_V(6); PG8_BAR;
    }
    for (;;) {
        const bool has_next = S.next(ui + 1, nxt);
        const char* nA = has_next ? (const char*)g.A + (size_t)nxt.pm * tstep : cA; const char* nB = has_next ? (const char*)g.Bt + (size_t)nxt.pn * tstep : cB;
        for (int t = 0; t < nt; t += 2) {
            const bool last = (t == nt - 2);
            const char* a1 = cA + (size_t)(t + 1) * kstep;
            const char* a2 = last ? nA : cA + (size_t)(t + 2) * kstep; const char* b2 = last ? nB : cB + (size_t)(t + 2) * kstep;
            const char* a3 = a2 + kstep; const char* b3 = b2 + kstep;
            if (last && has_next) S.a_ready(nxt);
            if constexpr (Epi::HAS_MID) { if (t == Epi::MID_T || t == 2 * Epi::MID_T) E.mid(acc, cur, wr, wc, fr, fq, t / Epi::MID_T - 1); }
            if constexpr (SP2) {
            PG8_LDB(B0, 0, 0); PG8_LDB(B1, 0, 1); PG8_SCHED; PG8_LDA(At, 0, 0); PG8_STAGE(PG8_SA(1, 1), a1 + hstep, voffA);
            PG8_WAIT_V(8); PG8_WAIT_L(0); PG8_BAR; PG8_MMA(0, 0, At, B0); PG8_MMA(0, 1, At, B1); PG8_BAR; PG8_SCHED;
            PG8_LDA(At, 0, 1); PG8_STAGE(PG8_SB(0, 0), b2, voffB); PG8_STAGE(PG8_SB(0, 1), b2 + hstep, voffB); PG8_STAGE(PG8_SA(0, 0), a2, voffA);
            PG8_WAIT_V(8); PG8_WAIT_L(0); PG8_BAR; PG8_MMA(1, 0, At, B0); PG8_MMA(1, 1, At, B1); PG8_BAR; PG8_SCHED;
            PG8_LDB(B0, 1, 0); PG8_LDB(B1, 1, 1); PG8_SCHED; PG8_LDA(At, 1, 0); PG8_STAGE(PG8_SA(0, 1), a2 + hstep, voffA);
            PG8_WAIT_V(8); PG8_WAIT_L(0); PG8_BAR; PG8_MMA(0, 0, At, B0); PG8_MMA(0, 1, At, B1); PG8_BAR; PG8_SCHED;
            PG8_LDA(At, 1, 1); PG8_STAGE(PG8_SB(1, 0), b3, voffB); PG8_STAGE(PG8_SB(1, 1), b3 + hstep, voffB); PG8_STAGE(PG8_SA(1, 0), a3, voffA);
            PG8_WAIT_V(8); PG8_WAIT_L(0); PG8_BAR; PG8_MMA(1, 0, At, B0); PG8_MMA(1, 1, At, B1); PG8_BAR; PG8_SCHED;
            } else {
            PG8_LDB(B0, 0, 0); PG8_SCHED; PG8_LDA(At, 0, 0); PG8_STAGE(PG8_SA(1, 1), a1 + hstep, voffA);
            PG8_WAIT_L(8); PG8_BAR; PG8_WAIT_L(0); PG8_MMA(0, 0, At, B0); PG8_BAR; PG8_SCHED;
            PG8_LDB(B1, 0, 1); PG8_STAGE(PG8_SB(0, 0), b2, voffB);
            PG8_BAR; PG8_WAIT_L(0); PG8_MMA(0, 1, At, B1); PG8_BAR;
            PG8_LDA(At, 0, 1); PG8_STAGE(PG8_SA(0, 0), a2, voffA);
            PG8_BAR; PG8_WAIT_L(0); PG8_MMA(1, 0, At, B0); PG8_BAR; PG8_SCHED;
            PG8_STAGE(PG8_SB(0, 1), b2 + hstep, voffB);
            PG8_WAIT_V(6); PG8_BAR; PG8_MMA(1, 1, At, B1); PG8_BAR;
            PG8_LDB(B0, 1, 0); PG8_SCHED; PG8_LDA(At, 1, 0); PG8_STAGE(PG8_SA(0, 1), a2 + hstep, voffA);
            PG8_WAIT_L(8); PG8_BAR; PG8_WAIT_L(0); PG8_MMA(0, 0, At, B0); PG8_BAR; PG8_SCHED;
            PG8_LDB(B1, 1, 1); PG8_STAGE(PG8_SB(1, 0), b3, voffB);
            PG8_BAR; PG8_WAIT_L(0); PG8_MMA(0, 1, At, B1); PG8_BAR;
            PG8_LDA(At, 1, 1); PG8_STAGE(PG8_SA(1, 0), a3, voffA);
            PG8_BAR; PG8_WAIT_L(0); PG8_MMA(1, 0, At, B0); PG8_BAR; PG8_SCHED;
            PG8_STAGE(PG8_SB(1, 1), b3 + hstep, voffB);
            PG8_WAIT_V(6); PG8_BAR; PG8_MMA(1, 1, At, B1); PG8_BAR;
            }
        }
        if constexpr (ALIGN_EPI) { if (wr == 0) PG8_BAR; }
        E(acc, cur, wr, wc, fr, fq); S.done(cur);
        if constexpr (Epi::WAIT_AFTER_EPI) __builtin_amdgcn_s_waitcnt(0x0F70);
        if (!has_next) break;
#pragma unroll
        for (int a = 0; a < 2; ++a)
#pragma unroll
            for (int b = 0; b < 2; ++b)
#pragma unroll
                for (int m = 0; m < 4; ++m)
#pragma unroll
                    for (int n = 0; n < 2; ++n) acc[a][b][m][n] = (f32x4){0.f, 0.f, 0.f, 0.f};
        cur = nxt; cA = nA; cB = nB; ++ui;
        if constexpr (ALIGN_EPI) { if (wr == 1) PG8_BAR; }
    }
    PG8_WAIT_V(0);
    if constexpr (!ALIGN_EPI) { if (wr == 0) PG8_BAR; }
    PG8_BAR;
#undef PG8_SA
#undef PG8_SB
#undef PG8_STAGE
#undef PG8_LDA
#undef PG8_LDF
#undef PG8_LDB
#undef PG8_MMA
#undef PG8_CAT
#undef PG8_CAT6
#undef PG8_WAIT_V
#undef PG8_WAIT_L
#undef PG8_BAR
#undef PG8_SCHED
}

template <class Epi, class Sched, bool ALIGN_EPI>
__device__ __forceinline__ void gemm_phase_fp6d(PG8_LAS unsigned char* lds, const Gemm g, const Sched& S, const Epi& E, int wave) {
    int tid_ = wave * 64 + lane_id(); OPQ_V(tid_);
    const int tid = tid_, wid = __builtin_amdgcn_readfirstlane(tid >> 6), lane = tid & 63, wr = wid >> 2, wc = wid & 3, fr = lane & 15, fq = lane >> 4;
    int K_ = g.K; OPQ_S(K_); const int K = K_, nt = K / BK;
    const size_t tstep = (size_t)nt * 24576;
    constexpr int SLOT = 49152, BOFF = 24576, KT = 96, KTG = 24576;
    unsigned voffA[3], voffB[3];
#pragma unroll
    for (int i = 0; i < 3; ++i) { voffA[i] = (unsigned)(i * 512 + tid) * 16u; voffB[i] = voffA[i]; }
    const unsigned ldsw = (unsigned)wid * 1024u;
    const int aoff = (wr * 64 + fr) * KT + 24 * fq, boff = BOFF + (wc * 32 + fr) * KT + 24 * fq;
    typedef int v2i_t __attribute__((ext_vector_type(2)));
    typedef int v4a8_t __attribute__((ext_vector_type(4), aligned(8)));
#define F6_STAGE(slot, pa, pb) do { _Pragma("unroll") for (int _i = 0; _i < 3; ++_i) { \
        __builtin_amdgcn_global_load_lds((const unsigned*)((pa) + voffA[_i]), (PG8_LAS unsigned*)(lds + (slot) * SLOT + ldsw + _i * 8192), 16, 0, 0); \
        __builtin_amdgcn_global_load_lds((const unsigned*)((pb) + voffB[_i]), (PG8_LAS unsigned*)(lds + (slot) * SLOT + BOFF + ldsw + _i * 8192), 16, 0, 0); } } while (0)
#define F6_LD(dst, p) do { const PG8_LAS unsigned char* p_ = (p); const v2i_t a_ = *(const volatile PG8_LAS v2i_t*)p_, b_ = *(const volatile PG8_LAS v2i_t*)(p_ + 8), c_ = *(const volatile PG8_LAS v2i_t*)(p_ + 16); \
        dst = __builtin_shufflevector(__builtin_shufflevector(a_, b_, 0, 1, 2, 3), __builtin_shufflevector(c_, c_, 0, 1, -1, -1), 0, 1, 2, 3, 4, 5); } while (0)
#define F6_WAIT_V(n) asm volatile("s_waitcnt vmcnt(" #n ")" ::: "memory")
#define F6_WAIT_L0 asm volatile("s_waitcnt lgkmcnt(0)" ::: "memory")
#define F6_BAR __builtin_amdgcn_s_barrier()
    Unit cur, nxt; int ui = 0;
    __builtin_amdgcn_s_waitcnt(0x0F70);
    if (!S.next(0, cur)) return;
    f32x4 acc[2][2][4][2];
#pragma unroll
    for (int a = 0; a < 2; ++a)
#pragma unroll
        for (int b = 0; b < 2; ++b)
#pragma unroll
            for (int m = 0; m < 4; ++m)
#pragma unroll
                for (int n = 0; n < 2; ++n) acc[a][b][m][n] = (f32x4){0.f, 0.f, 0.f, 0.f};
    const char* cA = (const char*)g.A + (size_t)cur.pm * tstep; const char* cB = (const char*)g.Bt + (size_t)cur.pn * tstep;
    F6_STAGE(0, cA, cB); F6_STAGE(1, cA + KTG, cB + KTG);
    F6_WAIT_V(0); F6_BAR;
    if (wr == 1) F6_BAR;
    int sr = 0;
    for (;;) {
        const bool has_next = S.next(ui + 1, nxt);
        const char* nA = has_next ? (const char*)g.A + (size_t)nxt.pm * tstep : cA; const char* nB = has_next ? (const char*)g.Bt + (size_t)nxt.pn * tstep : cB;
#pragma unroll 1
        for (int t = 0; t < nt; ++t) {
            const int t2 = t + 2; const char* ta = t2 < nt ? cA + (size_t)t2 * KTG : nA + (size_t)(t2 - nt) * KTG; const char* tb = t2 < nt ? cB + (size_t)t2 * KTG : nB + (size_t)(t2 - nt) * KTG;
            int sw = sr + 2; if (sw >= 3) sw -= 3;
            F6_STAGE(sw, ta, tb);
            v6i_t A6[2][4], B6[2][2];
            const PG8_LAS unsigned char* sp = lds + sr * SLOT;
#pragma unroll
            for (int bj = 0; bj < 2; ++bj)
#pragma unroll
                for (int n = 0; n < 2; ++n) F6_LD(B6[bj][n], sp + boff + (bj * 128 + n * 16) * KT);
#pragma unroll
            for (int ai = 0; ai < 2; ++ai)
#pragma unroll
                for (int m = 0; m < 4; ++m) F6_LD(A6[ai][m], sp + aoff + (ai * 128 + m * 16) * KT);
            if (wr == 1) F6_WAIT_V(6);
            F6_WAIT_L0; F6_BAR;
            __builtin_amdgcn_s_setprio(1);
#pragma unroll
            for (int ai = 0; ai < 2; ++ai)
#pragma unroll
                for (int bj = 0; bj < 2; ++bj)
#pragma unroll
                    for (int m = 0; m < 4; ++m)
#pragma unroll
                        for (int n = 0; n < 2; ++n) asm volatile("v_mfma_f32_16x16x128_f8f6f4 %0, %1, %2, %0 cbsz:2 blgp:2" : "+v"(acc[ai][bj][m][n]) : "v"(B6[bj][n]), "v"(A6[ai][m]));
            __builtin_amdgcn_s_setprio(0);
            if (wr == 0) F6_WAIT_V(6);
            F6_BAR; __builtin_amdgcn_sched_barrier(0);
            sr = sr == 2 ? 0 : sr + 1;
        }
        if constexpr (ALIGN_EPI) { if (wr == 0) F6_BAR; }
        E(acc, cur, wr, wc, fr, fq); S.done(cur);
        if constexpr (Epi::WAIT_AFTER_EPI) __builtin_amdgcn_s_waitcnt(0x0F70);
        if (!has_next) break;
#pragma unroll
        for (int a = 0; a < 2; ++a)
#pragma unroll
            for (int b = 0; b < 2; ++b)
#pragma unroll
                for (int m = 0; m < 4; ++m)
#pragma unroll
                    for (int n = 0; n < 2; ++n) acc[a][b][m][n] = (f32x4){0.f, 0.f, 0.f, 0.f};
        cur = nxt; cA = nA; cB = nB; ++ui;
        if constexpr (ALIGN_EPI) { if (wr == 1) F6_BAR; }
    }
    F6_WAIT_V(0);
    if constexpr (!ALIGN_EPI) { if (wr == 0) F6_BAR; }
    F6_BAR;
#undef F6_STAGE
#undef F6_LD
#undef F6_WAIT_V
#undef F6_WAIT_L0
#undef F6_BAR
}
}

#ifndef PG8_SP2
#define PG8_SP2 true
#endif
#ifndef PG8_ALIGN
#define PG8_ALIGN true
#endif

constexpr int NWAVES = 8;
constexpr int BATCH = 4, SEQ = 2048, D = 4096, DEPTH = 2, M = BATCH * SEQ;
constexpr int DIN = 19736;
constexpr int NZ = 19712;
constexpr int NZP = 19968;
constexpr int GATE_PN = 77;
constexpr int DFF = 16384, NY = 3072;
constexpr int ZC_AQ = 0, ZC_AK = 1024, ZC_AV = 1152, ZC_MQ = 1280, ZC_MK = 1792, ZC_MV = 2304, ZC_MO = 3328, ZC_CQ = 4352, ZC_CK = 5376, ZC_CV = 6400, ZC_GA = 7424;
constexpr float LN_EPS = 1e-5f, DN_ALPHA = 1.41421356237309515f, LOG2E = 1.4426950408889634f;

constexpr size_t MiB = 1u << 20;
constexpr size_t WS_CTL = 0, CTL_ZERO_BYTES = 2 * MiB;
constexpr int NZB = 2560, NZ8 = 17408;
__host__ __device__ constexpr bool z_is_fp8(int n0) { return n0 < 1024 || (n0 >= 3328 && n0 < 19712); }
__host__ __device__ constexpr int z_row(int n0) { return n0 < 1024 ? n0 : n0 < 3328 ? n0 - 1024 : n0 < 19712 ? n0 - 2304 : n0 - 19712 + 2304; }
__host__ __device__ constexpr bool fp6_layer(int l) { return l >= 0; }
__host__ __device__ constexpr float w6_scale(int n0) { return n0 < 1024 ? 512.f : n0 < 4352 ? 128.f : n0 < 5376 ? 1024.f : n0 < 6400 ? 128.f : n0 < 7424 ? 256.f : 128.f; }
constexpr float W8_SCALE = 64.f;
constexpr size_t SZ_WIN = (size_t)NZB * D * 2, SZ_WIN8 = (size_t)NZ8 * D, SZ_WUP = (size_t)D * NY * 2, SZ_WO = (size_t)D * D * 2, SZ_WF = (size_t)DFF * D * 2;
constexpr size_t WS_WIN = 2 * MiB;
constexpr size_t WS_WIN8 = WS_WIN + 2 * SZ_WIN;
constexpr size_t WS_A8 = WS_WIN8 + 2 * SZ_WIN8;
constexpr size_t WS_WUP = WS_A8 + (size_t)M * D;
constexpr size_t WS_WO = WS_WUP + 2 * SZ_WUP;
constexpr size_t WS_WF1 = WS_WO + 2 * SZ_WO;
constexpr size_t WS_WF2 = WS_WF1 + 2 * SZ_WF;
constexpr size_t WS_XB = WS_WF2 + 2 * SZ_WF;
constexpr size_t WS_TA = WS_XB + (size_t)M * D * 2;
constexpr size_t WS_TB = WS_TA + (size_t)M * D * 2;
constexpr size_t WS_Z = WS_TB + (size_t)M * D * 2;
constexpr size_t WS_G = WS_Z + (size_t)M * NZ * 2;
constexpr size_t WS_SC = WS_G + 1 * MiB;
constexpr size_t WS_Y = WS_SC + 1 * MiB;
constexpr size_t WS_MIX = WS_Y + (size_t)M * NY * 2;
constexpr size_t WS_A6 = WS_MIX + (size_t)M * D * 2;
constexpr size_t WS_END = WS_A6 + (size_t)M * D;
static_assert(WS_WIN % 256 == 0 && WS_Z % 256 == 0 && WS_G % 256 == 0 && WS_Y % 256 == 0, "alignment");
constexpr int CW_TMO = 0, CW_BAR = 4096;
constexpr int CW_STAT = 16384, CW_CF1 = CW_STAT + 4 * M * 2 * 2, CW_CIN = CW_CF1 + 2 * 2 * DFF * 2, CW_ZERO = CW_CIN + 2 * NZP * 2, CW_END = CW_ZERO + NZP * 2;
constexpr float FX_S1 = 16777216.f, FX_S2 = 1048576.f, FX_C = 4294967296.f;
static_assert((size_t)CW_END * 4 <= CTL_ZERO_BYTES, "control region");

constexpr int RING_OFF = 0, RING_BYTES = 131072;
constexpr int SCR_BYTES = NWAVES * 64 * 65 * 4;
constexpr int LDSCTL_OFF = 147456, MISC_OFF = LDSCTL_OFF + 320;
constexpr int LDS_BYTES = 151552;
static_assert(SCR_BYTES <= LDSCTL_OFF && MISC_OFF + 128 <= LDS_BYTES, "LDS map");

#define GAS __attribute__((address_space(1)))
#define LAS __attribute__((address_space(3)))
typedef unsigned short bf16;
typedef unsigned v4u __attribute__((ext_vector_type(4)));
typedef unsigned v2u __attribute__((ext_vector_type(2)));
typedef float f32x4 __attribute__((ext_vector_type(4)));
typedef GAS unsigned gu32;
#define RLX_AGENT __ATOMIC_RELAXED, __HIP_MEMORY_SCOPE_AGENT
#define LDS_WAIT() asm volatile("s_waitcnt lgkmcnt(0)" ::: "memory")
#define VM_WAIT() asm volatile("s_waitcnt vmcnt(0)" ::: "memory")
using pg8::cvt_pk_bf16; using pg8::bf_lo; using pg8::bf_hi;

#define XB_TMO      128
#define XB_XCNT(j)  (256  + 64 * (j))
#define XB_XSUB(j)  (1280 + 64 * (j))
#define XB_XGEN(j)  (2304 + 64 * (j))
#define XB_TOP      3328
#define XB_TOPGEN   3392
#define XCD_BAR_WORDS 3456
#define XB_SPIN_CAP (1u << 18)

__device__ __forceinline__ unsigned xb_ld(unsigned* p)              { return __hip_atomic_load(p, __ATOMIC_RELAXED, __HIP_MEMORY_SCOPE_AGENT); }
__device__ __forceinline__ unsigned xb_add(unsigned* p, unsigned v) { return __hip_atomic_fetch_add(p, v, __ATOMIC_RELAXED, __HIP_MEMORY_SCOPE_AGENT); }
__device__ __forceinline__ unsigned xb_xcc_id() { return (unsigned)__builtin_amdgcn_s_getreg((3 << 11) | 20) & 0xFu; }
#define XB_SPIN(cond, bar) do { unsigned _sp = 0; while (cond) { __builtin_amdgcn_s_sleep(1); \
    if ((++_sp & 255u) == 0u) { if (xb_ld(&(bar)[XB_TMO])) break; if (_sp > XB_SPIN_CAP) { atomicAdd(&(bar)[XB_TMO], 1u); break; } } } } while (0)

struct XcdBarrier { unsigned* bar; unsigned x; volatile LAS unsigned* st; int wave; };

__device__ __forceinline__ XcdBarrier xcd_barrier_post(unsigned* bar, volatile LAS unsigned* st) {
    XcdBarrier b; b.bar = bar; b.x = xb_xcc_id(); b.st = st; b.wave = 0;
    if (threadIdx.x == 0) (void)xb_add(&bar[XB_XCNT(b.x)], 1u);
    return b;
}
__device__ __forceinline__ void xcd_barrier_complete(unsigned* bar, unsigned x, unsigned& nloc, unsigned& nx) {
    const unsigned G = gridDim.x * gridDim.y * gridDim.z;
    unsigned sum, cnt, mine, sp = 0u;
    for (;;) {
        sum = 0u; cnt = 0u; mine = 0u;
#pragma unroll
        for (unsigned j = 0; j < 16; ++j) { const unsigned c = xb_ld(&bar[XB_XCNT(j)]); sum += c; cnt += (c > 0u) ? 1u : 0u; mine = (j == x) ? c : mine; }
        if (sum == G) break;
        __builtin_amdgcn_s_sleep(1);
        if ((++sp & 255u) == 0u) { if (xb_ld(&bar[XB_TMO])) break; if (sp > XB_SPIN_CAP) { atomicAdd(&bar[XB_TMO], 1u); break; } }
    }
    nloc = mine > 0u ? mine : 1u; nx = cnt > 0u ? cnt : 1u;
}
__device__ __forceinline__ void xcd_barrier(const XcdBarrier& b) {
    asm volatile("s_waitcnt vmcnt(0)" ::: "memory");
    __syncthreads();
    if (b.wave == 0 && lane_id() == 0) {
        unsigned* bar = b.bar; OPQ_S(bar);
        __builtin_amdgcn_s_waitcnt(0);
        unsigned nloc = b.st[0], nx = b.st[1];
        if (nloc == 0u) { xcd_barrier_complete(bar, b.x, nloc, nx); b.st[0] = nloc; b.st[1] = nx; }
        const unsigned old = xb_add(&bar[XB_XSUB(b.x)], 1u);
        const unsigned gen = old / nloc;
        if (old + 1u == (gen + 1u) * nloc) {
            __builtin_amdgcn_fence(__ATOMIC_RELEASE, "agent");
            asm volatile("s_waitcnt vmcnt(0)" ::: "memory");
            const unsigned og = xb_add(&bar[XB_TOP], 1u);
            const unsigned tg = og / nx;
            if (og + 1u == (tg + 1u) * nx) xb_add(&bar[XB_TOPGEN], 1u);
            else XB_SPIN(xb_ld(&bar[XB_TOPGEN]) == tg, bar);
            __builtin_amdgcn_fence(__ATOMIC_ACQUIRE, "agent");
            xb_add(&bar[XB_XGEN(b.x)], 1u);
            asm volatile("s_waitcnt vmcnt(0)" ::: "memory");
        } else {
            XB_SPIN(xb_ld(&bar[XB_XGEN(b.x)]) == gen, bar);
            __builtin_amdgcn_fence(__ATOMIC_ACQUIRE, "agent");
            asm volatile("s_waitcnt vmcnt(0)" ::: "memory");
        }
    }
    __syncthreads();
}

struct Frame {
    LAS unsigned char* lds;
    volatile LAS unsigned* MISC;
    gu32* ctl;
    int wave;
    int vcu, G;
};

__device__ __forceinline__ float lane_get(float v, int src_lane) { return __int_as_float(__builtin_amdgcn_ds_bpermute(src_lane << 2, __float_as_int(v))); }
__device__ __forceinline__ float wave_sum(float v, int lane) {
#pragma unroll
    for (int o = 1; o < 64; o <<= 1) v += lane_get(v, lane ^ o);
    return v;
}
__device__ __forceinline__ float wave_max(float v, int lane) {
#pragma unroll
    for (int o = 1; o < 64; o <<= 1) v = fmaxf(v, lane_get(v, lane ^ o));
    return v;
}

__device__ __forceinline__ float rbf(float x) { return bf_lo(cvt_pk_bf16(x, x)); }
__device__ __forceinline__ void tr_item(const float* __restrict__ W, int ldw, int k0, int srccol, bf16* __restrict__ WT, size_t ldt, int n0, int kdst, float scale, LAS float* scr, int lane,
                                        const float* __restrict__ gk, const float* __restrict__ bk, pg8::fx64* c1, pg8::fx64* c2, unsigned char* __restrict__ WT8 = nullptr, bool fp6 = false, float wsc = W8_SCALE) {
    const int i = lane & 15, kr = lane >> 4;
    f32x4 a1 = (f32x4){0.f, 0.f, 0.f, 0.f}, a2 = a1; const float c1s = WT8 ? 1.f / wsc : 1.f;
    if (srccol >= 0) {
        f32x4 v[16];
#pragma unroll
        for (int r = 0; r < 16; ++r) v[r] = __builtin_nontemporal_load((const f32x4*)(W + (size_t)(k0 + 4 * r + kr) * ldw + srccol + 4 * i));
#pragma unroll
        for (int r = 0; r < 16; ++r) { LAS float* s = scr + (4 * r + kr) * 65 + 4 * i; float gs = scale, bs = 0.f;
            if (gk) { gs *= gk[k0 + 4 * r + kr]; bs = bk[k0 + 4 * r + kr] * scale; }
#pragma unroll
            for (int j = 0; j < 4; ++j) { const float w = WT8 ? (fp6 ? v_e2m3(v[r][j] * gs) : __builtin_amdgcn_cvt_f32_fp8(__builtin_amdgcn_cvt_pk_fp8_f32(__builtin_amdgcn_fmed3f(v[r][j] * gs, -448.f, 448.f), 0.f, 0, false), 0)) : rbf(v[r][j] * gs); s[j] = w; a1[j] += w; a2[j] += v[r][j] * bs; } }
    } else {
#pragma unroll
        for (int r = 0; r < 16; ++r) { LAS float* s = scr + (4 * r + kr) * 65 + 4 * i; float gs = scale, bs = 0.f;
            if (gk) { gs *= gk[k0 + 4 * r + kr]; bs = bk[k0 + 4 * r + kr] * scale; }
#pragma unroll
            for (int j = 0; j < 4; ++j) { const int cc = 4 * i + j; float val = 0.f;
                if (srccol == -2 && cc < 24) { const int sc = cc < 16 ? 3328 + cc : 7440 + (cc - 16); val = W[(size_t)(k0 + 4 * r + kr) * ldw + sc]; }
                const float w = rbf(val * gs); s[j] = w; a1[j] += w; a2[j] += val * bs; } }
    }
    if (gk) {
#pragma unroll
        for (int j = 0; j < 4; ++j) { a1[j] += lane_get(a1[j], lane ^ 16); a2[j] += lane_get(a2[j], lane ^ 16); a1[j] += lane_get(a1[j], lane ^ 32); a2[j] += lane_get(a2[j], lane ^ 32); }
        if (kr == 0) {
#pragma unroll
            for (int j = 0; j < 4; ++j) { pg8::fx_add(c1 + n0 + 4 * i + j, a1[j] * c1s, FX_C); pg8::fx_add(c2 + n0 + 4 * i + j, a2[j] * c1s, FX_C); } }
    }
    LDS_WAIT(); asm volatile("" ::: "memory");
    if (WT8) {
        const int c = lane & 3, nn = lane >> 2;
#pragma unroll
        for (int jj = 0; jj < 4; ++jj) { const int n = nn + 16 * jj; const LAS float* s = scr + (16 * c) * 65 + n; v4u o;
            if (fp6) { unsigned cd[16];
#pragma unroll
                for (int e = 0; e < 16; ++e) cd[e] = q_e2m3(s[e * 65]);
                store_e2m3_group(e2m3_ktile(WT8, n0 + n, k0 >> 7, true), ((k0 & 64) >> 4) + c, pack16_e2m3(cd)); continue; }
#pragma unroll
            for (int d = 0; d < 4; ++d) { int p = __builtin_amdgcn_cvt_pk_fp8_f32(s[(4 * d) * 65], s[(4 * d + 1) * 65], 0, false); p = __builtin_amdgcn_cvt_pk_fp8_f32(s[(4 * d + 2) * 65], s[(4 * d + 3) * 65], p, true); o[d] = (unsigned)p; }
            __builtin_nontemporal_store(o, (v4u*)(WT8 + (size_t)(n0 + n) * ldt + kdst + k0 + 16 * c)); }
        LDS_WAIT(); asm volatile("" ::: "memory");
        return;
    }
    const int c = lane & 7, nn = lane >> 3;
#pragma unroll
    for (int jj = 0; jj < 8; ++jj) { const int n = nn + 8 * jj; const LAS float* s = scr + (8 * c) * 65 + n;
        v4u o; o.x = cvt_pk_bf16(s[0 * 65], s[1 * 65]); o.y = cvt_pk_bf16(s[2 * 65], s[3 * 65]); o.z = cvt_pk_bf16(s[4 * 65], s[5 * 65]); o.w = cvt_pk_bf16(s[6 * 65], s[7 * 65]);
        __builtin_nontemporal_store(o, (v4u*)(WT + (size_t)(n0 + n) * ldt + kdst + k0 + 8 * c)); }
    LDS_WAIT(); asm volatile("" ::: "memory");
}

struct Args {
    const float* in[16]; float* out; unsigned char* ws; int ph_lo, ph_hi;
};
typedef const __attribute__((address_space(4))) Args* KArgs;

constexpr int I_IN = (D / 64) * (NZP / 64), I_UP = (1024 / 64) * (D / 64), I_O = (D / 64) * (D / 64), I_F1 = (D / 64) * (DFF / 64), I_F2 = (DFF / 64) * (D / 64);
constexpr int I_LAYER = I_IN + 3 * I_UP + I_O + I_F1 + I_F2;
__device__ __forceinline__ void conv_item(KArgs A, int it, LAS float* scr, int lane) {
    const int l = it / I_LAYER; int r = it - l * I_LAYER;
    if (r < I_IN) {
        constexpr int NB = NZP / 64; const int kb = r / NB, nb = r - kb * NB, n0 = nb * 64;
        int srccol; float scale = 1.f;
        if (n0 < 3328) { srccol = n0; if (n0 < 1024) scale = 0.125f * LOG2E; else if (n0 >= ZC_MK && n0 < ZC_MV) scale = 0.125f; }
        else if (n0 < 7424) { srccol = n0 + 16; if (n0 >= ZC_CQ && n0 < ZC_CK) scale = 0.08838834764831845f * LOG2E; }
        else if (n0 < NZ) srccol = n0 + 24;
        else if (n0 == NZ) srccol = -2;
        else srccol = -1;
        pg8::fx64* cf = (pg8::fx64*)((unsigned*)(A->ws + WS_CTL) + CW_CIN);
        if (z_is_fp8(n0)) {
            const int nd = z_row(n0); const float wsc = w6_scale(n0);
            tr_item(A->in[1] + (size_t)l * D * DIN, DIN, kb * 64, srccol, nullptr, D, nd, 0, scale * wsc, scr, lane,
                    l ? A->in[14] : nullptr, l ? A->in[15] : nullptr, cf + (n0 - nd), cf + NZP + (n0 - nd), A->ws + WS_WIN8 + l * SZ_WIN8, true, wsc);
        } else {
            const int nd = z_row(n0);
            tr_item(A->in[1] + (size_t)l * D * DIN, DIN, kb * 64, srccol, (bf16*)(A->ws + WS_WIN + l * SZ_WIN), D, nd, 0, scale, scr, lane,
                    l ? A->in[14] : nullptr, l ? A->in[15] : nullptr, cf + (n0 - nd), cf + NZP + (n0 - nd));
        }
        return;
    }
    r -= I_IN;
    if (r < 3 * I_UP) { const int br = r / I_UP; r -= br * I_UP; constexpr int NB = D / 64; const int kb = r / NB, nb = r - kb * NB;
        tr_item(A->in[6 + br] + (size_t)l * 1024 * D, D, kb * 64, nb * 64, nullptr, NY, nb * 64, br * 1024, W8_SCALE, scr, lane, nullptr, nullptr, nullptr, nullptr, A->ws + WS_WUP + l * SZ_WUP);
        return; }
    r -= 3 * I_UP;
    if (r < I_O) { constexpr int NB = D / 64; const int kb = r / NB, nb = r - kb * NB;
        tr_item(A->in[9] + (size_t)l * D * D, D, kb * 64, nb * 64, nullptr, D, nb * 64, 0, 128.f, scr, lane, nullptr, nullptr, nullptr, nullptr, A->ws + WS_WO + l * SZ_WO);
        return; }
    r -= I_O;
    if (r < I_F1) { constexpr int NB = DFF / 64; const int kb = r / NB, nb = r - kb * NB;
        pg8::fx64* cf = (pg8::fx64*)((unsigned*)(A->ws + WS_CTL) + CW_CF1) + l * 2 * DFF;
        tr_item(A->in[12] + (size_t)l * D * DFF, DFF, kb * 64, nb * 64, (bf16*)(A->ws + WS_WF1 + l * SZ_WF), D, nb * 64, 0, 1.f, scr, lane, A->in[10] + l * D, A->in[11] + l * D, cf, cf + DFF);
        return; }
    r -= I_F1;
    { constexpr int NB = D / 64; const int kb = r / NB, nb = r - kb * NB;
        tr_item(A->in[13] + (size_t)l * DFF * D, D, kb * 64, nb * 64, (bf16*)(A->ws + WS_WF2 + l * SZ_WF), DFF, nb * 64, 0, 1.f, scr, lane, nullptr, nullptr, nullptr, nullptr); }
}
__device__ __forceinline__ void p0_prologue(Frame& F, KArgs A_) {
    KArgs A = A_; OPQ_S(A);
    int tid = F.wave * 64 + lane_id(); OPQ_V(tid); const int lane = tid & 63;
    LAS float* scr = (LAS float*)(F.lds) + F.wave * (64 * 65);
    const int gw = F.vcu * NWAVES + F.wave, NGW = F.G * NWAVES;
#if defined(MIX_NAIVE)
    for (int it = gw; it < DEPTH * I_LAYER; it += NGW) conv_item(A, it, scr, lane);
#else
    for (int it = gw; it < I_IN; it += NGW) conv_item(A, it, scr, lane);
#endif
    const f32x4* xs = (const f32x4*)A->in[0];
    {
        const size_t n16 = (size_t)M * D / 16, st = (size_t)F.G * 512; size_t i = (size_t)(F.vcu * 512 + tid);
        v4u* xb2 = (v4u*)(A->ws + WS_XB); v4u* x6 = (v4u*)(A->ws + WS_A6);
#define X_CHUNK(ci, q0, q1, q2, q3) do { const f32x4 q_[4] = {q0, q1, q2, q3}; v4u o0, o1, o6; unsigned cd[16]; \
            o0.x = cvt_pk_bf16(q_[0][0], q_[0][1]); o0.y = cvt_pk_bf16(q_[0][2], q_[0][3]); o0.z = cvt_pk_bf16(q_[1][0], q_[1][1]); o0.w = cvt_pk_bf16(q_[1][2], q_[1][3]); \
            o1.x = cvt_pk_bf16(q_[2][0], q_[2][1]); o1.y = cvt_pk_bf16(q_[2][2], q_[2][3]); o1.z = cvt_pk_bf16(q_[3][0], q_[3][1]); o1.w = cvt_pk_bf16(q_[3][2], q_[3][3]); \
                        _Pragma("unroll") for (int e_ = 0; e_ < 16; ++e_) cd[e_] = q_e2m3(q_[e_ >> 2][e_ & 3] * pg8::A6_SCALE); \
            o6 = pack16_e2m3(cd); \
            xb2[2 * (ci)] = o0; xb2[2 * (ci) + 1] = o1; store_e2m3_group(e2m3_ktile((unsigned char*)x6, (int)((ci) >> 8), (int)(((ci) >> 3) & 31), false), (int)((ci) & 7), o6); } while (0)
#pragma unroll 1
        for (; i + st < n16; i += 2 * st) {
            f32x4 v[2][4];
#pragma unroll
            for (int u = 0; u < 2; ++u)
#pragma unroll
                for (int q = 0; q < 4; ++q) v[u][q] = __builtin_nontemporal_load(xs + (i + u * st) * 4 + q);
#pragma unroll
            for (int u = 0; u < 2; ++u) X_CHUNK(i + u * st, v[u][0], v[u][1], v[u][2], v[u][3]);
        }
#pragma unroll 1
        for (; i < n16; i += st) { const f32x4 v0 = xs[i * 4], v1 = xs[i * 4 + 1], v2 = xs[i * 4 + 2], v3 = xs[i * 4 + 3]; X_CHUNK(i, v0, v1, v2, v3); }
#undef X_CHUNK
    }
}

__device__ __forceinline__ void lnout_phase(Frame& F, const bf16* __restrict__ T, const pg8::fx64* __restrict__ st, const float* __restrict__ g, const float* __restrict__ b, float* __restrict__ xo) {
    int lane = lane_id(); OPQ_V(lane); int gw = F.vcu * NWAVES + F.wave; OPQ_S(gw); const int NGW = F.G * NWAVES;
    for (int row = gw; row < M; row += NGW) {
        const float s1 = (float)st[2 * (size_t)row] * (1.f / FX_S1), s2 = (float)st[2 * (size_t)row + 1] * (1.f / FX_S2);
        const float mean = s1 * (1.f / D), rstd = __builtin_amdgcn_rsqf(fmaxf(s2 * (1.f / D) - mean * mean, 0.f) + LN_EPS), rm = rstd * mean;
        const v4u* tr = (const v4u*)(T + (size_t)row * D) + lane;
#pragma unroll 2
        for (int j = 0; j < 8; ++j) { const int c0 = 8 * (lane + 64 * j); const v4u w = tr[64 * j];
            const f32x4 g0 = *(const f32x4*)(g + c0), g1 = *(const f32x4*)(g + c0 + 4), b0 = *(const f32x4*)(b + c0), b1 = *(const f32x4*)(b + c0 + 4);
            *(f32x4*)(xo + (size_t)row * D + c0) = ((f32x4){bf_lo(w.x), bf_hi(w.x), bf_lo(w.y), bf_hi(w.y)} * rstd - rm) * g0 + b0;
            *(f32x4*)(xo + (size_t)row * D + c0 + 4) = ((f32x4){bf_lo(w.z), bf_hi(w.z), bf_lo(w.w), bf_hi(w.w)} * rstd - rm) * g1 + b1; }
    }
}

__device__ __forceinline__ float log_sigmoid(float x) { return fminf(x, 0.f) - log1pf(expf(-fabsf(x))); }
__device__ __forceinline__ void scan_phase(Frame& F, KArgs A_, int l) {
    KArgs A = A_; OPQ_S(A);
    int lane = lane_id(); OPQ_V(lane); int gw = F.vcu * NWAVES + F.wave; OPQ_S(gw); const int NGW = F.G * NWAVES;
    const float* G = (const float*)(A->ws + WS_G); float* SC = (float*)(A->ws + WS_SC);
    for (int it = gw; it < 64; it += NGW) {
        const int fox = it >> 5, bh = it & 31, b = bh >> 3, h = bh & 7;
        const float* fp = G + (size_t)((fox ? 16 : 8) + h) * M + b * SEQ + 32 * lane;
        const float bf = fox ? A->in[4][l * 8 + h] : A->in[3][l * 8 + h];
        float Fv[32]; float run = 0.f;
#pragma unroll
        for (int j = 0; j < 32; ++j) { run += log_sigmoid(fp[j] + bf); Fv[j] = run; }
        float inc = run;
#pragma unroll
        for (int o = 1; o < 64; o <<= 1) { const float t = lane_get(inc, lane - o); if (lane >= o) inc += t; }
        const float excl = inc - run;
        const size_t ob = (size_t)bh * SEQ + 32 * lane;
        if (fox) {
#pragma unroll
            for (int j = 0; j < 32; ++j) SC[ob + j] = -(Fv[j] + excl) * LOG2E;
        } else {
            const float* ip = G + (size_t)h * M + b * SEQ + 32 * lane; const float bi = A->in[2][l * 8 + h];
            float av[32]; float rm = -3.0e38f;
#pragma unroll
            for (int j = 0; j < 32; ++j) { Fv[j] += excl; av[j] = (ip[j] + bi) - Fv[j]; rm = fmaxf(rm, av[j]); }
            float incm = rm;
#pragma unroll
            for (int o = 1; o < 64; o <<= 1) { const float t = lane_get(incm, lane - o); if (lane >= o) incm = fmaxf(incm, t); }
            float pre = lane_get(incm, lane - 1); if (lane == 0) pre = 0.f; pre = fmaxf(pre, 0.f);
            float rr = pre;
#pragma unroll
            for (int j = 0; j < 32; ++j) { rr = fmaxf(rr, av[j]); SC[(size_t)32 * SEQ + ob + j] = av[j] * LOG2E; SC[(size_t)64 * SEQ + ob + j] = rr * LOG2E; SC[(size_t)96 * SEQ + ob + j] = expf(-(Fv[j] + rr)); }
        }
    }
}

#if defined(MIX_NAIVE)
__device__ __forceinline__ float dot8(const v4u a, const v4u b) {
    return bf_lo(a.x) * bf_lo(b.x) + bf_hi(a.x) * bf_hi(b.x) + bf_lo(a.y) * bf_lo(b.y) + bf_hi(a.y) * bf_hi(b.y) + bf_lo(a.z) * bf_lo(b.z) + bf_hi(a.z) * bf_hi(b.z) + bf_lo(a.w) * bf_lo(b.w) + bf_hi(a.w) * bf_hi(b.w);
}
__device__ __forceinline__ void mixers_naive(Frame& F, KArgs A_, int l) {
    KArgs A = A_; OPQ_S(A);
    int lane = lane_id(); OPQ_V(lane); int gw = F.vcu * NWAVES + F.wave; OPQ_S(gw); const int NGW = F.G * NWAVES;
    const bf16* Z = (const bf16*)(A->ws + WS_Z); bf16* Y = (bf16*)(A->ws + WS_Y); const float* SC = (const float*)(A->ws + WS_SC);
    LAS float* sbuf = (LAS float*)(F.lds) + F.wave * 2048;
    for (int it = gw; it < M * 16; it += NGW) {
        const int hq = it & 15, row = it >> 4, t = row & (SEQ - 1), kvh = hq >> 3;
        const v4u* qp = (const v4u*)(Z + (size_t)row * NZ + ZC_AQ + hq * 64);
        v4u qv[8];
#pragma unroll
        for (int c = 0; c < 8; ++c) qv[c] = qp[c];
        const float slope = exp2f(-0.5f * (float)(hq + 1)) * LOG2E, sink = A->in[5][l * 16 + hq] * LOG2E;
        float sc[2];
#pragma unroll
        for (int kk = 0; kk < 2; ++kk) { const int s = t - 127 + lane + 64 * kk; float d = -__builtin_inff();
            if (s >= 0) { const v4u* kp = (const v4u*)(Z + (size_t)(row - t + s) * NZ + ZC_AK + kvh * 64); float a = 0.f;
#pragma unroll
                for (int c = 0; c < 8; ++c) a += dot8(qv[c], kp[c]);
                d = a - slope * (float)(t - s); }
            sc[kk] = d; }
        const float mx = fmaxf(wave_max(fmaxf(sc[0], sc[1]), lane), sink);
        const float p0 = __builtin_amdgcn_exp2f(sc[0] - mx), p1 = __builtin_amdgcn_exp2f(sc[1] - mx);
        const float den = wave_sum(p0 + p1, lane) + __builtin_amdgcn_exp2f(sink - mx);
        float acc = 0.f;
#pragma unroll
        for (int kk = 0; kk < 2; ++kk) { const float pk = kk ? p1 : p0;
#pragma unroll 8
            for (int j = 0; j < 64; ++j) { const int s = t - 127 + j + 64 * kk; const float pj = lane_get(pk, j);
                if (s >= 0) acc += pj * __uint_as_float((unsigned)Z[(size_t)(row - t + s) * NZ + ZC_AV + kvh * 64 + lane] << 16); } }
        const float o = acc / den; const unsigned ob = cvt_pk_bf16(o, o);
        Y[(size_t)row * NY + hq * 64 + lane] = (bf16)(ob & 0xffffu);
    }
    for (int it = gw; it < 2 * 32 * SEQ; it += NGW) {
        const int fox = it >= 32 * SEQ; const int i2 = fox ? it - 32 * SEQ : it; const int bh = i2 & 31, t = i2 >> 5, b = bh >> 3, h = bh & 7;
        const size_t row = (size_t)b * SEQ + t; const int nkb = (t >> 6) + 1;
        const int qc = fox ? ZC_CQ + h * 128 : ZC_MQ + h * 64, kc = fox ? ZC_CK + h * 128 : ZC_MK + h * 64, vc = fox ? ZC_CV + h * 128 : ZC_MV + h * 128;
        const int nch = fox ? 16 : 8;
        const v4u* qp = (const v4u*)(Z + row * NZ + qc);
        v4u qv[16];
#pragma unroll
        for (int c = 0; c < 16; ++c) qv[c] = (c < nch) ? qp[c] : (v4u){0u, 0u, 0u, 0u};
        const float* bias = SC + (size_t)(fox ? 0 : 32) * SEQ + (size_t)bh * SEQ;
        const float RL = fox ? 0.f : SC[(size_t)64 * SEQ + (size_t)bh * SEQ + t];
        float mx = -__builtin_inff();
        for (int kb = 0; kb < nkb; ++kb) { const int s = kb * 64 + lane; float val = fox ? -__builtin_inff() : 0.f;
            if (s <= t) { const v4u* kp = (const v4u*)(Z + ((size_t)b * SEQ + s) * NZ + kc); float a = 0.f;
#pragma unroll
                for (int c = 0; c < 16; ++c) if (c < nch) a += dot8(qv[c], kp[c]);
                val = fox ? a + bias[s] : a * __builtin_amdgcn_exp2f(bias[s] - RL); }
            sbuf[s] = val; mx = fmaxf(mx, val); }
        float den;
        if (fox) { mx = wave_max(mx, lane); float sum = 0.f;
            for (int kb = 0; kb < nkb; ++kb) { const int s = kb * 64 + lane; const float p = __builtin_amdgcn_exp2f(sbuf[s] - mx); sbuf[s] = p; sum += p; }
            den = wave_sum(sum, lane);
        } else { float sum = 0.f;
            for (int kb = 0; kb < nkb; ++kb) sum += sbuf[kb * 64 + lane];
            den = wave_sum(sum, lane); den = fmaxf(fabsf(den), SC[(size_t)96 * SEQ + (size_t)bh * SEQ + t]); }
        LDS_WAIT(); asm volatile("" ::: "memory");
        float a0 = 0.f, a1 = 0.f;
        const bf16* vp = Z + ((size_t)b * SEQ) * NZ + vc + 2 * lane;
#pragma unroll 8
        for (int s = 0; s <= t; ++s) { const float p = sbuf[s]; const unsigned w = *(const unsigned*)(vp + (size_t)s * NZ); a0 += p * bf_lo(w); a1 += p * bf_hi(w); }
        a0 /= den; a1 /= den;
        if (!fox) { const unsigned w = *(const unsigned*)(Z + row * NZ + ZC_MO + h * 128 + 2 * lane);
            a0 *= 1.f / (1.f + expf(-bf_lo(w))); a1 *= 1.f / (1.f + expf(-bf_hi(w))); }
        *(unsigned*)(Y + row * NY + (fox ? 2048 : 1024) + h * 128 + 2 * lane) = cvt_pk_bf16(a0, a1);
        LDS_WAIT(); asm volatile("" ::: "memory");
    }
}


#endif
typedef float f32x16 __attribute__((ext_vector_type(16)));
typedef short s16x8 __attribute__((ext_vector_type(8)));
typedef short s16x4 __attribute__((ext_vector_type(4)));
constexpr int MX_KB0 = 0, MX_KB1 = 64 * 272, MX_VB0 = 2 * 64 * 272, MX_VB1 = MX_VB0 + 64 * 320, MX_QW = MX_VB1 + 64 * 320;
constexpr int MX_SC_A = 77824, MX_SC_R = MX_SC_A + 8192, MX_SC_E = MX_SC_R + 1024, MX_SC_W = MX_SC_E + 1024;
static_assert(MX_QW <= MX_SC_A && MX_SC_W + 64 <= RING_BYTES, "mixer LDS");
static_assert(16.f * 128.f == 2048.f && W8_SCALE == 64.f && NZB == 10 * 256 && NZ8 == 68 * 256, "EpiRes::ascale == 1 / (MIX8_SCALE * WO8_SCALE); EpiZ constants");
constexpr float Y8_SCALE = 8.f, MIX8_SCALE = 16.f, WO8_SCALE = 128.f;
constexpr float MX_THR = 8.f;
__device__ __forceinline__ float swap32_max(float v) { auto rr = __builtin_amdgcn_permlane32_swap(__float_as_uint(v), __float_as_uint(v), false, false); return fmaxf(__uint_as_float(rr[0]), __uint_as_float(rr[1])); }
__device__ __forceinline__ float swap32_add(float v) { auto rr = __builtin_amdgcn_permlane32_swap(__float_as_uint(v), __float_as_uint(v), false, false); return __uint_as_float(rr[0]) + __uint_as_float(rr[1]); }
__device__ __forceinline__ s16x4 vtr(const LAS unsigned char* p) { return __builtin_bit_cast(s16x4, __builtin_amdgcn_ds_read_tr16_b64_v4i16((LAS s16x4*)p)); }

template <int MODE>
__device__ __forceinline__ void mixer_scan(LAS unsigned char* lds, const float* __restrict__ G, float bias_f, float bias_i, int b, int h, int qb, int wave, int lane) {
    LAS float* key = (LAS float*)(lds + MX_SC_A); LAS float* rl = (LAS float*)(lds + MX_SC_R); LAS float* em = (LAS float*)(lds + MX_SC_E); LAS float* wt = (LAS float*)(lds + MX_SC_W);
    const int tid = wave * 64 + lane, s0 = 4 * tid, nk = 256 * (qb + 1); const bool act = s0 < nk;
    f32x4 fv = (f32x4){0.f, 0.f, 0.f, 0.f}, iv = fv;
    if (act) { fv = *(const f32x4*)(G + (size_t)((MODE == 2 ? 16 : 8) + h) * M + (size_t)b * SEQ + s0); if (MODE == 1) iv = *(const f32x4*)(G + (size_t)h * M + (size_t)b * SEQ + s0); }
    float Fv[4]; float run = 0.f;
#pragma unroll
    for (int j = 0; j < 4; ++j) { run += act ? log_sigmoid(fv[j] + bias_f) : 0.f; Fv[j] = run; }
    float inc = run;
#pragma unroll
    for (int o = 1; o < 64; o <<= 1) { const float t = lane_get(inc, lane - o); if (lane >= o) inc += t; }
    if (lane == 63) wt[wave] = inc;
    __syncthreads();
    float off = inc - run;
#pragma unroll
    for (int w = 0; w < NWAVES; ++w) if (w < wave) off += wt[w];
    if (MODE == 2) {
        if (act) *(LAS f32x4*)(key + s0) = (f32x4){-(Fv[0] + off) * LOG2E, -(Fv[1] + off) * LOG2E, -(Fv[2] + off) * LOG2E, -(Fv[3] + off) * LOG2E};
    } else {
        float av[4], mv[4]; float rm = -3.0e38f;
#pragma unroll
        for (int j = 0; j < 4; ++j) { Fv[j] += off; av[j] = act ? (iv[j] + bias_i) - Fv[j] : -3.0e38f; rm = fmaxf(rm, av[j]); mv[j] = rm; }
        float incm = rm;
#pragma unroll
        for (int o = 1; o < 64; o <<= 1) { const float t = lane_get(incm, lane - o); if (lane >= o) incm = fmaxf(incm, t); }
        if (lane == 63) wt[8 + wave] = incm;
        float pre = lane_get(incm, lane - 1); if (lane == 0) pre = 0.f;
        __syncthreads();
        pre = fmaxf(pre, 0.f);
#pragma unroll
        for (int w = 0; w < NWAVES; ++w) if (w < wave) pre = fmaxf(pre, wt[8 + w]);
        if (act) { *(LAS f32x4*)(key + s0) = (f32x4){av[0] * LOG2E, av[1] * LOG2E, av[2] * LOG2E, av[3] * LOG2E};
            const int r0 = s0 - 256 * qb;
            if (r0 >= 0) {
#pragma unroll
                for (int j = 0; j < 4; ++j) { const float R = fmaxf(pre, mv[j]); rl[r0 + j] = R * LOG2E; em[r0 + j] = expf(-(Fv[j] + R)); } } }
    }
    __syncthreads();
}

template <int MODE>
__device__ __forceinline__ void mixer_unit(LAS unsigned char* lds, const bf16* __restrict__ Z, bf16* __restrict__ Y, const float* __restrict__ G, float gb_f, float gb_i, float sink_l2, int b, int h, int qb, int wave, int lane) {
    constexpr int DQK = (MODE == 2) ? 128 : 64, DV = (MODE == 0) ? 64 : 128;
    constexpr int KP = DQK * 2 + 16, VP = (DV == 128) ? 320 : 192;
    constexpr int NKD = DQK / 16, NDB = DV / 32, KCH = DQK / 8, VCH = DV / 8, KLD = 64 * KCH / 512, VLD = 64 * VCH / 512;
    const int c = lane & 31, hi = lane >> 5, tid = wave * 64 + lane;
    const int qc = (MODE == 0) ? ZC_AQ + h * 64 : (MODE == 1) ? ZC_MQ + h * 64 : ZC_CQ + h * 128;
    const int kc = (MODE == 0) ? ZC_AK + (h >> 3) * 64 : (MODE == 1) ? ZC_MK + h * 64 : ZC_CK + h * 128;
    const int vc = (MODE == 0) ? ZC_AV + (h >> 3) * 64 : (MODE == 1) ? ZC_MV + h * 128 : ZC_CV + h * 128;
    const int yc = (MODE == 0) ? h * 64 : (MODE == 1) ? 1024 + h * 128 : 2048 + h * 128;
    const size_t rowb = (size_t)b * SEQ;
    const int q0w = 256 * qb + 32 * wave, qabs = q0w + c;
    const int j_lo = (MODE == 0) ? (qb > 0 ? 4 * qb - 2 : 0) : 0, j_hi = 4 * qb + 4;
    if (MODE != 0) mixer_scan<MODE>(lds, G, gb_f, gb_i, b, h, qb, wave, lane);
    const LAS float* bias = (const LAS float*)(lds + MX_SC_A);
    s16x8 qf[NKD];
    { const bf16* qp = Z + (rowb + qabs) * NZ + qc + 8 * hi;
#pragma unroll
      for (int kd = 0; kd < NKD; ++kd) qf[kd] = *(const s16x8*)(qp + 16 * kd); }
    f32x16 O[NDB];
#pragma unroll
    for (int db = 0; db < NDB; ++db)
#pragma unroll
        for (int r = 0; r < 16; ++r) O[db][r] = 0.f;
    float m = (MODE == 0) ? sink_l2 : -1.0e30f, lsum = (MODE == 0 && hi == 0) ? 1.f : 0.f;
    const float RL = (MODE == 1) ? ((const LAS float*)(lds + MX_SC_R))[32 * wave + c] : 0.f;
    const float slope = (MODE == 0) ? exp2f(-0.5f * (float)(h + 1)) * LOG2E : 0.f;
    v4u kr0[KLD], vr0[VLD], kr1[KLD], vr1[VLD];
#define MX_LOADG(KR, VR, j) do { _Pragma("unroll") for (int i_ = 0; i_ < KLD; ++i_) { const int cid = tid + 512 * i_, row = cid / KCH, cc = cid % KCH; KR[i_] = *(const v4u*)(Z + (rowb + 64 * (j) + row) * NZ + kc + 8 * cc); } \
        _Pragma("unroll") for (int i_ = 0; i_ < VLD; ++i_) { const int cid = tid + 512 * i_, row = cid / VCH, cc = cid % VCH; VR[i_] = *(const v4u*)(Z + (rowb + 64 * (j) + row) * NZ + vc + 8 * cc); } } while (0)
#define MX_STORE(KR, VR, bufi) do { _Pragma("unroll") for (int i_ = 0; i_ < KLD; ++i_) { const int cid = tid + 512 * i_, row = cid / KCH, cc = cid % KCH; *(LAS v4u*)(lds + ((bufi) ? MX_KB1 : MX_KB0) + row * KP + 16 * cc) = KR[i_]; } \
        _Pragma("unroll") for (int i_ = 0; i_ < VLD; ++i_) { const int cid = tid + 512 * i_, row = cid / VCH, cc = cid % VCH; *(LAS v4u*)(lds + ((bufi) ? MX_VB1 : MX_VB0) + row * VP + 16 * cc) = VR[i_]; } } while (0)
    MX_LOADG(kr1, vr1, j_lo); MX_STORE(kr1, vr1, 0);
    MX_LOADG(kr1, vr1, j_lo + 1);
    __syncthreads();
#pragma unroll
    for (int kd = 0; kd < NKD; ++kd) asm volatile("" : "+v"(qf[kd]));
    const int kbase = c * KP + 16 * hi;
    const int vbase = (4 * hi + ((lane & 15) >> 2)) * VP + (16 * ((lane >> 4) & 1) + 4 * (lane & 3)) * 2;
    auto step = [&](const int j, v4u (&ka)[KLD], v4u (&va)[VLD], v4u (&kb_)[KLD], v4u (&vb_)[VLD]) __attribute__((always_inline)) {
        const int cur = (j - j_lo) & 1;
        { const int jn = (j + 2 < j_hi) ? j + 2 : j_hi - 1; MX_LOADG(ka, va, jn); }
        bool active = 64 * j <= q0w + 31;
        if (MODE == 0) active = active && (64 * j + 63 >= q0w - 127);
        if (active) {
            const LAS unsigned char* Kb = lds + (cur ? MX_KB1 : MX_KB0) + kbase;
            const LAS unsigned char* Vb = lds + (cur ? MX_VB1 : MX_VB0) + vbase;
            f32x16 p[2];
#pragma unroll
            for (int kb = 0; kb < 2; ++kb) {
#pragma unroll
                for (int r = 0; r < 16; ++r) p[kb][r] = 0.f;
                { s16x8 kf[NKD];
#pragma unroll
                  for (int kd = 0; kd < NKD; ++kd) kf[kd] = *(const LAS s16x8*)(Kb + (32 * kb) * KP + 32 * kd);
                  __builtin_amdgcn_sched_barrier(0);
#pragma unroll
                  for (int kd = 0; kd < NKD; ++kd) p[kb] = __builtin_amdgcn_mfma_f32_32x32x16_bf16(kf[kd], qf[kd], p[kb], 0, 0, 0); }
            }
            const bool need_mask = (64 * j + 63 > q0w) || (MODE == 0 && 64 * j < q0w + 31 - 127);
            const int krel = qabs - 64 * j - 4 * hi;
            float den_t = 0.f;
            if (MODE == 1) {
#pragma unroll
                for (int kb = 0; kb < 2; ++kb) { const LAS float* bp = bias + 64 * j + 32 * kb + 4 * hi;
#pragma unroll
                    for (int g = 0; g < 4; ++g) { const f32x4 a4 = *(const LAS f32x4*)(bp + 8 * g);
#pragma unroll
                        for (int e = 0; e < 4; ++e) { const int r = 4 * g + e; float v = p[kb][r] * __builtin_amdgcn_exp2f(a4[e] - RL);
                            if (need_mask && (32 * kb + 8 * g + e) > krel) v = 0.f;
                            den_t += v; p[kb][r] = v; } } }
                lsum += den_t;
            } else {
                float tmax = -__builtin_inff();
#pragma unroll
                for (int kb = 0; kb < 2; ++kb) {
                    f32x4 b4[4];
                    if (MODE == 2) { const LAS float* bp = bias + 64 * j + 32 * kb + 4 * hi;
#pragma unroll
                        for (int g = 0; g < 4; ++g) b4[g] = *(const LAS f32x4*)(bp + 8 * g); }
#pragma unroll
                    for (int r = 0; r < 16; ++r) { const int ko = 32 * kb + 8 * (r >> 2) + (r & 3);
                        float s = p[kb][r];
                        if (MODE == 2) { s += b4[r >> 2][r & 3]; if (need_mask && ko > krel) s = -__builtin_inff(); }
                        else { const int dist = krel - ko; s -= slope * (float)dist; if (need_mask && (unsigned)dist >= 128u) s = -__builtin_inff(); }
                        p[kb][r] = s; tmax = fmaxf(tmax, s); }
                }
                tmax = swap32_max(tmax);
                if (!__all(tmax <= m + MX_THR)) {
                    const float mn = fmaxf(m, tmax), alpha = __builtin_amdgcn_exp2f(m - mn); m = mn; lsum *= alpha;
#pragma unroll
                    for (int db = 0; db < NDB; ++db)
#pragma unroll
                        for (int r = 0; r < 16; ++r) O[db][r] *= alpha;
                }
#pragma unroll
                for (int kb = 0; kb < 2; ++kb)
#pragma unroll
                    for (int r = 0; r < 16; ++r) { const float e = __builtin_amdgcn_exp2f(p[kb][r] - m); den_t += e; p[kb][r] = e; }
                lsum += den_t;
            }
            s16x8 pb[2][2];
#pragma unroll
            for (int kb = 0; kb < 2; ++kb)
#pragma unroll
                for (int s = 0; s < 2; ++s) { v4u w; w.x = cvt_pk_bf16(p[kb][8 * s + 0], p[kb][8 * s + 1]); w.y = cvt_pk_bf16(p[kb][8 * s + 2], p[kb][8 * s + 3]); w.z = cvt_pk_bf16(p[kb][8 * s + 4], p[kb][8 * s + 5]); w.w = cvt_pk_bf16(p[kb][8 * s + 6], p[kb][8 * s + 7]);
                    pb[kb][s] = __builtin_bit_cast(s16x8, w); }
#pragma unroll
            for (int db = 0; db < NDB; ++db) { s16x4 vlo[2][2], vhi[2][2];
#pragma unroll
                for (int kb = 0; kb < 2; ++kb)
#pragma unroll
                    for (int s = 0; s < 2; ++s) { vlo[kb][s] = vtr(Vb + (32 * kb + 16 * s) * VP + 64 * db); vhi[kb][s] = vtr(Vb + (32 * kb + 16 * s + 8) * VP + 64 * db); }
                __builtin_amdgcn_sched_barrier(0);
#pragma unroll
                for (int kb = 0; kb < 2; ++kb)
#pragma unroll
                    for (int s = 0; s < 2; ++s) { const s16x4 lo = vlo[kb][s], hh = vhi[kb][s];
                        const s16x8 a = (s16x8){lo[0], lo[1], lo[2], lo[3], hh[0], hh[1], hh[2], hh[3]};
                        O[db] = __builtin_amdgcn_mfma_f32_32x32x16_bf16(a, pb[kb][s], O[db], 0, 0, 0); } }
        }
        MX_STORE(kb_, vb_, cur ^ 1);
        __syncthreads();
    };
    for (int j = j_lo; j < j_hi; j += 2) { step(j, kr0, vr0, kr1, vr1); step(j + 1, kr1, vr1, kr0, vr0); }
#undef MX_LOADG
#undef MX_STORE
    const float tot = swap32_add(lsum);
    float inv;
    if (MODE == 1) inv = 1.f / fmaxf(fabsf(tot), ((const LAS float*)(lds + MX_SC_E))[32 * wave + c]);
    else inv = 1.f / tot;
    unsigned char* yp = (unsigned char*)Y + (rowb + qabs) * NY + yc + 4 * hi;
    const bf16* op = Z + (rowb + qabs) * NZ + ZC_MO + h * 128 + 4 * hi;
#pragma unroll
    for (int db = 0; db < NDB; ++db)
#pragma unroll
        for (int g = 0; g < 4; ++g) { float o0 = O[db][4 * g] * inv, o1 = O[db][4 * g + 1] * inv, o2 = O[db][4 * g + 2] * inv, o3 = O[db][4 * g + 3] * inv;
            if (MODE == 1) { const v2u gw = *(const v2u*)(op + 32 * db + 8 * g);
                o0 *= __builtin_amdgcn_rcpf(1.f + __builtin_amdgcn_exp2f(-LOG2E * bf_lo(gw.x))); o1 *= __builtin_amdgcn_rcpf(1.f + __builtin_amdgcn_exp2f(-LOG2E * bf_hi(gw.x)));
                o2 *= __builtin_amdgcn_rcpf(1.f + __builtin_amdgcn_exp2f(-LOG2E * bf_lo(gw.y))); o3 *= __builtin_amdgcn_rcpf(1.f + __builtin_amdgcn_exp2f(-LOG2E * bf_hi(gw.y))); }
            *(int*)(yp + 32 * db + 8 * g) = pk4_e4m3(o0 * Y8_SCALE, o1 * Y8_SCALE, o2 * Y8_SCALE, o3 * Y8_SCALE); }
}

constexpr int CW_QUEUE = 8192;
constexpr int MX_UNITS = 512 + 512;
constexpr int CV_CHUNK = 64;
__device__ __forceinline__ void mixers_mfma(Frame& F, KArgs A_, int l) {
    KArgs A = A_; OPQ_S(A);
    int lane = lane_id(); OPQ_V(lane);
    const bf16* Z = (const bf16*)(A->ws + WS_Z); bf16* Y = (bf16*)(A->ws + WS_Y); const float* G = (const float*)(A->ws + WS_G);
    unsigned* qhead = (unsigned*)(A->ws + WS_CTL) + CW_QUEUE + 64 * l;
    volatile LAS unsigned* qw = F.MISC + 16;
    LAS float* scr = (LAS float*)(F.lds) + F.wave * (64 * 65);
    const int cv_lo = l ? I_LAYER + I_IN : I_IN, cv_n = ((l ? 2 * I_LAYER : I_LAYER + I_IN) - cv_lo) / CV_CHUNK;
    static_assert(I_IN % CV_CHUNK == 0 && I_LAYER % CV_CHUNK == 0 && (I_LAYER - I_IN) / CV_CHUNK <= MX_UNITS, "queue layout");
    const unsigned long long order = 0x081923A4B5C67DEFull;
    unsigned pend = 0u;
    if (F.wave == 0 && lane == 0) qw[0] = __hip_atomic_fetch_add(qhead, 1u, __ATOMIC_RELAXED, __HIP_MEMORY_SCOPE_AGENT);
    __syncthreads();
    for (;;) {
        const unsigned e = qw[0];
        if (e >= (unsigned)(MX_UNITS + cv_n)) break;
        OPQ_V(lane);
        if (F.wave == 0 && lane == 0) pend = __hip_atomic_fetch_add(qhead, 1u, __ATOMIC_RELAXED, __HIP_MEMORY_SCOPE_AGENT);
        int u = -1, c = -1;
        if (e < 2u * (unsigned)cv_n) { if (e & 1u) c = (int)(e >> 1); else u = (int)(e >> 1); } else u = (int)e - cv_n;
        if (c >= 0) {
#pragma unroll 1
            for (int k = 0; k < CV_CHUNK / NWAVES; ++k) conv_item(A, cv_lo + c * CV_CHUNK + k * NWAVES + F.wave, scr, lane);
        } else if (u < 512) {
            const unsigned code = (unsigned)(order >> (4 * (u >> 5))) & 15u; const int bh = u & 31, qb = code & 7;
            if (code & 8u) mixer_unit<2>(F.lds, Z, Y, G, A->in[4][l * 8 + (bh & 7)], 0.f, 0.f, bh >> 3, bh & 7, qb, F.wave, lane);
            else mixer_unit<1>(F.lds, Z, Y, G, A->in[3][l * 8 + (bh & 7)], A->in[2][l * 8 + (bh & 7)], 0.f, bh >> 3, bh & 7, qb, F.wave, lane);
        } else {
            const unsigned v = (unsigned)u - 512u; const int qb = 7 - (int)(v >> 6), bh = v & 63;
            mixer_unit<0>(F.lds, Z, Y, G, 0.f, 0.f, A->in[5][l * 16 + (bh & 15)] * LOG2E, bh >> 4, bh & 15, qb, F.wave, lane);
        }
        __syncthreads();
        if (F.wave == 0 && lane == 0) qw[0] = pend;
        __syncthreads();
    }
}

constexpr int PH_PER_LAYER = 7, N_PHASES = 2 + DEPTH * PH_PER_LAYER;
__global__ void __launch_bounds__(NWAVES * 64, 2) hyb_fwd(Args args) {
    extern __shared__ __attribute__((aligned(16))) unsigned char lds[];
    Frame F;
    F.lds = (LAS unsigned char*)lds;
    F.MISC = (volatile LAS unsigned*)(F.lds + MISC_OFF);
    F.wave = __builtin_amdgcn_readfirstlane((int)threadIdx.x >> 6);
    F.G = gridDim.x; { const int bx = blockIdx.x; F.vcu = (F.G % 8 == 0) ? (bx % 8) * (F.G / 8) + bx / 8 : bx; }
    const KArgs ka = (KArgs)__builtin_amdgcn_kernarg_segment_ptr();
    F.ctl = (gu32*)(args.ws + WS_CTL);
    for (int u = threadIdx.x; u < (LDS_BYTES - LDSCTL_OFF) / 4; u += NWAVES * 64) ((LAS unsigned*)(F.lds + LDSCTL_OFF))[u] = 0u;
    __syncthreads();
    const int lo = args.ph_lo, hi = args.ph_hi;
    XcdBarrier bar; bar.bar = (unsigned*)(F.ctl + CW_BAR); bar.x = 0; bar.st = F.MISC + 8; bar.wave = F.wave;
    if (hi - lo > 1) { bar = xcd_barrier_post((unsigned*)(F.ctl + CW_BAR), F.MISC + 8); bar.wave = F.wave; }
#define IN(k) (lo <= (k) && (k) < hi)
#define SEAM(k) do { if (IN(k) && IN((k) + 1)) xcd_barrier(bar); } while (0)
#define PHASE_PTRS KArgs A = ka; OPQ_S(A); unsigned char* ws = A->ws; int bx = blockIdx.x; OPQ_S(bx); unsigned* ctlw = (unsigned*)(ws + WS_CTL)
#define FXP(word_off) ((pg8::fx64*)(ctlw + (word_off)))
#define STATP(layer, which) FXP(CW_STAT + ((layer) * 2 + (which)) * 4 * M)

    if (IN(0)) { p0_prologue(F, ka); } SEAM(0);

    for (int l = 0; l < DEPTH; ++l) {
        const int pb = 1 + l * PH_PER_LAYER;
        if (IN(pb + 0)) {
            PHASE_PTRS;
            pg8::Gemm g{(const pg8::bf16_t*)(ws + (l ? WS_TB : WS_XB)), (const pg8::bf16_t*)(ws + WS_WIN + l * SZ_WIN), M, NZB, D}; pg8::StaticOrder S; S.init(M, NZB, F.G, bx);
            pg8::EpiZ<false> E{(pg8::bf16_t*)(ws + WS_Z), (float*)(ws + WS_G), NZ, M, pg8::LnFold{STATP(l ? l - 1 : 0, 1), l ? (const float*)(ws + WS_SC) : (const float*)(ctlw + CW_ZERO), l ? (const float*)(ws + WS_SC) + NZP : (const float*)(ctlw + CW_ZERO), l}};
            pg8::gemm_phase<pg8::EpiZ<false>, pg8::StaticOrder, PG8_ALIGN, PG8_SP2>(F.lds + RING_OFF, g, S, E, F.wave);
        }
        if (IN(pb + 0) && fp6_layer(l)) {
            PHASE_PTRS;
            pg8::Gemm g{(const pg8::bf16_t*)(ws + WS_A6), (const pg8::bf16_t*)(ws + WS_WIN8 + l * SZ_WIN8), M, NZ8, D / 2}; pg8::ExtraOrder S; S.init(M, NZ8, F.G, bx);
            if (F.G == 256) { S.n_full = 7; S.n_extra = 2; S.c_min = 64; } else { S.n_full = (M / 256) * (NZ8 / 256) / F.G + 1; S.n_extra = 0; S.c_min = 0; }
            if (l == 0) { pg8::EpiZ<true, 0, 1> E{(pg8::bf16_t*)(ws + WS_Z), (float*)(ws + WS_G), NZ, M, pg8::LnFold{STATP(0, 1), (const float*)(ctlw + CW_ZERO), (const float*)(ctlw + CW_ZERO), 0}};
                pg8::gemm_phase_fp6d<pg8::EpiZ<true, 0, 1>, pg8::ExtraOrder, PG8_ALIGN>(F.lds + RING_OFF, g, S, E, F.wave); }
            else { pg8::EpiZ<true, 0, 2> E{(pg8::bf16_t*)(ws + WS_Z), (float*)(ws + WS_G), NZ, M, pg8::LnFold{STATP(l - 1, 1), (const float*)(ws + WS_SC), (const float*)(ws + WS_SC) + NZP, 1}};
                pg8::gemm_phase_fp6d<pg8::EpiZ<true, 0, 2>, pg8::ExtraOrder, PG8_ALIGN>(F.lds + RING_OFF, g, S, E, F.wave); }
        }
        if (IN(pb + 0) && !fp6_layer(l)) {
            PHASE_PTRS;
            pg8::Gemm g{(const pg8::bf16_t*)(ws + WS_A8), (const pg8::bf16_t*)(ws + WS_WIN8 + l * SZ_WIN8), M, NZ8, D / 2}; pg8::ExtraOrder S; S.init(M, NZ8, F.G, bx);
            if (F.G == 256) { S.n_full = 7; S.n_extra = 2; S.c_min = 64; } else { S.n_full = (M / 256) * (NZ8 / 256) / F.G + 1; S.n_extra = 0; S.c_min = 0; }
            pg8::EpiZ<true> E{(pg8::bf16_t*)(ws + WS_Z), (float*)(ws + WS_G), NZ, M, pg8::LnFold{STATP(l ? l - 1 : 0, 1), l ? (const float*)(ws + WS_SC) : (const float*)(ctlw + CW_ZERO), l ? (const float*)(ws + WS_SC) + NZP : (const float*)(ctlw + CW_ZERO), l}};
            pg8::gemm_phase<pg8::EpiZ<true>, pg8::ExtraOrder, PG8_ALIGN, PG8_SP2, true>(F.lds + RING_OFF, g, S, E, F.wave);
        }
        SEAM(pb + 0);
#if defined(MIX_NAIVE)
        if (IN(pb + 1)) { scan_phase(F, ka, l); }
        SEAM(pb + 1);
#endif
#if defined(MIX_NAIVE)
        if (IN(pb + 2)) { mixers_naive(F, ka, l); }
#else
        if (IN(pb + 2)) { mixers_mfma(F, ka, l); }
#endif
        SEAM(pb + 2);
        if (IN(pb + 3)) {
            PHASE_PTRS;
            {
                float* cf = (float*)(ws + WS_SC); int tl_ = F.wave * 64 + lane_id(); OPQ_V(tl_); const int t0 = bx * 512 + tl_, nt_ = F.G * 512;
                if (l == 0) for (int i = t0; i < 2 * NZP; i += nt_) cf[i] = (float)FXP(CW_CIN)[i] * (1.f / FX_C);
                for (int i = t0; i < 2 * DFF; i += nt_) cf[2 * NZP + l * 2 * DFF + i] = (float)(FXP(CW_CF1) + l * 2 * DFF)[i] * (1.f / FX_C);
            }
            pg8::Gemm g{(const pg8::bf16_t*)(ws + WS_Y), (const pg8::bf16_t*)(ws + WS_WUP + l * SZ_WUP), M, D, NY / 2}; pg8::StaticOrder S; S.init(M, D, F.G, bx);
            pg8::EpiMix<true> E{(const pg8::bf16_t*)(ws + WS_Z) + ZC_GA, (pg8::bf16_t*)(ws + WS_MIX), NZ, D, MIX8_SCALE / (Y8_SCALE * W8_SCALE)};
            pg8::gemm_phase<pg8::EpiMix<true>, pg8::StaticOrder, PG8_ALIGN, PG8_SP2, true>(F.lds + RING_OFF, g, S, E, F.wave);
        }
        SEAM(pb + 3);
        if (IN(pb + 4)) {
            PHASE_PTRS;
            pg8::Gemm g{(const pg8::bf16_t*)(ws + WS_MIX), (const pg8::bf16_t*)(ws + WS_WO + l * SZ_WO), M, D, D / 2}; pg8::StaticOrder S; S.init(M, D, F.G, bx);
            if (l == 0) { pg8::EpiRes<0, true> E{A->in[0], nullptr, nullptr, A->in[14], A->in[15], (pg8::bf16_t*)(ws + WS_TA), STATP(l, 0), nullptr, nullptr, D};
                pg8::gemm_phase<pg8::EpiRes<0, true>, pg8::StaticOrder, PG8_ALIGN, PG8_SP2, true>(F.lds + RING_OFF, g, S, E, F.wave); }
            else { pg8::EpiRes<1, true> E{nullptr, (const pg8::bf16_t*)(ws + WS_TB), STATP(l - 1, 1), A->in[14] + (l - 1) * D, A->in[15] + (l - 1) * D, (pg8::bf16_t*)(ws + WS_TA), STATP(l, 0), nullptr, nullptr, D};
                pg8::gemm_phase<pg8::EpiRes<1, true>, pg8::StaticOrder, PG8_ALIGN, PG8_SP2, true>(F.lds + RING_OFF, g, S, E, F.wave); }
        }
        SEAM(pb + 4);
        if (IN(pb + 5)) {
            PHASE_PTRS;
            pg8::Gemm g{(const pg8::bf16_t*)(ws + WS_TA), (const pg8::bf16_t*)(ws + WS_WF1 + l * SZ_WF), M, DFF, D}; pg8::StaticOrder S; S.init(M, DFF, F.G, bx);
            pg8::EpiRelu2 E{(pg8::bf16_t*)(ws + WS_Z), DFF, pg8::LnFold{STATP(l, 0), (const float*)(ws + WS_SC) + 2 * NZP + l * 2 * DFF, (const float*)(ws + WS_SC) + 2 * NZP + l * 2 * DFF + DFF, 1}};
            pg8::gemm_phase<pg8::EpiRelu2, pg8::StaticOrder, PG8_ALIGN, PG8_SP2>(F.lds + RING_OFF, g, S, E, F.wave);
        }
        SEAM(pb + 5);
        if (IN(pb + 6)) {
            PHASE_PTRS;
            pg8::Gemm g{(const pg8::bf16_t*)(ws + WS_Z), (const pg8::bf16_t*)(ws + WS_WF2 + l * SZ_WF), M, D, DFF}; pg8::StaticOrder S; S.init(M, D, F.G, bx);
            pg8::EpiRes<1, false> E{nullptr, (const pg8::bf16_t*)(ws + WS_TA), STATP(l, 0), A->in[10] + l * D, A->in[11] + l * D,
                             (pg8::bf16_t*)(ws + WS_TB), STATP(l, 1), nullptr, (l + 1 < DEPTH) ? ws + WS_A6 : nullptr, D};
            pg8::gemm_phase<pg8::EpiRes<1, false>, pg8::StaticOrder, PG8_ALIGN, PG8_SP2>(F.lds + RING_OFF, g, S, E, F.wave);
        }
        SEAM(pb + 6);
    }
    if (IN(N_PHASES - 1)) { PHASE_PTRS; (void)bx; lnout_phase(F, (const bf16*)(ws + WS_TB), STATP(DEPTH - 1, 1), A->in[14] + (DEPTH - 1) * D, A->in[15] + (DEPTH - 1) * D, A->out); }
#undef IN
#undef SEAM
#undef PHASE_PTRS
#undef FXP
#undef STATP
}

extern "C" void kernel_launch(void* const* d_in, const int* in_sizes, int n_in, void* d_out, int out_size, void* d_ws, size_t ws_size, hipStream_t stream) {
    static int grid = 0;
    if (grid == 0) {
        if (n_in != 16 || in_sizes[0] != M * D || out_size != M * D || ws_size < WS_END) { fprintf(stderr, "kernel_launch: unexpected shapes (n_in %d, in0 %d, out %d, ws %zu < %zu)\n", n_in, n_in > 0 ? in_sizes[0] : -1, out_size, ws_size, (size_t)WS_END); grid = -1; return; }
        int dev = 0, cus = 0, per_cu = 0;
        if (hipGetDevice(&dev) != hipSuccess || hipDeviceGetAttribute(&cus, hipDeviceAttributeMultiprocessorCount, dev) != hipSuccess) { grid = -1; return; }
        if (hipFuncSetAttribute((const void*)hyb_fwd, hipFuncAttributeMaxDynamicSharedMemorySize, LDS_BYTES) != hipSuccess) { fprintf(stderr, "kernel_launch: hipFuncSetAttribute failed\n"); grid = -1; return; }
        if (hipOccupancyMaxActiveBlocksPerMultiprocessor(&per_cu, (const void*)hyb_fwd, NWAVES * 64, LDS_BYTES) != hipSuccess || per_cu < 1) { fprintf(stderr, "kernel_launch: occupancy query says %d blocks per CU\n", per_cu); (void)hipGetLastError(); grid = -1; return; }
        grid = cus;
    }
    if (grid < 0) return;
    (void)hipMemsetAsync((char*)d_ws + WS_CTL, 0, CTL_ZERO_BYTES, stream);
    Args a{};
    for (int i = 0; i < 16; ++i) a.in[i] = (const float*)d_in[i];
    a.out = (float*)d_out; a.ws = (unsigned char*)d_ws;
#if MK_N_LAUNCHES == 1
    a.ph_lo = 0; a.ph_hi = N_PHASES;
    hipLaunchKernelGGL(hyb_fwd, dim3(grid), dim3(NWAVES * 64), LDS_BYTES, stream, a);
#else
    for (int p = 0; p < N_PHASES; ++p) { a.ph_lo = p; a.ph_hi = p + 1; hipLaunchKernelGGL(hyb_fwd, dim3(grid), dim3(NWAVES * 64), LDS_BYTES, stream, a); }
#endif
}
```

```cpp
#include <hip/hip_runtime.h>
#include <cstdio>
#include <cstdint>

#define OPQ_V(x) asm volatile("" : "+v"(x))
#define OPQ_S(x) asm volatile("" : "+s"(x))
__device__ __forceinline__ int lane_id() { unsigned z = 0u; asm volatile("" : "+v"(z)); return (int)__builtin_amdgcn_mbcnt_hi(~0u, __builtin_amdgcn_mbcnt_lo(~0u, z)); }
__device__ __forceinline__ int pk4_e4m3(float a, float b, float c, float d) {
    a = __builtin_amdgcn_fmed3f(a, -448.f, 448.f); b = __builtin_amdgcn_fmed3f(b, -448.f, 448.f); c = __builtin_amdgcn_fmed3f(c, -448.f, 448.f); d = __builtin_amdgcn_fmed3f(d, -448.f, 448.f);
    int p = __builtin_amdgcn_cvt_pk_fp8_f32(a, b, 0, false); return __builtin_amdgcn_cvt_pk_fp8_f32(c, d, p, true);
}
__device__ __forceinline__ unsigned q_e2m3(float x) {
    const float a = fminf(fabsf(x), 7.5f); const float s = a < 2.f ? 8.f : (a < 4.f ? 4.f : 2.f); const unsigned o = a < 2.f ? 0u : (a < 4.f ? 8u : 16u);
    return ((unsigned)(int)__builtin_rintf(a * s) + o) | (x < 0.f ? 32u : 0u);
}
__device__ __forceinline__ float v_e2m3(float x) {
    const float a = fminf(fabsf(x), 7.5f); const float s = a < 2.f ? 8.f : (a < 4.f ? 4.f : 2.f), si = a < 2.f ? 0.125f : (a < 4.f ? 0.25f : 0.5f);
    return __builtin_copysignf(__builtin_rintf(a * s) * si, x);
}
typedef unsigned pk6x4_t __attribute__((ext_vector_type(4)));
__device__ __forceinline__ pk6x4_t pack16_e2m3(const unsigned (&c)[16]) {
    pk6x4_t d;
    d.x = c[0] | (c[1] << 6) | (c[2] << 12) | (c[3] << 18) | (c[4] << 24) | (c[5] << 30);
    d.y = (c[5] >> 2) | (c[6] << 4) | (c[7] << 10) | (c[8] << 16) | (c[9] << 22) | (c[10] << 28);
    d.z = (c[10] >> 4) | (c[11] << 2) | (c[12] << 8) | (c[13] << 14) | (c[14] << 20) | (c[15] << 26);
    d.w = 0u; return d;
}
__device__ __forceinline__ unsigned char* e2m3_ktile(unsigned char* img, int row, int kt, bool perm) {
    int rin = row & 255; if (perm) { const int w = rin & 31; rin = (rin & ~31) + 16 * ((w >> 2) & 1) + 4 * (w >> 3) + (w & 3); }
    return img + ((size_t)((row >> 8) * 32 + kt) * 256 + rin) * 96;
}
__device__ __forceinline__ void store_e2m3_group(unsigned char* ktile, int c16, pk6x4_t d) { unsigned* p = (unsigned*)(ktile + 12 * c16); p[0] = d.x; p[1] = d.y; p[2] = d.z; }
#ifndef MK_N_LAUNCHES
#define MK_N_LAUNCHES 1
#endif

namespace pg8 {
#define PG8_LAS __attribute__((address_space(3)))
typedef unsigned short bf16_t;
typedef short bf16x8 __attribute__((ext_vector_type(8)));
typedef float f32x4 __attribute__((ext_vector_type(4)));
typedef unsigned u32x4 __attribute__((ext_vector_type(4)));
constexpr int BM = 256, BK = 64, HALF = 128, HTB = HALF * BK * 2, STAGE_BYTES = 8 * HTB, NXCD = 8, WGM = 8;

__host__ __device__ __forceinline__ int lds_byte(int r, int c) { const int st = (r >> 4) * 2 + (c >> 5), rr = r & 15, cc = c & 31, ob = rr * 64 + cc * 2; return st * 1024 + (ob ^ (((ob >> 9) & 1) << 5)); }
__host__ __device__ __forceinline__ void stage_rc(int b, int& R, int& C) { const int st = b / 1024, sb = b % 1024, swz = sb ^ (((sb >> 9) & 1) << 5); R = (st >> 1) * 16 + swz / 64; C = (st & 1) * 32 + (swz % 64) / 2; }
__host__ __device__ __forceinline__ int perm32(int rho) { const int n = rho >> 4, i = rho & 15; return 8 * (i >> 2) + 4 * n + (i & 3); }

struct Unit { int pm, pn; };
struct Gemm { const bf16_t* A; const bf16_t* Bt; int M, N, K; };

struct StaticOrder {
    int nM, nN, nwg, G, c;
    __host__ __device__ void init(int M, int N, int G_, int c_) { nM = M / BM; nN = N / BM; nwg = nM * nN; G = G_; c = c_; }
    __host__ __device__ bool next(int i, Unit& u) const {
        const long L = (long)i * G + c; if (L >= nwg) return false;
        int wgid = (int)L; { const int q = nwg / NXCD, r = nwg % NXCD, xcd = wgid % NXCD, off = wgid / NXCD; wgid = (xcd < r ? xcd * (q + 1) : r * (q + 1) + (xcd - r) * q) + off; }
        const int nig = WGM * nN, gid = wgid / nig, fm = gid * WGM, gsz = (nM - fm) < WGM ? (nM - fm) : WGM;
        u.pm = fm + ((wgid % nig) % gsz); u.pn = (wgid % nig) / gsz; return true;
    }
    __device__ __forceinline__ void a_ready(const Unit&) const {}
    __device__ __forceinline__ void done(const Unit&) const {}
};

struct ExtraOrder : StaticOrder {
    int n_full, n_extra, c_min;
    __host__ __device__ bool next(int i, Unit& u) const {
        long L;
        if (i < n_full) L = (long)i * G + c;
        else if (c >= c_min && i < n_full + n_extra) L = (long)n_full * G + (long)(i - n_full) * (G - c_min) + (c - c_min);
        else return false;
        if (L >= nwg) return false;
        int wgid = (int)L; { const int q = nwg / NXCD, r = nwg % NXCD, xcd = wgid % NXCD, off = wgid / NXCD; wgid = (xcd < r ? xcd * (q + 1) : r * (q + 1) + (xcd - r) * q) + off; }
        const int nig = WGM * nN, gid = wgid / nig, fm = gid * WGM, gsz = (nM - fm) < WGM ? (nM - fm) : WGM;
        u.pm = fm + ((wgid % nig) % gsz); u.pn = (wgid % nig) / gsz; return true;
    }
};

__device__ __forceinline__ unsigned cvt_pk_bf16(float lo, float hi) { unsigned r; asm volatile("v_cvt_pk_bf16_f32 %0, %1, %2" : "=v"(r) : "v"(lo), "v"(hi)); return r; }
__device__ __forceinline__ float bf_lo(unsigned w) { return __uint_as_float(w << 16); }
__device__ __forceinline__ float bf_hi(unsigned w) { return __uint_as_float(w & 0xffff0000u); }


typedef float f32x2 __attribute__((ext_vector_type(2)));
typedef long long fx64;
__device__ __forceinline__ void fx_add(fx64* p, float v, float scale) { __hip_atomic_fetch_add(p, (fx64)__float2ll_rn(v * scale), __ATOMIC_RELAXED, __HIP_MEMORY_SCOPE_AGENT); }
struct LnFold {
    const fx64* st; const float* c1; const float* c2; int on;
    static constexpr float INV_D = 1.f / 4096.f, EPS = 1e-5f;
    __device__ __forceinline__ void row(int r, float& rr, float& rm) const {
        if (on) { const fx64 a = st[2 * (size_t)r], b = st[2 * (size_t)r + 1]; const float mu = (float)a * (INV_D / 16777216.f), var = fmaxf((float)b * (INV_D / 1048576.f) - mu * mu, 0.f); rr = __builtin_amdgcn_rsqf(var + EPS); rm = rr * mu; }
        else { rr = 1.f; rm = 0.f; }
    }
    __device__ __forceinline__ void cols(int c0, f32x4 (&k1)[2][2], f32x4 (&k2)[2][2]) const {
#pragma unroll
        for (int bj = 0; bj < 2; ++bj)
#pragma unroll
            for (int n = 0; n < 2; ++n) { k1[bj][n] = *(const f32x4*)(c1 + c0 + bj * HALF + 4 * n); k2[bj][n] = *(const f32x4*)(c2 + c0 + bj * HALF + 4 * n); }
    }
};
constexpr float A6_SCALE = 2.f, A6_SCALE1 = 1.f, W6_SCALE = 128.f;
template <bool F8, int PN0 = 0, int F6 = 0> struct EpiZ {
    static constexpr bool PERM = true, AFTER_DRAIN = false, HAS_MID = false, WAIT_AFTER_EPI = !F8;
    bf16_t* Z; float* G; int ldz, Mrows; LnFold ln;
    static constexpr int gate_pn = F8 ? -1 : 9, seg_pn = F8 ? 4 : 9, off_lo = F8 ? 0 : 1024, off_hi = F8 ? 2304 : 1024, gate_coff = 19712 - 9 * 256; static constexpr float ascale = F6 == 1 ? 1.f / (A6_SCALE * W6_SCALE) : F6 == 2 ? 1.f / (A6_SCALE1 * W6_SCALE) : F8 ? 1.f / 64.f : 1.f;
    __device__ __forceinline__ void operator()(const f32x4 (&acc)[2][2][4][2], const Unit& u, int wr, int wc, int fr, int fq) const {
        OPQ_V(fr); OPQ_V(fq);
        const int pn = u.pn + PN0;
        const int row0 = u.pm * BM + wr * 64 + fr, col0 = pn * BM + wc * 32 + 8 * fq + (pn == gate_pn ? gate_coff : (pn < seg_pn ? off_lo : off_hi));
        f32x4 k1[2][2], k2[2][2]; ln.cols(col0, k1, k2);
        const float asc = F6 ? (F6 == 1 ? 1.f / A6_SCALE : 1.f / A6_SCALE1) * (pn < 4 ? 1.f / 512.f : pn < 8 ? 1.f / 128.f : pn < 12 ? 1.f / 1024.f : pn < 16 ? 1.f / 128.f : pn < 20 ? 1.f / 256.f : 1.f / 128.f) : ascale;
        if (pn == gate_pn) {
#pragma unroll
            for (int bj = 0; bj < 2; ++bj)
#pragma unroll
                for (int n = 0; n < 2; ++n) asm volatile("" :: "v"(k1[bj][n]), "v"(k2[bj][n]));
            if (wc == 0 && fq < 3) {
#pragma unroll
                for (int ai = 0; ai < 2; ++ai)
#pragma unroll
                    for (int m = 0; m < 4; ++m) { const int r = row0 + ai * HALF + m * 16; float rr, rm; ln.row(r, rr, rm); rr *= asc;
#pragma unroll
                        for (int n = 0; n < 2; ++n)
#pragma unroll
                            for (int j = 0; j < 4; ++j) G[(size_t)(8 * fq + 4 * n + j) * Mrows + r] = rr * acc[ai][0][m][n][j] - rm * k1[0][n][j] + k2[0][n][j]; }
            }
            return;
        }
#pragma unroll
        for (int ai = 0; ai < 2; ++ai)
#pragma unroll
            for (int m = 0; m < 4; ++m) { const int r = row0 + ai * HALF + m * 16; float rr, rm; ln.row(r, rr, rm); rr *= asc; bf16_t* rowp = Z + (size_t)r * ldz + col0;
#pragma unroll
                for (int bj = 0; bj < 2; ++bj) { f32x4 v0 = acc[ai][bj][m][0] * rr - k1[bj][0] * rm + k2[bj][0], v1 = acc[ai][bj][m][1] * rr - k1[bj][1] * rm + k2[bj][1];
                    if (F8 && pn >= 20) {
#pragma unroll
                        for (int j = 0; j < 4; ++j) { v0[j] = __builtin_amdgcn_exp2f(__builtin_amdgcn_fmed3f(v0[j], -40.f, 40.f) * -1.4426950408889634f); v1[j] = __builtin_amdgcn_exp2f(__builtin_amdgcn_fmed3f(v1[j], -40.f, 40.f) * -1.4426950408889634f); } }
                    u32x4 w; w.x = cvt_pk_bf16(v0[0], v0[1]); w.y = cvt_pk_bf16(v0[2], v0[3]); w.z = cvt_pk_bf16(v1[0], v1[1]); w.w = cvt_pk_bf16(v1[2], v1[3]);
                    *(u32x4*)(rowp + bj * HALF) = w; } }
    }
};
struct EpiRelu2 {
    static constexpr bool PERM = true, AFTER_DRAIN = false, HAS_MID = false, WAIT_AFTER_EPI = false;
    bf16_t* O; int ldc; LnFold ln;
    __device__ __forceinline__ void operator()(const f32x4 (&acc)[2][2][4][2], const Unit& u, int wr, int wc, int fr, int fq) const {
        OPQ_V(fr); OPQ_V(fq);
        const int row0 = u.pm * BM + wr * 64 + fr, col0 = u.pn * BM + wc * 32 + 8 * fq;
        f32x4 k1[2][2], k2[2][2]; ln.cols(col0, k1, k2);
#pragma unroll
        for (int ai = 0; ai < 2; ++ai)
#pragma unroll
            for (int m = 0; m < 4; ++m) { const int r = row0 + ai * HALF + m * 16; float rr, rm; ln.row(r, rr, rm); bf16_t* rowp = O + (size_t)r * ldc + col0;
#pragma unroll
                for (int bj = 0; bj < 2; ++bj) { f32x4 v0 = acc[ai][bj][m][0] * rr - k1[bj][0] * rm + k2[bj][0], v1 = acc[ai][bj][m][1] * rr - k1[bj][1] * rm + k2[bj][1];
#pragma unroll
                    for (int j = 0; j < 4; ++j) { const float a = fmaxf(v0[j], 0.f), b = fmaxf(v1[j], 0.f); v0[j] = a * a; v1[j] = b * b; }
                    u32x4 w; w.x = cvt_pk_bf16(v0[0], v0[1]); w.y = cvt_pk_bf16(v0[2], v0[3]); w.z = cvt_pk_bf16(v1[0], v1[1]); w.w = cvt_pk_bf16(v1[2], v1[3]);
                    *(u32x4*)(rowp + bj * HALF) = w; } }
    }
};
template <int mode, bool F8> struct EpiRes {
    static constexpr bool PERM = true, AFTER_DRAIN = false, HAS_MID = false, WAIT_AFTER_EPI = false;
    const float* X; const bf16_t* Tp; const fx64* stp; const float* g; const float* b; bf16_t* T; fx64* sto; unsigned char* T8; unsigned char* T6; int ldc; static constexpr float alpha = 1.41421356237309515f  , ascale = F8 ? 1.f / 2048.f : 1.f;
    __device__ __forceinline__ void operator()(const f32x4 (&acc)[2][2][4][2], const Unit& u, int wr, int wc, int fr, int fq) const {
        OPQ_V(fr); OPQ_V(fq);
        const int row0 = u.pm * BM + wr * 64 + fr, col0 = u.pn * BM + wc * 32 + 8 * fq;
        f32x4 gv[2][2], bv[2][2];
#pragma unroll
        for (int bj = 0; bj < 2; ++bj)
#pragma unroll
            for (int n = 0; n < 2; ++n) { if (mode) { gv[bj][n] = *(const f32x4*)(g + col0 + bj * HALF + 4 * n); bv[bj][n] = *(const f32x4*)(b + col0 + bj * HALF + 4 * n); } }
        LnFold lp{stp, nullptr, nullptr, mode};
        const int lane = fr + 16 * fq;
#pragma unroll
        for (int ai = 0; ai < 2; ++ai) {
            u32x4 tw[4][2];
            if (mode) {
#pragma unroll
                for (int m = 0; m < 4; ++m)
#pragma unroll
                    for (int bj = 0; bj < 2; ++bj) tw[m][bj] = *(const u32x4*)(Tp + (size_t)(row0 + ai * HALF + m * 16) * ldc + col0 + bj * HALF);
            }
#pragma unroll
            for (int mp = 0; mp < 2; ++mp) {
                f32x4 xf[2][2][2];
                if (!mode) {
#pragma unroll
                    for (int mm = 0; mm < 2; ++mm)
#pragma unroll
                        for (int bj = 0; bj < 2; ++bj)
#pragma unroll
                            for (int n = 0; n < 2; ++n) xf[mm][bj][n] = *(const f32x4*)(X + (size_t)(row0 + ai * HALF + (2 * mp + mm) * 16) * ldc + col0 + bj * HALF + 4 * n);
                }
#pragma unroll
                for (int mm = 0; mm < 2; ++mm) { const int m = 2 * mp + mm, r = row0 + ai * HALF + m * 16; bf16_t* rowp = T + (size_t)r * ldc + col0; float s1 = 0.f, s2 = 0.f;
                    float rr = 1.f, rm = 0.f; if (mode) lp.row(r, rr, rm);
                    unsigned p6lo[2], p6hi[2];
#pragma unroll
                    for (int bj = 0; bj < 2; ++bj) { f32x4 x0, x1;
                        if (mode) { const u32x4 w = tw[m][bj];
                            x0 = ((f32x4){bf_lo(w.x), bf_hi(w.x), bf_lo(w.y), bf_hi(w.y)} * rr - rm) * gv[bj][0] + bv[bj][0];
                            x1 = ((f32x4){bf_lo(w.z), bf_hi(w.z), bf_lo(w.w), bf_hi(w.w)} * rr - rm) * gv[bj][1] + bv[bj][1]; }
                        else { x0 = xf[mm][bj][0]; x1 = xf[mm][bj][1]; }
                        const f32x4 v0 = x0 * alpha + acc[ai][bj][m][0] * ascale, v1 = x1 * alpha + acc[ai][bj][m][1] * ascale;
                        u32x4 w; w.x = cvt_pk_bf16(v0[0], v0[1]); w.y = cvt_pk_bf16(v0[2], v0[3]); w.z = cvt_pk_bf16(v1[0], v1[1]); w.w = cvt_pk_bf16(v1[2], v1[3]);
                        *(u32x4*)(rowp + bj * HALF) = w;
                        if (T6) { unsigned cd[8];
#pragma unroll
                            for (int e = 0; e < 4; ++e) { cd[e] = q_e2m3(v0[e] * A6_SCALE1); cd[4 + e] = q_e2m3(v1[e] * A6_SCALE1); }
                            p6lo[bj] = cd[0] | (cd[1] << 6) | (cd[2] << 12) | (cd[3] << 18) | (cd[4] << 24) | (cd[5] << 30); p6hi[bj] = (cd[5] >> 2) | (cd[6] << 4) | (cd[7] << 10); }
#pragma unroll
                        for (int d = 0; d < 4; ++d) { const float a = bf_lo(w[d]), c = bf_hi(w[d]); s1 += a + c; s2 += a * a + c * c; } }
                    if (T6) {
                        const bool odd = (fq & 1) != 0;
                        const unsigned rlo = (unsigned)__builtin_amdgcn_ds_bpermute((lane ^ 16) << 2, (int)(odd ? p6lo[0] : p6lo[1])), rhi = (unsigned)__builtin_amdgcn_ds_bpermute((lane ^ 16) << 2, (int)(odd ? p6hi[0] : p6hi[1]));
                        const unsigned flo = odd ? rlo : p6lo[0], fhi = odd ? rhi : p6hi[0], slo = odd ? p6lo[1] : rlo, shi = odd ? p6hi[1] : rhi;
                        pk6x4_t d6; d6.x = flo; d6.y = fhi | (slo << 16); d6.z = (slo >> 16) | (shi << 16); d6.w = 0u;
                        store_e2m3_group(e2m3_ktile(T6, r, 2 * u.pn + (odd ? 1 : 0), false), 2 * wc + (fq >> 1), d6); }
                    s1 += __int_as_float(__builtin_amdgcn_ds_bpermute((lane ^ 16) << 2, __float_as_int(s1))); s2 += __int_as_float(__builtin_amdgcn_ds_bpermute((lane ^ 16) << 2, __float_as_int(s2)));
                    s1 += __int_as_float(__builtin_amdgcn_ds_bpermute((lane ^ 32) << 2, __float_as_int(s1))); s2 += __int_as_float(__builtin_amdgcn_ds_bpermute((lane ^ 32) << 2, __float_as_int(s2)));
                    if (fq == 0) { fx_add(sto + 2 * (size_t)r, s1, 16777216.f); fx_add(sto + 2 * (size_t)r + 1, s2, 1048576.f); } }
                asm volatile("" ::: "memory");
            }
        }
    }
};
template <bool F8> struct EpiMix {
    static constexpr bool PERM = true, AFTER_DRAIN = false, HAS_MID = true, WAIT_AFTER_EPI = false; static constexpr int MID_T = F8 ? 8 : 16;
    const bf16_t* Zg; bf16_t* O; int ldz, ldc; float ascale;
    static __device__ __forceinline__ float e_neg(float e) { return e; }
    __device__ __forceinline__ void mid(f32x4 (&acc)[2][2][4][2], const Unit& u, int wr, int wc, int fr, int fq, int seg) const {
        OPQ_V(fr); OPQ_V(fq);
        const int row0 = u.pm * BM + wr * 64 + fr, col0 = u.pn * BM + wc * 32 + 8 * fq;
#pragma unroll
        for (int ai = 0; ai < 2; ++ai) {
            u32x4 gx[4][2], gy[4][2];
#pragma unroll
            for (int m = 0; m < 4; ++m) { const bf16_t* zr = Zg + (size_t)(row0 + ai * HALF + m * 16) * ldz + col0 + seg * 4096;
#pragma unroll
                for (int bj = 0; bj < 2; ++bj) { gx[m][bj] = *(const u32x4*)(zr + bj * HALF); gy[m][bj] = *(const u32x4*)(zr + bj * HALF + 4096); } }
#pragma unroll
            for (int m = 0; m < 4; ++m)
#pragma unroll
                for (int bj = 0; bj < 2; ++bj)
#pragma unroll
                    for (int d = 0; d < 4; ++d) { const int n = d >> 1, j = (d & 1) * 2;
                        const float r0 = (1.f + e_neg(bf_lo(gy[m][bj][d]))) * __builtin_amdgcn_rcpf(1.f + e_neg(bf_lo(gx[m][bj][d])));
                        const float r1 = (1.f + e_neg(bf_hi(gy[m][bj][d]))) * __builtin_amdgcn_rcpf(1.f + e_neg(bf_hi(gx[m][bj][d])));
                        acc[ai][bj][m][n][j] *= r0; acc[ai][bj][m][n][j + 1] *= r1; }
            asm volatile("" ::: "memory"); }
    }
    __device__ __forceinline__ void operator()(const f32x4 (&acc)[2][2][4][2], const Unit& u, int wr, int wc, int fr, int fq) const {
        OPQ_V(fr); OPQ_V(fq);
        const int row0 = u.pm * BM + wr * 64 + fr, col0 = u.pn * BM + wc * 32 + 8 * fq;
#pragma unroll
        for (int ai = 0; ai < 2; ++ai) {
            u32x4 gcv[4][2];
#pragma unroll
            for (int m = 0; m < 4; ++m) { const bf16_t* zr = Zg + (size_t)(row0 + ai * HALF + m * 16) * ldz + col0 + 8192; gcv[m][0] = *(const u32x4*)(zr); gcv[m][1] = *(const u32x4*)(zr + HALF); }
#pragma unroll
            for (int m = 0; m < 4; ++m) { bf16_t* rowp = O + (size_t)(row0 + ai * HALF + m * 16) * ldc + col0;
#pragma unroll
                for (int bj = 0; bj < 2; ++bj) { const u32x4 gc = gcv[m][bj]; const f32x4 v0 = acc[ai][bj][m][0], v1 = acc[ai][bj][m][1]; float o[8];
                    o[0] = v0[0] * __builtin_amdgcn_rcpf(1.f + e_neg(bf_lo(gc[0]))); o[1] = v0[1] * __builtin_amdgcn_rcpf(1.f + e_neg(bf_hi(gc[0])));
                    o[2] = v0[2] * __builtin_amdgcn_rcpf(1.f + e_neg(bf_lo(gc[1]))); o[3] = v0[3] * __builtin_amdgcn_rcpf(1.f + e_neg(bf_hi(gc[1])));
                    o[4] = v1[0] * __builtin_amdgcn_rcpf(1.f + e_neg(bf_lo(gc[2]))); o[5] = v1[1] * __builtin_amdgcn_rcpf(1.f + e_neg(bf_hi(gc[2])));
                    o[6] = v1[2] * __builtin_amdgcn_rcpf(1.f + e_neg(bf_lo(gc[3]))); o[7] = v1[3] * __builtin_amdgcn_rcpf(1.f + e_neg(bf_hi(gc[3])));
                    if constexpr (F8) {
#pragma unroll
                        for (int e = 0; e < 8; ++e) o[e] *= ascale;
                        const int p0 = pk4_e4m3(o[0], o[1], o[2], o[3]), p1 = pk4_e4m3(o[4], o[5], o[6], o[7]);
                        typedef int v2i_t __attribute__((ext_vector_type(2))); *(v2i_t*)((unsigned char*)O + (size_t)(row0 + ai * HALF + m * 16) * ldc + col0 + bj * HALF) = (v2i_t){p0, p1};
                    } else {
                    u32x4 w; w.x = cvt_pk_bf16(o[0], o[1]); w.y = cvt_pk_bf16(o[2], o[3]); w.z = cvt_pk_bf16(o[4], o[5]); w.w = cvt_pk_bf16(o[6], o[7]);
                    *(u32x4*)(rowp + bj * HALF) = w; } } }
            asm volatile("" ::: "memory"); }
    }
};

typedef int v4i_t __attribute__((ext_vector_type(4)));
typedef int v8i_t __attribute__((ext_vector_type(8)));
typedef int v6i_t __attribute__((ext_vector_type(6)));
template <class Epi, class Sched, bool ALIGN_EPI = false, bool SP2 = false, bool FP8 = false, bool FP6 = false>
__device__ __forceinline__ void gemm_phase(PG8_LAS unsigned char* lds, const Gemm g, const Sched& S, const Epi& E, int wave) {
    int tid_ = wave * 64 + lane_id(); OPQ_V(tid_);
    const int tid = tid_, wid = __builtin_amdgcn_readfirstlane(tid >> 6), lane = tid & 63, wr = wid >> 2, wc = wid & 3, fr = lane & 15, fq = lane >> 4;
    int K_ = g.K; OPQ_S(K_); const int K = K_, nt = K / BK;
    unsigned voffA[2], voffB[2];
#pragma unroll
    for (int i = 0; i < 2; ++i) { int R, C; stage_rc(tid * 16 + i * 8192, R, C); const int Rb = Epi::PERM ? ((R & ~31) + perm32(R & 31)) : R;
        voffA[i] = (unsigned)(R * K + C) * 2u; voffB[i] = (unsigned)(Rb * K + C) * 2u; }
    const size_t kstep = (size_t)(BK * 2);
    const size_t hstep = (size_t)HALF * K * 2;
    const size_t tstep = 2 * hstep;
    const unsigned ldsw = (unsigned)wid * 1024u;
    const int aoff = lds_byte(wr * 64 + fr, fq * 8), boff = lds_byte(wc * 32 + fr, fq * 8);
#define PG8_SA(b, h) (((b) * 2 + (h)) * HTB)
#define PG8_SB(b, h) ((4 + (b) * 2 + (h)) * HTB)
#define PG8_STAGE(bufoff, gbase, voff) do { _Pragma("unroll") for (int _i = 0; _i < 2; ++_i) \
        __builtin_amdgcn_global_load_lds((const unsigned*)((const char*)(gbase) + (voff)[_i]), (PG8_LAS unsigned*)(lds + (bufoff) + ldsw + _i * 8192), 16, 0, 0); } while (0)
#define PG8_LDF(p) ([&](const PG8_LAS unsigned char* p_, int k_) -> bf16x8 { if constexpr (FP6) { if (k_ == 1) { typedef short s4_t __attribute__((ext_vector_type(4))); const s4_t h_ = *(const volatile PG8_LAS s4_t*)p_;   return __builtin_shufflevector(h_, h_, 0, 1, 2, 3, -1, -1, -1, -1); } } return *(const PG8_LAS bf16x8*)p_; })
#define PG8_LDA(dst, b, h) do { _Pragma("unroll") for (int m = 0; m < 4; ++m) _Pragma("unroll") for (int k = 0; k < 2; ++k) dst[m][k] = PG8_LDF(0)(lds + PG8_SA(b, h) + aoff + m * 2048 + k * 1024, k); } while (0)
#define PG8_LDB(dst, b, h) do { _Pragma("unroll") for (int n = 0; n < 2; ++n) _Pragma("unroll") for (int k = 0; k < 2; ++k) dst[n][k] = PG8_LDF(0)(lds + PG8_SB(b, h) + boff + n * 2048 + k * 1024, k); } while (0)
#define PG8_CAT(x) __builtin_shufflevector(__builtin_bit_cast(v4i_t, (x)[0]), __builtin_bit_cast(v4i_t, (x)[1]), 0, 1, 2, 3, 4, 5, 6, 7)
#define PG8_CAT6(x) __builtin_shufflevector(__builtin_bit_cast(v4i_t, (x)[0]), __builtin_bit_cast(v4i_t, (x)[1]), 0, 1, 2, 3, 4, 5)
#define PG8_MMA(ai, bj, At, Bt) do { __builtin_amdgcn_s_setprio(1); if constexpr (FP6) { v6i_t a6_[4], b6_[2]; _Pragma("unroll") for (int m = 0; m < 4; ++m) a6_[m] = PG8_CAT6(At[m]); _Pragma("unroll") for (int n = 0; n < 2; ++n) b6_[n] = PG8_CAT6(Bt[n]); \
        _Pragma("unroll") for (int m = 0; m < 4; ++m) _Pragma("unroll") for (int n = 0; n < 2; ++n) \
        asm volatile("v_mfma_f32_16x16x128_f8f6f4 %0, %1, %2, %0 cbsz:2 blgp:2" : "+v"(acc[ai][bj][m][n]) : "v"(b6_[n]), "v"(a6_[m])); } \
        else if constexpr (FP8) { _Pragma("unroll") for (int m = 0; m < 4; ++m) _Pragma("unroll") for (int n = 0; n < 2; ++n) \
        asm volatile("v_mfma_f32_16x16x128_f8f6f4 %0, %1, %2, %0" : "+v"(acc[ai][bj][m][n]) : "v"(PG8_CAT(Bt[n])), "v"(PG8_CAT(At[m]))); } \
        else { _Pragma("unroll") for (int m = 0; m < 4; ++m) _Pragma("unroll") for (int n = 0; n < 2; ++n) _Pragma("unroll") for (int k = 0; k < 2; ++k) \
        acc[ai][bj][m][n] = __builtin_amdgcn_mfma_f32_16x16x32_bf16(Bt[n][k], At[m][k], acc[ai][bj][m][n], 0, 0, 0); } __builtin_amdgcn_s_setprio(0); } while (0)
#define PG8_WAIT_V(n) asm volatile("s_waitcnt vmcnt(" #n ")" ::: "memory")
#define PG8_WAIT_L(n) asm volatile("s_waitcnt lgkmcnt(" #n ")" ::: "memory")
#define PG8_BAR __builtin_amdgcn_s_barrier()
#define PG8_SCHED __builtin_amdgcn_sched_barrier(0)
    Unit cur, nxt; int ui = 0;
    __builtin_amdgcn_s_waitcnt(0x0F70);
    if (!S.next(0, cur)) return;
    f32x4 acc[2][2][4][2];
#pragma unroll
    for (int a = 0; a < 2; ++a)
#pragma unroll
        for (int b = 0; b < 2; ++b)
#pragma unroll
            for (int m = 0; m < 4; ++m)
#pragma unroll
                for (int n = 0; n < 2; ++n) acc[a][b][m][n] = (f32x4){0.f, 0.f, 0.f, 0.f};
    bf16x8 At[4][2], B0[2][2], B1[2][2];
    const char* cA = (const char*)g.A + (size_t)cur.pm * tstep; const char* cB = (const char*)g.Bt + (size_t)cur.pn * tstep;
    S.a_ready(cur);
    if constexpr (SP2) {
        PG8_STAGE(PG8_SB(0, 0), cB, voffB); PG8_STAGE(PG8_SB(0, 1), cB + hstep, voffB); PG8_STAGE(PG8_SA(0, 0), cA, voffA); PG8_STAGE(PG8_SA(0, 1), cA + hstep, voffA);
        if (wr == 1) PG8_BAR;
        PG8_WAIT_V(2); PG8_BAR;
        PG8_STAGE(PG8_SB(1, 0), cB + kstep, voffB); PG8_STAGE(PG8_SA(1, 0), cA + kstep, voffA); PG8_STAGE(PG8_SB(1, 1), cB + hstep + kstep, voffB);
        PG8_WAIT_V(6); PG8_BAR;
    } else {
        PG8_STAGE(PG8_SB(0, 0), cB, voffB); PG8_STAGE(PG8_SA(0, 0), cA, voffA); PG8_STAGE(PG8_SB(0, 1), cB + hstep, voffB); PG8_STAGE(PG8_SA(0, 1), cA + hstep, voffA);
        if (wr == 1) PG8_BAR;
        PG8_WAIT_V(4); PG8_BAR;
        PG8_STAGE(PG8_SB(1, 0), cB + kstep, voffB); PG8_STAGE(PG8_SA(1, 0), cA + kstep, voffA); PG8_STAGE(PG8_SB(1, 1), cB + hstep + kstep, voffB);
        PG8_WAIT_V(6); PG8_BAR;
    }
    for (;;) {
        const bool has_next = S.next(ui + 1, nxt);
        const char* nA = has_next ? (const char*)g.A + (size_t)nxt.pm * tstep : cA; const char* nB = has_next ? (const char*)g.Bt + (size_t)nxt.pn * tstep : cB;
        for (int t = 0; t < nt; t += 2) {
            const bool last = (t == nt - 2);
            const char* a1 = cA + (size_t)(t + 1) * kstep;
            const char* a2 = last ? nA : cA + (size_t)(t + 2) * kstep; const char* b2 = last ? nB : cB + (size_t)(t + 2) * kstep;
            const char* a3 = a2 + kstep; const char* b3 = b2 + kstep;
            if (last && has_next) S.a_ready(nxt);
            if constexpr (Epi::HAS_MID) { if (t == Epi::MID_T || t == 2 * Epi::MID_T) E.mid(acc, cur, wr, wc, fr, fq, t / Epi::MID_T - 1); }
            if constexpr (SP2) {
            PG8_LDB(B0, 0, 0); PG8_LDB(B1, 0, 1); PG8_SCHED; PG8_LDA(At, 0, 0); PG8_STAGE(PG8_SA(1, 1), a1 + hstep, voffA);
            PG8_WAIT_V(8); PG8_WAIT_L(0); __builtin_amdgcn_s_setprio(1); PG8_BAR; PG8_MMA(0, 0, At, B0); PG8_MMA(0, 1, At, B1); PG8_BAR; PG8_SCHED;
            PG8_LDA(At, 0, 1); PG8_STAGE(PG8_SB(0, 0), b2, voffB); PG8_STAGE(PG8_SB(0, 1), b2 + hstep, voffB); PG8_STAGE(PG8_SA(0, 0), a2, voffA);
            PG8_WAIT_V(8); PG8_WAIT_L(0); __builtin_amdgcn_s_setprio(1); PG8_BAR; PG8_MMA(1, 0, At, B0); PG8_MMA(1, 1, At, B1); PG8_BAR; PG8_SCHED;
            PG8_LDB(B0, 1, 0); PG8_LDB(B1, 1, 1); PG8_SCHED; PG8_LDA(At, 1, 0); PG8_STAGE(PG8_SA(0, 1), a2 + hstep, voffA);
            PG8_WAIT_V(8); PG8_WAIT_L(0); __builtin_amdgcn_s_setprio(1); PG8_BAR; PG8_MMA(0, 0, At, B0); PG8_MMA(0, 1, At, B1); PG8_BAR; PG8_SCHED;
            PG8_LDA(At, 1, 1); PG8_STAGE(PG8_SB(1, 0), b3, voffB); PG8_STAGE(PG8_SB(1, 1), b3 + hstep, voffB); PG8_STAGE(PG8_SA(1, 0), a3, voffA);
            PG8_WAIT_V(8); PG8_WAIT_L(0); __builtin_amdgcn_s_setprio(1); PG8_BAR; PG8_MMA(1, 0, At, B0); PG8_MMA(1, 1, At, B1); PG8_BAR; PG8_SCHED;
            } else {
            PG8_LDB(B0, 0, 0); PG8_SCHED; PG8_LDA(At, 0, 0); PG8_STAGE(PG8_SA(1, 1), a1 + hstep, voffA);
            PG8_WAIT_L(8); PG8_BAR; PG8_WAIT_L(0); PG8_MMA(0, 0, At, B0); PG8_BAR; PG8_SCHED;
            PG8_LDB(B1, 0, 1); PG8_STAGE(PG8_SB(0, 0), b2, voffB);
            PG8_BAR; PG8_WAIT_L(0); PG8_MMA(0, 1, At, B1); PG8_BAR;
            PG8_LDA(At, 0, 1); PG8_STAGE(PG8_SA(0, 0), a2, voffA);
            PG8_BAR; PG8_WAIT_L(0); PG8_MMA(1, 0, At, B0); PG8_BAR; PG8_SCHED;
            PG8_STAGE(PG8_SB(0, 1), b2 + hstep, voffB);
            PG8_WAIT_V(6); PG8_BAR; PG8_MMA(1, 1, At, B1); PG8_BAR;
            PG8_LDB(B0, 1, 0); PG8_SCHED; PG8_LDA(At, 1, 0); PG8_STAGE(PG8_SA(0, 1), a2 + hstep, voffA);
            PG8_WAIT_L(8); PG8_BAR; PG8_WAIT_L(0); PG8_MMA(0, 0, At, B0); PG8_BAR; PG8_SCHED;
            PG8_LDB(B1, 1, 1); PG8_STAGE(PG8_SB(1, 0), b3, voffB);
            PG8_BAR; PG8_WAIT_L(0); PG8_MMA(0, 1, At, B1); PG8_BAR;
            PG8_LDA(At, 1, 1); PG8_STAGE(PG8_SA(1, 0), a3, voffA);
            PG8_BAR; PG8_WAIT_L(0); PG8_MMA(1, 0, At, B0); PG8_BAR; PG8_SCHED;
            PG8_STAGE(PG8_SB(1, 1), b3 + hstep, voffB);
            PG8_WAIT_V(6); PG8_BAR; PG8_MMA(1, 1, At, B1); PG8_BAR;
            }
        }
        if constexpr (ALIGN_EPI) { if (wr == 0) PG8_BAR; }
        E(acc, cur, wr, wc, fr, fq); S.done(cur);
        if constexpr (Epi::WAIT_AFTER_EPI) __builtin_amdgcn_s_waitcnt(0x0F70);
        if (!has_next) break;
#pragma unroll
        for (int a = 0; a < 2; ++a)
#pragma unroll
            for (int b = 0; b < 2; ++b)
#pragma unroll
                for (int m = 0; m < 4; ++m)
#pragma unroll
                    for (int n = 0; n < 2; ++n) acc[a][b][m][n] = (f32x4){0.f, 0.f, 0.f, 0.f};
        cur = nxt; cA = nA; cB = nB; ++ui;
        if constexpr (ALIGN_EPI) { if (wr == 1) PG8_BAR; }
    }
    PG8_WAIT_V(0);
    if constexpr (!ALIGN_EPI) { if (wr == 0) PG8_BAR; }
    PG8_BAR;
#undef PG8_SA
#undef PG8_SB
#undef PG8_STAGE
#undef PG8_LDA
#undef PG8_LDF
#undef PG8_LDB
#undef PG8_MMA
#undef PG8_CAT
#undef PG8_CAT6
#undef PG8_WAIT_V
#undef PG8_WAIT_L
#undef PG8_BAR
#undef PG8_SCHED
}

template <class Epi, class Sched, bool ALIGN_EPI>
__device__ __forceinline__ void gemm_phase_fp6d(PG8_LAS unsigned char* lds, const Gemm g, const Sched& S, const Epi& E, int wave) {
    int tid_ = wave * 64 + lane_id(); OPQ_V(tid_);
    const int tid = tid_, wid = __builtin_amdgcn_readfirstlane(tid >> 6), lane = tid & 63, wr = wid >> 2, wc = wid & 3, fr = lane & 15, fq = lane >> 4;
    int K_ = g.K; OPQ_S(K_); const int K = K_, nt = K / BK;
    const size_t tstep = (size_t)nt * 24576;
    constexpr int SLOT = 49152, BOFF = 24576, KT = 96, KTG = 24576;
    unsigned voffA[3], voffB[3];
#pragma unroll
    for (int i = 0; i < 3; ++i) { voffA[i] = (unsigned)(i * 512 + tid) * 16u; voffB[i] = voffA[i]; }
    const unsigned ldsw = (unsigned)wid * 1024u;
    const int aoff = (wr * 64 + fr) * KT + 24 * fq, boff = BOFF + (wc * 32 + fr) * KT + 24 * fq;
    typedef int v2i_t __attribute__((ext_vector_type(2)));
    typedef int v4a8_t __attribute__((ext_vector_type(4), aligned(8)));
#define F6_STAGE(slot, pa, pb) do { _Pragma("unroll") for (int _i = 0; _i < 3; ++_i) { \
        __builtin_amdgcn_global_load_lds((const unsigned*)((pa) + voffA[_i]), (PG8_LAS unsigned*)(lds + (slot) * SLOT + ldsw + _i * 8192), 16, 0, 0); \
        __builtin_amdgcn_global_load_lds((const unsigned*)((pb) + voffB[_i]), (PG8_LAS unsigned*)(lds + (slot) * SLOT + BOFF + ldsw + _i * 8192), 16, 0, 0); } } while (0)
#define F6_LD(dst, p) do { const PG8_LAS unsigned char* p_ = (p); const v2i_t a_ = *(const volatile PG8_LAS v2i_t*)p_, b_ = *(const volatile PG8_LAS v2i_t*)(p_ + 8), c_ = *(const volatile PG8_LAS v2i_t*)(p_ + 16); \
        dst = __builtin_shufflevector(__builtin_shufflevector(a_, b_, 0, 1, 2, 3), __builtin_shufflevector(c_, c_, 0, 1, -1, -1), 0, 1, 2, 3, 4, 5); } while (0)
#define F6_WAIT_V(n) asm volatile("s_waitcnt vmcnt(" #n ")" ::: "memory")
#define F6_WAIT_L0 asm volatile("s_waitcnt lgkmcnt(0)" ::: "memory")
#define F6_BAR __builtin_amdgcn_s_barrier()
    Unit cur, nxt; int ui = 0;
    __builtin_amdgcn_s_waitcnt(0x0F70);
    if (!S.next(0, cur)) return;
    f32x4 acc[2][2][4][2];
#pragma unroll
    for (int a = 0; a < 2; ++a)
#pragma unroll
        for (int b = 0; b < 2; ++b)
#pragma unroll
            for (int m = 0; m < 4; ++m)
#pragma unroll
                for (int n = 0; n < 2; ++n) acc[a][b][m][n] = (f32x4){0.f, 0.f, 0.f, 0.f};
    const char* cA = (const char*)g.A + (size_t)cur.pm * tstep; const char* cB = (const char*)g.Bt + (size_t)cur.pn * tstep;
    F6_STAGE(0, cA, cB); F6_STAGE(1, cA + KTG, cB + KTG);
    F6_WAIT_V(0); F6_BAR;
    if (wr == 1) F6_BAR;
    int sr = 0;
    for (;;) {
        const bool has_next = S.next(ui + 1, nxt);
        const char* nA = has_next ? (const char*)g.A + (size_t)nxt.pm * tstep : cA; const char* nB = has_next ? (const char*)g.Bt + (size_t)nxt.pn * tstep : cB;
#pragma unroll 1
        for (int t = 0; t < nt; ++t) {
            const int t2 = t + 2; const char* ta = t2 < nt ? cA + (size_t)t2 * KTG : nA + (size_t)(t2 - nt) * KTG; const char* tb = t2 < nt ? cB + (size_t)t2 * KTG : nB + (size_t)(t2 - nt) * KTG;
            int sw = sr + 2; if (sw >= 3) sw -= 3;
            F6_STAGE(sw, ta, tb);
            v6i_t A6[2][4], B6[2][2];
            const PG8_LAS unsigned char* sp = lds + sr * SLOT;
#pragma unroll
            for (int bj = 0; bj < 2; ++bj)
#pragma unroll
                for (int n = 0; n < 2; ++n) F6_LD(B6[bj][n], sp + boff + (bj * 128 + n * 16) * KT);
#pragma unroll
            for (int ai = 0; ai < 2; ++ai)
#pragma unroll
                for (int m = 0; m < 4; ++m) F6_LD(A6[ai][m], sp + aoff + (ai * 128 + m * 16) * KT);
            if (wr == 1) F6_WAIT_V(6);
            F6_WAIT_L0; F6_BAR;
            __builtin_amdgcn_s_setprio(1);
#pragma unroll
            for (int ai = 0; ai < 2; ++ai)
#pragma unroll
                for (int bj = 0; bj < 2; ++bj)
#pragma unroll
                    for (int m = 0; m < 4; ++m)
#pragma unroll
                        for (int n = 0; n < 2; ++n) asm volatile("v_mfma_f32_16x16x128_f8f6f4 %0, %1, %2, %0 cbsz:2 blgp:2" : "+v"(acc[ai][bj][m][n]) : "v"(B6[bj][n]), "v"(A6[ai][m]));
            __builtin_amdgcn_s_setprio(0);
            if (wr == 0) F6_WAIT_V(6);
            F6_BAR; __builtin_amdgcn_sched_barrier(0);
            sr = sr == 2 ? 0 : sr + 1;
        }
        if constexpr (ALIGN_EPI) { if (wr == 0) F6_BAR; }
        E(acc, cur, wr, wc, fr, fq); S.done(cur);
        if constexpr (Epi::WAIT_AFTER_EPI) __builtin_amdgcn_s_waitcnt(0x0F70);
        if (!has_next) break;
#pragma unroll
        for (int a = 0; a < 2; ++a)
#pragma unroll
            for (int b = 0; b < 2; ++b)
#pragma unroll
                for (int m = 0; m < 4; ++m)
#pragma unroll
                    for (int n = 0; n < 2; ++n) acc[a][b][m][n] = (f32x4){0.f, 0.f, 0.f, 0.f};
        cur = nxt; cA = nA; cB = nB; ++ui;
        if constexpr (ALIGN_EPI) { if (wr == 1) F6_BAR; }
    }
    F6_WAIT_V(0);
    if constexpr (!ALIGN_EPI) { if (wr == 0) F6_BAR; }
    F6_BAR;
#undef F6_STAGE
#undef F6_LD
#undef F6_WAIT_V
#undef F6_WAIT_L0
#undef F6_BAR
}
}

#ifndef PG8_SP2
#define PG8_SP2 true
#endif
#ifndef PG8_ALIGN
#define PG8_ALIGN true
#endif

constexpr int NWAVES = 8;
constexpr int BATCH = 4, SEQ = 2048, D = 4096, DEPTH = 2, M = BATCH * SEQ;
constexpr int DIN = 19736;
constexpr int NZ = 19712;
constexpr int NZP = 19968;
constexpr int GATE_PN = 77;
constexpr int DFF = 16384, NY = 3072;
constexpr int ZC_AQ = 0, ZC_AK = 1024, ZC_AV = 1152, ZC_MQ = 1280, ZC_MK = 1792, ZC_MV = 2304, ZC_MO = 3328, ZC_CQ = 4352, ZC_CK = 5376, ZC_CV = 6400, ZC_GA = 7424;
constexpr float LN_EPS = 1e-5f, DN_ALPHA = 1.41421356237309515f, LOG2E = 1.4426950408889634f;

constexpr size_t MiB = 1u << 20;
constexpr size_t WS_CTL = 0, CTL_ZERO_BYTES = 2 * MiB;
constexpr int NZB = 2560, NZ8 = 17408;
__host__ __device__ constexpr bool z_is_fp8(int n0) { return n0 < 1024 || (n0 >= 3328 && n0 < 19712); }
__host__ __device__ constexpr int z_row(int n0) { return n0 < 1024 ? n0 : n0 < 3328 ? n0 - 1024 : n0 < 19712 ? n0 - 2304 : n0 - 19712 + 2304; }
__host__ __device__ constexpr bool fp6_layer(int l) { return l >= 0; }
__host__ __device__ constexpr float w6_scale(int n0) { return n0 < 1024 ? 512.f : n0 < 4352 ? 128.f : n0 < 5376 ? 1024.f : n0 < 6400 ? 128.f : n0 < 7424 ? 256.f : 128.f; }
constexpr float W8_SCALE = 64.f;
constexpr size_t SZ_WIN = (size_t)NZB * D * 2, SZ_WIN8 = (size_t)NZ8 * D, SZ_WUP = (size_t)D * NY * 2, SZ_WO = (size_t)D * D * 2, SZ_WF = (size_t)DFF * D * 2;
constexpr size_t WS_WIN = 2 * MiB;
constexpr size_t WS_WIN8 = WS_WIN + 2 * SZ_WIN;
constexpr size_t WS_A8 = WS_WIN8 + 2 * SZ_WIN8;
constexpr size_t WS_WUP = WS_A8 + (size_t)M * D;
constexpr size_t WS_WO = WS_WUP + 2 * SZ_WUP;
constexpr size_t WS_WF1 = WS_WO + 2 * SZ_WO;
constexpr size_t WS_WF2 = WS_WF1 + 2 * SZ_WF;
constexpr size_t WS_XB = WS_WF2 + 2 * SZ_WF;
constexpr size_t WS_TA = WS_XB + (size_t)M * D * 2;
constexpr size_t WS_TB = WS_TA + (size_t)M * D * 2;
constexpr size_t WS_Z = WS_TB + (size_t)M * D * 2;
constexpr size_t WS_G = WS_Z + (size_t)M * NZ * 2;
constexpr size_t WS_SC = WS_G + 1 * MiB;
constexpr size_t WS_Y = WS_SC + 1 * MiB;
constexpr size_t WS_MIX = WS_Y + (size_t)M * NY * 2;
constexpr size_t WS_A6 = WS_MIX + (size_t)M * D * 2;
constexpr size_t WS_END = WS_A6 + (size_t)M * D;
static_assert(WS_WIN % 256 == 0 && WS_Z % 256 == 0 && WS_G % 256 == 0 && WS_Y % 256 == 0, "alignment");
constexpr int CW_TMO = 0, CW_BAR = 4096;
constexpr int CW_STAT = 16384, CW_CF1 = CW_STAT + 4 * M * 2 * 2, CW_CIN = CW_CF1 + 2 * 2 * DFF * 2, CW_ZERO = CW_CIN + 2 * NZP * 2, CW_END = CW_ZERO + NZP * 2;
constexpr float FX_S1 = 16777216.f, FX_S2 = 1048576.f, FX_C = 4294967296.f;
static_assert((size_t)CW_END * 4 <= CTL_ZERO_BYTES, "control region");

constexpr int RING_OFF = 0, RING_BYTES = 131072;
constexpr int SCR_BYTES = NWAVES * 64 * 65 * 4;
constexpr int LDSCTL_OFF = 147456, MISC_OFF = LDSCTL_OFF + 320;
constexpr int LDS_BYTES = 151552;
static_assert(SCR_BYTES <= LDSCTL_OFF && MISC_OFF + 128 <= LDS_BYTES, "LDS map");

#define GAS __attribute__((address_space(1)))
#define LAS __attribute__((address_space(3)))
typedef unsigned short bf16;
typedef unsigned v4u __attribute__((ext_vector_type(4)));
typedef unsigned v2u __attribute__((ext_vector_type(2)));
typedef float f32x4 __attribute__((ext_vector_type(4)));
typedef GAS unsigned gu32;
#define RLX_AGENT __ATOMIC_RELAXED, __HIP_MEMORY_SCOPE_AGENT
#define LDS_WAIT() asm volatile("s_waitcnt lgkmcnt(0)" ::: "memory")
#define VM_WAIT() asm volatile("s_waitcnt vmcnt(0)" ::: "memory")
using pg8::cvt_pk_bf16; using pg8::bf_lo; using pg8::bf_hi;

#define XB_TMO      128
#define XB_XCNT(j)  (256  + 64 * (j))
#define XB_XSUB(j)  (1280 + 64 * (j))
#define XB_XGEN(j)  (2304 + 64 * (j))
#define XB_TOP      3328
#define XB_TOPGEN   3392
#define XCD_BAR_WORDS 3456
#define XB_SPIN_CAP (1u << 18)

__device__ __forceinline__ unsigned xb_ld(unsigned* p)              { return __hip_atomic_load(p, __ATOMIC_RELAXED, __HIP_MEMORY_SCOPE_AGENT); }
__device__ __forceinline__ unsigned xb_add(unsigned* p, unsigned v) { return __hip_atomic_fetch_add(p, v, __ATOMIC_RELAXED, __HIP_MEMORY_SCOPE_AGENT); }
__device__ __forceinline__ unsigned xb_xcc_id() { return (unsigned)__builtin_amdgcn_s_getreg((3 << 11) | 20) & 0xFu; }
#define XB_SPIN(cond, bar) do { unsigned _sp = 0; while (cond) { __builtin_amdgcn_s_sleep(1); \
    if ((++_sp & 255u) == 0u) { if (xb_ld(&(bar)[XB_TMO])) break; if (_sp > XB_SPIN_CAP) { atomicAdd(&(bar)[XB_TMO], 1u); break; } } } } while (0)

struct XcdBarrier { unsigned* bar; unsigned x; volatile LAS unsigned* st; int wave; };

__device__ __forceinline__ XcdBarrier xcd_barrier_post(unsigned* bar, volatile LAS unsigned* st) {
    XcdBarrier b; b.bar = bar; b.x = xb_xcc_id(); b.st = st; b.wave = 0;
    if (threadIdx.x == 0) (void)xb_add(&bar[XB_XCNT(b.x)], 1u);
    return b;
}
__device__ __forceinline__ void xcd_barrier_complete(unsigned* bar, unsigned x, unsigned& nloc, unsigned& nx) {
    const unsigned G = gridDim.x * gridDim.y * gridDim.z;
    unsigned sum, cnt, mine, sp = 0u;
    for (;;) {
        sum = 0u; cnt = 0u; mine = 0u;
#pragma unroll
        for (unsigned j = 0; j < 16; ++j) { const unsigned c = xb_ld(&bar[XB_XCNT(j)]); sum += c; cnt += (c > 0u) ? 1u : 0u; mine = (j == x) ? c : mine; }
        if (sum == G) break;
        __builtin_amdgcn_s_sleep(1);
        if ((++sp & 255u) == 0u) { if (xb_ld(&bar[XB_TMO])) break; if (sp > XB_SPIN_CAP) { atomicAdd(&bar[XB_TMO], 1u); break; } }
    }
    nloc = mine > 0u ? mine : 1u; nx = cnt > 0u ? cnt : 1u;
}
__device__ __forceinline__ void xcd_barrier(const XcdBarrier& b) {
    asm volatile("s_waitcnt vmcnt(0)" ::: "memory");
    __syncthreads();
    if (b.wave == 0 && lane_id() == 0) {
        unsigned* bar = b.bar; OPQ_S(bar);
        __builtin_amdgcn_s_waitcnt(0);
        unsigned nloc = b.st[0], nx = b.st[1];
        if (nloc == 0u) { xcd_barrier_complete(bar, b.x, nloc, nx); b.st[0] = nloc; b.st[1] = nx; }
        const unsigned old = xb_add(&bar[XB_XSUB(b.x)], 1u);
        const unsigned gen = old / nloc;
        if (old + 1u == (gen + 1u) * nloc) {
            __builtin_amdgcn_fence(__ATOMIC_RELEASE, "agent");
            asm volatile("s_waitcnt vmcnt(0)" ::: "memory");
            const unsigned og = xb_add(&bar[XB_TOP], 1u);
            const unsigned tg = og / nx;
            if (og + 1u == (tg + 1u) * nx) xb_add(&bar[XB_TOPGEN], 1u);
            else XB_SPIN(xb_ld(&bar[XB_TOPGEN]) == tg, bar);
            __builtin_amdgcn_fence(__ATOMIC_ACQUIRE, "agent");
            xb_add(&bar[XB_XGEN(b.x)], 1u);
            asm volatile("s_waitcnt vmcnt(0)" ::: "memory");
        } else {
            XB_SPIN(xb_ld(&bar[XB_XGEN(b.x)]) == gen, bar);
            __builtin_amdgcn_fence(__ATOMIC_ACQUIRE, "agent");
            asm volatile("s_waitcnt vmcnt(0)" ::: "memory");
        }
    }
    __syncthreads();
}

struct Frame {
    LAS unsigned char* lds;
    volatile LAS unsigned* MISC;
    gu32* ctl;
    int wave;
    int vcu, G;
};

__device__ __forceinline__ float lane_get(float v, int src_lane) { return __int_as_float(__builtin_amdgcn_ds_bpermute(src_lane << 2, __float_as_int(v))); }
__device__ __forceinline__ float wave_sum(float v, int lane) {
#pragma unroll
    for (int o = 1; o < 64; o <<= 1) v += lane_get(v, lane ^ o);
    return v;
}
__device__ __forceinline__ float wave_max(float v, int lane) {
#pragma unroll
    for (int o = 1; o < 64; o <<= 1) v = fmaxf(v, lane_get(v, lane ^ o));
    return v;
}

__device__ __forceinline__ float rbf(float x) { return bf_lo(cvt_pk_bf16(x, x)); }
__device__ __forceinline__ void tr_item(const float* __restrict__ W, int ldw, int k0, int srccol, bf16* __restrict__ WT, size_t ldt, int n0, int kdst, float scale, LAS float* scr, int lane,
                                        const float* __restrict__ gk, const float* __restrict__ bk, pg8::fx64* c1, pg8::fx64* c2, unsigned char* __restrict__ WT8 = nullptr, bool fp6 = false, float wsc = W8_SCALE) {
    const int i = lane & 15, kr = lane >> 4;
    f32x4 a1 = (f32x4){0.f, 0.f, 0.f, 0.f}, a2 = a1; const float c1s = WT8 ? 1.f / wsc : 1.f;
    if (srccol >= 0) {
        f32x4 v[16];
#pragma unroll
        for (int r = 0; r < 16; ++r) v[r] = __builtin_nontemporal_load((const f32x4*)(W + (size_t)(k0 + 4 * r + kr) * ldw + srccol + 4 * i));
#pragma unroll
        for (int r = 0; r < 16; ++r) { LAS float* s = scr + (4 * r + kr) * 65 + 4 * i; float gs = scale, bs = 0.f;
            if (gk) { gs *= gk[k0 + 4 * r + kr]; bs = bk[k0 + 4 * r + kr] * scale; }
#pragma unroll
            for (int j = 0; j < 4; ++j) { const float w = WT8 ? (fp6 ? v_e2m3(v[r][j] * gs) : __builtin_amdgcn_cvt_f32_fp8(__builtin_amdgcn_cvt_pk_fp8_f32(__builtin_amdgcn_fmed3f(v[r][j] * gs, -448.f, 448.f), 0.f, 0, false), 0)) : rbf(v[r][j] * gs); s[j] = w; a1[j] += w; a2[j] += v[r][j] * bs; } }
    } else {
#pragma unroll
        for (int r = 0; r < 16; ++r) { LAS float* s = scr + (4 * r + kr) * 65 + 4 * i; float gs = scale, bs = 0.f;
            if (gk) { gs *= gk[k0 + 4 * r + kr]; bs = bk[k0 + 4 * r + kr] * scale; }
#pragma unroll
            for (int j = 0; j < 4; ++j) { const int cc = 4 * i + j; float val = 0.f;
                if (srccol == -2 && cc < 24) { const int sc = cc < 16 ? 3328 + cc : 7440 + (cc - 16); val = W[(size_t)(k0 + 4 * r + kr) * ldw + sc]; }
                const float w = rbf(val * gs); s[j] = w; a1[j] += w; a2[j] += val * bs; } }
    }
    if (gk) {
#pragma unroll
        for (int j = 0; j < 4; ++j) { a1[j] += lane_get(a1[j], lane ^ 16); a2[j] += lane_get(a2[j], lane ^ 16); a1[j] += lane_get(a1[j], lane ^ 32); a2[j] += lane_get(a2[j], lane ^ 32); }
        if (kr == 0) {
#pragma unroll
            for (int j = 0; j < 4; ++j) { pg8::fx_add(c1 + n0 + 4 * i + j, a1[j] * c1s, FX_C); pg8::fx_add(c2 + n0 + 4 * i + j, a2[j] * c1s, FX_C); } }
    }
    LDS_WAIT(); asm volatile("" ::: "memory");
    if (WT8) {
        const int c = lane & 3, nn = lane >> 2;
#pragma unroll
        for (int jj = 0; jj < 4; ++jj) { const int n = nn + 16 * jj; const LAS float* s = scr + (16 * c) * 65 + n; v4u o;
            if (fp6) { unsigned cd[16];
#pragma unroll
                for (int e = 0; e < 16; ++e) cd[e] = q_e2m3(s[e * 65]);
                store_e2m3_group(e2m3_ktile(WT8, n0 + n, k0 >> 7, true), ((k0 & 64) >> 4) + c, pack16_e2m3(cd)); continue; }
#pragma unroll
            for (int d = 0; d < 4; ++d) { int p = __builtin_amdgcn_cvt_pk_fp8_f32(s[(4 * d) * 65], s[(4 * d + 1) * 65], 0, false); p = __builtin_amdgcn_cvt_pk_fp8_f32(s[(4 * d + 2) * 65], s[(4 * d + 3) * 65], p, true); o[d] = (unsigned)p; }
            __builtin_nontemporal_store(o, (v4u*)(WT8 + (size_t)(n0 + n) * ldt + kdst + k0 + 16 * c)); }
        LDS_WAIT(); asm volatile("" ::: "memory");
        return;
    }
    const int c = lane & 7, nn = lane >> 3;
#pragma unroll
    for (int jj = 0; jj < 8; ++jj) { const int n = nn + 8 * jj; const LAS float* s = scr + (8 * c) * 65 + n;
        v4u o; o.x = cvt_pk_bf16(s[0 * 65], s[1 * 65]); o.y = cvt_pk_bf16(s[2 * 65], s[3 * 65]); o.z = cvt_pk_bf16(s[4 * 65], s[5 * 65]); o.w = cvt_pk_bf16(s[6 * 65], s[7 * 65]);
        __builtin_nontemporal_store(o, (v4u*)(WT + (size_t)(n0 + n) * ldt + kdst + k0 + 8 * c)); }
    LDS_WAIT(); asm volatile("" ::: "memory");
}

struct Args {
    const float* in[16]; float* out; unsigned char* ws; int ph_lo, ph_hi;
};
typedef const __attribute__((address_space(4))) Args* KArgs;

constexpr int I_IN = (D / 64) * (NZP / 64), I_UP = (1024 / 64) * (D / 64), I_O = (D / 64) * (D / 64), I_F1 = (D / 64) * (DFF / 64), I_F2 = (DFF / 64) * (D / 64);
constexpr int I_LAYER = I_IN + 3 * I_UP + I_O + I_F1 + I_F2;
__device__ __forceinline__ void conv_item(KArgs A, int it, LAS float* scr, int lane) {
    const int l = it / I_LAYER; int r = it - l * I_LAYER;
    if (r < I_IN) {
        constexpr int NB = NZP / 64; const int kb = r / NB, nb = r - kb * NB, n0 = nb * 64;
        int srccol; float scale = 1.f;
        if (n0 < 3328) { srccol = n0; if (n0 < 1024) scale = 0.125f * LOG2E; else if (n0 >= ZC_MK && n0 < ZC_MV) scale = 0.125f; }
        else if (n0 < 7424) { srccol = n0 + 16; if (n0 >= ZC_CQ && n0 < ZC_CK) scale = 0.08838834764831845f * LOG2E; }
        else if (n0 < NZ) srccol = n0 + 24;
        else if (n0 == NZ) srccol = -2;
        else srccol = -1;
        pg8::fx64* cf = (pg8::fx64*)((unsigned*)(A->ws + WS_CTL) + CW_CIN);
        if (z_is_fp8(n0)) {
            const int nd = z_row(n0); const float wsc = w6_scale(n0);
            tr_item(A->in[1] + (size_t)l * D * DIN, DIN, kb * 64, srccol, nullptr, D, nd, 0, scale * wsc, scr, lane,
                    l ? A->in[14] : nullptr, l ? A->in[15] : nullptr, cf + (n0 - nd), cf + NZP + (n0 - nd), A->ws + WS_WIN8 + l * SZ_WIN8, true, wsc);
        } else {
            const int nd = z_row(n0);
            tr_item(A->in[1] + (size_t)l * D * DIN, DIN, kb * 64, srccol, (bf16*)(A->ws + WS_WIN + l * SZ_WIN), D, nd, 0, scale, scr, lane,
                    l ? A->in[14] : nullptr, l ? A->in[15] : nullptr, cf + (n0 - nd), cf + NZP + (n0 - nd));
        }
        return;
    }
    r -= I_IN;
    if (r < 3 * I_UP) { const int br = r / I_UP; r -= br * I_UP; constexpr int NB = D / 64; const int kb = r / NB, nb = r - kb * NB;
        tr_item(A->in[6 + br] + (size_t)l * 1024 * D, D, kb * 64, nb * 64, nullptr, NY, nb * 64, br * 1024, W8_SCALE, scr, lane, nullptr, nullptr, nullptr, nullptr, A->ws + WS_WUP + l * SZ_WUP);
        return; }
    r -= 3 * I_UP;
    if (r < I_O) { constexpr int NB = D / 64; const int kb = r / NB, nb = r - kb * NB;
        tr_item(A->in[9] + (size_t)l * D * D, D, kb * 64, nb * 64, nullptr, D, nb * 64, 0, 128.f, scr, lane, nullptr, nullptr, nullptr, nullptr, A->ws + WS_WO + l * SZ_WO);
        return; }
    r -= I_O;
    if (r < I_F1) { constexpr int NB = DFF / 64; const int kb = r / NB, nb = r - kb * NB;
        pg8::fx64* cf = (pg8::fx64*)((unsigned*)(A->ws + WS_CTL) + CW_CF1) + l * 2 * DFF;
        tr_item(A->in[12] + (size_t)l * D * DFF, DFF, kb * 64, nb * 64, (bf16*)(A->ws + WS_WF1 + l * SZ_WF), D, nb * 64, 0, 1.f, scr, lane, A->in[10] + l * D, A->in[11] + l * D, cf, cf + DFF);
        return; }
    r -= I_F1;
    { constexpr int NB = D / 64; const int kb = r / NB, nb = r - kb * NB;
        tr_item(A->in[13] + (size_t)l * DFF * D, D, kb * 64, nb * 64, (bf16*)(A->ws + WS_WF2 + l * SZ_WF), DFF, nb * 64, 0, 1.f, scr, lane, nullptr, nullptr, nullptr, nullptr); }
}
__device__ __forceinline__ void p0_prologue(Frame& F, KArgs A_) {
    KArgs A = A_; OPQ_S(A);
    int tid = F.wave * 64 + lane_id(); OPQ_V(tid); const int lane = tid & 63;
    LAS float* scr = (LAS float*)(F.lds) + F.wave * (64 * 65);
    const int gw = F.vcu * NWAVES + F.wave, NGW = F.G * NWAVES;
#if defined(MIX_NAIVE)
    for (int it = gw; it < DEPTH * I_LAYER; it += NGW) conv_item(A, it, scr, lane);
#else
    for (int it = gw; it < I_IN; it += NGW) conv_item(A, it, scr, lane);
#endif
    const f32x4* xs = (const f32x4*)A->in[0];
    {
        const size_t n16 = (size_t)M * D / 16, st = (size_t)F.G * 512; size_t i = (size_t)(F.vcu * 512 + tid);
        v4u* xb2 = (v4u*)(A->ws + WS_XB); v4u* x6 = (v4u*)(A->ws + WS_A6);
#define X_CHUNK(ci, q0, q1, q2, q3) do { const f32x4 q_[4] = {q0, q1, q2, q3}; v4u o0, o1, o6; unsigned cd[16]; \
            o0.x = cvt_pk_bf16(q_[0][0], q_[0][1]); o0.y = cvt_pk_bf16(q_[0][2], q_[0][3]); o0.z = cvt_pk_bf16(q_[1][0], q_[1][1]); o0.w = cvt_pk_bf16(q_[1][2], q_[1][3]); \
            o1.x = cvt_pk_bf16(q_[2][0], q_[2][1]); o1.y = cvt_pk_bf16(q_[2][2], q_[2][3]); o1.z = cvt_pk_bf16(q_[3][0], q_[3][1]); o1.w = cvt_pk_bf16(q_[3][2], q_[3][3]); \
                        _Pragma("unroll") for (int e_ = 0; e_ < 16; ++e_) cd[e_] = q_e2m3(q_[e_ >> 2][e_ & 3] * pg8::A6_SCALE); \
            o6 = pack16_e2m3(cd); \
            xb2[2 * (ci)] = o0; xb2[2 * (ci) + 1] = o1; store_e2m3_group(e2m3_ktile((unsigned char*)x6, (int)((ci) >> 8), (int)(((ci) >> 3) & 31), false), (int)((ci) & 7), o6); } while (0)
#pragma unroll 1
        for (; i + st < n16; i += 2 * st) {
            f32x4 v[2][4];
#pragma unroll
            for (int u = 0; u < 2; ++u)
#pragma unroll
                for (int q = 0; q < 4; ++q) v[u][q] = __builtin_nontemporal_load(xs + (i + u * st) * 4 + q);
#pragma unroll
            for (int u = 0; u < 2; ++u) X_CHUNK(i + u * st, v[u][0], v[u][1], v[u][2], v[u][3]);
        }
#pragma unroll 1
        for (; i < n16; i += st) { const f32x4 v0 = xs[i * 4], v1 = xs[i * 4 + 1], v2 = xs[i * 4 + 2], v3 = xs[i * 4 + 3]; X_CHUNK(i, v0, v1, v2, v3); }
#undef X_CHUNK
    }
}

__device__ __forceinline__ void lnout_phase(Frame& F, const bf16* __restrict__ T, const pg8::fx64* __restrict__ st, const float* __restrict__ g, const float* __restrict__ b, float* __restrict__ xo) {
    int lane = lane_id(); OPQ_V(lane); int gw = F.vcu * NWAVES + F.wave; OPQ_S(gw); const int NGW = F.G * NWAVES;
    for (int row = gw; row < M; row += NGW) {
        const float s1 = (float)st[2 * (size_t)row] * (1.f / FX_S1), s2 = (float)st[2 * (size_t)row + 1] * (1.f / FX_S2);
        const float mean = s1 * (1.f / D), rstd = __builtin_amdgcn_rsqf(fmaxf(s2 * (1.f / D) - mean * mean, 0.f) + LN_EPS), rm = rstd * mean;
        const v4u* tr = (const v4u*)(T + (size_t)row * D) + lane;
#pragma unroll 2
        for (int j = 0; j < 8; ++j) { const int c0 = 8 * (lane + 64 * j); const v4u w = tr[64 * j];
            const f32x4 g0 = *(const f32x4*)(g + c0), g1 = *(const f32x4*)(g + c0 + 4), b0 = *(const f32x4*)(b + c0), b1 = *(const f32x4*)(b + c0 + 4);
            *(f32x4*)(xo + (size_t)row * D + c0) = ((f32x4){bf_lo(w.x), bf_hi(w.x), bf_lo(w.y), bf_hi(w.y)} * rstd - rm) * g0 + b0;
            *(f32x4*)(xo + (size_t)row * D + c0 + 4) = ((f32x4){bf_lo(w.z), bf_hi(w.z), bf_lo(w.w), bf_hi(w.w)} * rstd - rm) * g1 + b1; }
    }
}

__device__ __forceinline__ float log_sigmoid(float x) { return fminf(x, 0.f) - log1pf(expf(-fabsf(x))); }
__device__ __forceinline__ void scan_phase(Frame& F, KArgs A_, int l) {
    KArgs A = A_; OPQ_S(A);
    int lane = lane_id(); OPQ_V(lane); int gw = F.vcu * NWAVES + F.wave; OPQ_S(gw); const int NGW = F.G * NWAVES;
    const float* G = (const float*)(A->ws + WS_G); float* SC = (float*)(A->ws + WS_SC);
    for (int it = gw; it < 64; it += NGW) {
        const int fox = it >> 5, bh = it & 31, b = bh >> 3, h = bh & 7;
        const float* fp = G + (size_t)((fox ? 16 : 8) + h) * M + b * SEQ + 32 * lane;
        const float bf = fox ? A->in[4][l * 8 + h] : A->in[3][l * 8 + h];
        float Fv[32]; float run = 0.f;
#pragma unroll
        for (int j = 0; j < 32; ++j) { run += log_sigmoid(fp[j] + bf); Fv[j] = run; }
        float inc = run;
#pragma unroll
        for (int o = 1; o < 64; o <<= 1) { const float t = lane_get(inc, lane - o); if (lane >= o) inc += t; }
        const float excl = inc - run;
        const size_t ob = (size_t)bh * SEQ + 32 * lane;
        if (fox) {
#pragma unroll
            for (int j = 0; j < 32; ++j) SC[ob + j] = -(Fv[j] + excl) * LOG2E;
        } else {
            const float* ip = G + (size_t)h * M + b * SEQ + 32 * lane; const float bi = A->in[2][l * 8 + h];
            float av[32]; float rm = -3.0e38f;
#pragma unroll
            for (int j = 0; j < 32; ++j) { Fv[j] += excl; av[j] = (ip[j] + bi) - Fv[j]; rm = fmaxf(rm, av[j]); }
            float incm = rm;
#pragma unroll
            for (int o = 1; o < 64; o <<= 1) { const float t = lane_get(incm, lane - o); if (lane >= o) incm = fmaxf(incm, t); }
            float pre = lane_get(incm, lane - 1); if (lane == 0) pre = 0.f; pre = fmaxf(pre, 0.f);
            float rr = pre;
#pragma unroll
            for (int j = 0; j < 32; ++j) { rr = fmaxf(rr, av[j]); SC[(size_t)32 * SEQ + ob + j] = av[j] * LOG2E; SC[(size_t)64 * SEQ + ob + j] = rr * LOG2E; SC[(size_t)96 * SEQ + ob + j] = expf(-(Fv[j] + rr)); }
        }
    }
}

#if defined(MIX_NAIVE)
__device__ __forceinline__ float dot8(const v4u a, const v4u b) {
    return bf_lo(a.x) * bf_lo(b.x) + bf_hi(a.x) * bf_hi(b.x) + bf_lo(a.y) * bf_lo(b.y) + bf_hi(a.y) * bf_hi(b.y) + bf_lo(a.z) * bf_lo(b.z) + bf_hi(a.z) * bf_hi(b.z) + bf_lo(a.w) * bf_lo(b.w) + bf_hi(a.w) * bf_hi(b.w);
}
__device__ __forceinline__ void mixers_naive(Frame& F, KArgs A_, int l) {
    KArgs A = A_; OPQ_S(A);
    int lane = lane_id(); OPQ_V(lane); int gw = F.vcu * NWAVES + F.wave; OPQ_S(gw); const int NGW = F.G * NWAVES;
    const bf16* Z = (const bf16*)(A->ws + WS_Z); bf16* Y = (bf16*)(A->ws + WS_Y); const float* SC = (const float*)(A->ws + WS_SC);
    LAS float* sbuf = (LAS float*)(F.lds) + F.wave * 2048;
    for (int it = gw; it < M * 16; it += NGW) {
        const int hq = it & 15, row = it >> 4, t = row & (SEQ - 1), kvh = hq >> 3;
        const v4u* qp = (const v4u*)(Z + (size_t)row * NZ + ZC_AQ + hq * 64);
        v4u qv[8];
#pragma unroll
        for (int c = 0; c < 8; ++c) qv[c] = qp[c];
        const float slope = exp2f(-0.5f * (float)(hq + 1)) * LOG2E, sink = A->in[5][l * 16 + hq] * LOG2E;
        float sc[2];
#pragma unroll
        for (int kk = 0; kk < 2; ++kk) { const int s = t - 127 + lane + 64 * kk; float d = -__builtin_inff();
            if (s >= 0) { const v4u* kp = (const v4u*)(Z + (size_t)(row - t + s) * NZ + ZC_AK + kvh * 64); float a = 0.f;
#pragma unroll
                for (int c = 0; c < 8; ++c) a += dot8(qv[c], kp[c]);
                d = a - slope * (float)(t - s); }
            sc[kk] = d; }
        const float mx = fmaxf(wave_max(fmaxf(sc[0], sc[1]), lane), sink);
        const float p0 = __builtin_amdgcn_exp2f(sc[0] - mx), p1 = __builtin_amdgcn_exp2f(sc[1] - mx);
        const float den = wave_sum(p0 + p1, lane) + __builtin_amdgcn_exp2f(sink - mx);
        float acc = 0.f;
#pragma unroll
        for (int kk = 0; kk < 2; ++kk) { const float pk = kk ? p1 : p0;
#pragma unroll 8
            for (int j = 0; j < 64; ++j) { const int s = t - 127 + j + 64 * kk; const float pj = lane_get(pk, j);
                if (s >= 0) acc += pj * __uint_as_float((unsigned)Z[(size_t)(row - t + s) * NZ + ZC_AV + kvh * 64 + lane] << 16); } }
        const float o = acc / den; const unsigned ob = cvt_pk_bf16(o, o);
        Y[(size_t)row * NY + hq * 64 + lane] = (bf16)(ob & 0xffffu);
    }
    for (int it = gw; it < 2 * 32 * SEQ; it += NGW) {
        const int fox = it >= 32 * SEQ; const int i2 = fox ? it - 32 * SEQ : it; const int bh = i2 & 31, t = i2 >> 5, b = bh >> 3, h = bh & 7;
        const size_t row = (size_t)b * SEQ + t; const int nkb = (t >> 6) + 1;
        const int qc = fox ? ZC_CQ + h * 128 : ZC_MQ + h * 64, kc = fox ? ZC_CK + h * 128 : ZC_MK + h * 64, vc = fox ? ZC_CV + h * 128 : ZC_MV + h * 128;
        const int nch = fox ? 16 : 8;
        const v4u* qp = (const v4u*)(Z + row * NZ + qc);
        v4u qv[16];
#pragma unroll
        for (int c = 0; c < 16; ++c) qv[c] = (c < nch) ? qp[c] : (v4u){0u, 0u, 0u, 0u};
        const float* bias = SC + (size_t)(fox ? 0 : 32) * SEQ + (size_t)bh * SEQ;
        const float RL = fox ? 0.f : SC[(size_t)64 * SEQ + (size_t)bh * SEQ + t];
        float mx = -__builtin_inff();
        for (int kb = 0; kb < nkb; ++kb) { const int s = kb * 64 + lane; float val = fox ? -__builtin_inff() : 0.f;
            if (s <= t) { const v4u* kp = (const v4u*)(Z + ((size_t)b * SEQ + s) * NZ + kc); float a = 0.f;
#pragma unroll
                for (int c = 0; c < 16; ++c) if (c < nch) a += dot8(qv[c], kp[c]);
                val = fox ? a + bias[s] : a * __builtin_amdgcn_exp2f(bias[s] - RL); }
            sbuf[s] = val; mx = fmaxf(mx, val); }
        float den;
        if (fox) { mx = wave_max(mx, lane); float sum = 0.f;
            for (int kb = 0; kb < nkb; ++kb) { const int s = kb * 64 + lane; const float p = __builtin_amdgcn_exp2f(sbuf[s] - mx); sbuf[s] = p; sum += p; }
            den = wave_sum(sum, lane);
        } else { float sum = 0.f;
            for (int kb = 0; kb < nkb; ++kb) sum += sbuf[kb * 64 + lane];
            den = wave_sum(sum, lane); den = fmaxf(fabsf(den), SC[(size_t)96 * SEQ + (size_t)bh * SEQ + t]); }
        LDS_WAIT(); asm volatile("" ::: "memory");
        float a0 = 0.f, a1 = 0.f;
        const bf16* vp = Z + ((size_t)b * SEQ) * NZ + vc + 2 * lane;
#pragma unroll 8
        for (int s = 0; s <= t; ++s) { const float p = sbuf[s]; const unsigned w = *(const unsigned*)(vp + (size_t)s * NZ); a0 += p * bf_lo(w); a1 += p * bf_hi(w); }
        a0 /= den; a1 /= den;
        if (!fox) { const unsigned w = *(const unsigned*)(Z + row * NZ + ZC_MO + h * 128 + 2 * lane);
            a0 *= 1.f / (1.f + expf(-bf_lo(w))); a1 *= 1.f / (1.f + expf(-bf_hi(w))); }
        *(unsigned*)(Y + row * NY + (fox ? 2048 : 1024) + h * 128 + 2 * lane) = cvt_pk_bf16(a0, a1);
        LDS_WAIT(); asm volatile("" ::: "memory");
    }
}


#endif
typedef float f32x16 __attribute__((ext_vector_type(16)));
typedef short s16x8 __attribute__((ext_vector_type(8)));
typedef short s16x4 __attribute__((ext_vector_type(4)));
constexpr int MX_KB0 = 0, MX_KB1 = 64 * 272, MX_VB0 = 2 * 64 * 272, MX_VB1 = MX_VB0 + 64 * 320, MX_QW = MX_VB1 + 64 * 320;
constexpr int MX_SC_A = 77824, MX_SC_R = MX_SC_A + 8192, MX_SC_E = MX_SC_R + 1024, MX_SC_W = MX_SC_E + 1024;
static_assert(MX_QW <= MX_SC_A && MX_SC_W + 64 <= RING_BYTES, "mixer LDS");
static_assert(16.f * 128.f == 2048.f && W8_SCALE == 64.f && NZB == 10 * 256 && NZ8 == 68 * 256, "EpiRes::ascale == 1 / (MIX8_SCALE * WO8_SCALE); EpiZ constants");
constexpr float Y8_SCALE = 8.f, MIX8_SCALE = 16.f, WO8_SCALE = 128.f;
constexpr float MX_THR = 8.f;
__device__ __forceinline__ float swap32_max(float v) { auto rr = __builtin_amdgcn_permlane32_swap(__float_as_uint(v), __float_as_uint(v), false, false); return fmaxf(__uint_as_float(rr[0]), __uint_as_float(rr[1])); }
__device__ __forceinline__ float swap32_add(float v) { auto rr = __builtin_amdgcn_permlane32_swap(__float_as_uint(v), __float_as_uint(v), false, false); return __uint_as_float(rr[0]) + __uint_as_float(rr[1]); }
__device__ __forceinline__ s16x4 vtr(const LAS unsigned char* p) { return __builtin_bit_cast(s16x4, __builtin_amdgcn_ds_read_tr16_b64_v4i16((LAS s16x4*)p)); }

template <int MODE>
__device__ __forceinline__ void mixer_scan(LAS unsigned char* lds, const float* __restrict__ G, float bias_f, float bias_i, int b, int h, int qb, int wave, int lane) {
    LAS float* key = (LAS float*)(lds + MX_SC_A); LAS float* rl = (LAS float*)(lds + MX_SC_R); LAS float* em = (LAS float*)(lds + MX_SC_E); LAS float* wt = (LAS float*)(lds + MX_SC_W);
    const int tid = wave * 64 + lane, s0 = 4 * tid, nk = 256 * (qb + 1); const bool act = s0 < nk;
    f32x4 fv = (f32x4){0.f, 0.f, 0.f, 0.f}, iv = fv;
    if (act) { fv = *(const f32x4*)(G + (size_t)((MODE == 2 ? 16 : 8) + h) * M + (size_t)b * SEQ + s0); if (MODE == 1) iv = *(const f32x4*)(G + (size_t)h * M + (size_t)b * SEQ + s0); }
    float Fv[4]; float run = 0.f;
#pragma unroll
    for (int j = 0; j < 4; ++j) { run += act ? log_sigmoid(fv[j] + bias_f) : 0.f; Fv[j] = run; }
    float inc = run;
#pragma unroll
    for (int o = 1; o < 64; o <<= 1) { const float t = lane_get(inc, lane - o); if (lane >= o) inc += t; }
    if (lane == 63) wt[wave] = inc;
    __syncthreads();
    float off = inc - run;
#pragma unroll
    for (int w = 0; w < NWAVES; ++w) if (w < wave) off += wt[w];
    if (MODE == 2) {
        if (act) *(LAS f32x4*)(key + s0) = (f32x4){-(Fv[0] + off) * LOG2E, -(Fv[1] + off) * LOG2E, -(Fv[2] + off) * LOG2E, -(Fv[3] + off) * LOG2E};
    } else {
        float av[4], mv[4]; float rm = -3.0e38f;
#pragma unroll
        for (int j = 0; j < 4; ++j) { Fv[j] += off; av[j] = act ? (iv[j] + bias_i) - Fv[j] : -3.0e38f; rm = fmaxf(rm, av[j]); mv[j] = rm; }
        float incm = rm;
#pragma unroll
        for (int o = 1; o < 64; o <<= 1) { const float t = lane_get(incm, lane - o); if (lane >= o) incm = fmaxf(incm, t); }
        if (lane == 63) wt[8 + wave] = incm;
        float pre = lane_get(incm, lane - 1); if (lane == 0) pre = 0.f;
        __syncthreads();
        pre = fmaxf(pre, 0.f);
#pragma unroll
        for (int w = 0; w < NWAVES; ++w) if (w < wave) pre = fmaxf(pre, wt[8 + w]);
        if (act) { *(LAS f32x4*)(key + s0) = (f32x4){av[0] * LOG2E, av[1] * LOG2E, av[2] * LOG2E, av[3] * LOG2E};
            const int r0 = s0 - 256 * qb;
            if (r0 >= 0) {
#pragma unroll
                for (int j = 0; j < 4; ++j) { const float R = fmaxf(pre, mv[j]); rl[r0 + j] = R * LOG2E; em[r0 + j] = expf(-(Fv[j] + R)); } } }
    }
    __syncthreads();
}

template <int MODE>
__device__ __forceinline__ void mixer_unit(LAS unsigned char* lds, const bf16* __restrict__ Z, bf16* __restrict__ Y, const float* __restrict__ G, float gb_f, float gb_i, float sink_l2, int b, int h, int qb, int wave, int lane) {
    constexpr int DQK = (MODE == 2) ? 128 : 64, DV = (MODE == 0) ? 64 : 128;
    constexpr int KP = DQK * 2 + 16, VP = (DV == 128) ? 320 : 192;
    constexpr int NKD = DQK / 16, NDB = DV / 32, KCH = DQK / 8, VCH = DV / 8, KLD = 64 * KCH / 512, VLD = 64 * VCH / 512;
    const int c = lane & 31, hi = lane >> 5, tid = wave * 64 + lane;
    const int qc = (MODE == 0) ? ZC_AQ + h * 64 : (MODE == 1) ? ZC_MQ + h * 64 : ZC_CQ + h * 128;
    const int kc = (MODE == 0) ? ZC_AK + (h >> 3) * 64 : (MODE == 1) ? ZC_MK + h * 64 : ZC_CK + h * 128;
    const int vc = (MODE == 0) ? ZC_AV + (h >> 3) * 64 : (MODE == 1) ? ZC_MV + h * 128 : ZC_CV + h * 128;
    const int yc = (MODE == 0) ? h * 64 : (MODE == 1) ? 1024 + h * 128 : 2048 + h * 128;
    const size_t rowb = (size_t)b * SEQ;
    const int q0w = 256 * qb + 32 * wave, qabs = q0w + c;
    const int j_lo = (MODE == 0) ? (qb > 0 ? 4 * qb - 2 : 0) : 0, j_hi = 4 * qb + 4;
    if (MODE != 0) mixer_scan<MODE>(lds, G, gb_f, gb_i, b, h, qb, wave, lane);
    const LAS float* bias = (const LAS float*)(lds + MX_SC_A);
    s16x8 qf[NKD];
    { const bf16* qp = Z + (rowb + qabs) * NZ + qc + 8 * hi;
#pragma unroll
      for (int kd = 0; kd < NKD; ++kd) qf[kd] = *(const s16x8*)(qp + 16 * kd); }
    f32x16 O[NDB];
#pragma unroll
    for (int db = 0; db < NDB; ++db)
#pragma unroll
        for (int r = 0; r < 16; ++r) O[db][r] = 0.f;
    float m = (MODE == 0) ? sink_l2 : -1.0e30f, lsum = (MODE == 0 && hi == 0) ? 1.f : 0.f;
    const float RL = (MODE == 1) ? ((const LAS float*)(lds + MX_SC_R))[32 * wave + c] : 0.f;
    const float slope = (MODE == 0) ? exp2f(-0.5f * (float)(h + 1)) * LOG2E : 0.f;
    v4u kr0[KLD], vr0[VLD], kr1[KLD], vr1[VLD];
#define MX_LOADG(KR, VR, j) do { _Pragma("unroll") for (int i_ = 0; i_ < KLD; ++i_) { const int cid = tid + 512 * i_, row = cid / KCH, cc = cid % KCH; KR[i_] = *(const v4u*)(Z + (rowb + 64 * (j) + row) * NZ + kc + 8 * cc); } \
        _Pragma("unroll") for (int i_ = 0; i_ < VLD; ++i_) { const int cid = tid + 512 * i_, row = cid / VCH, cc = cid % VCH; VR[i_] = *(const v4u*)(Z + (rowb + 64 * (j) + row) * NZ + vc + 8 * cc); } } while (0)
#define MX_STORE(KR, VR, bufi) do { _Pragma("unroll") for (int i_ = 0; i_ < KLD; ++i_) { const int cid = tid + 512 * i_, row = cid / KCH, cc = cid % KCH; *(LAS v4u*)(lds + ((bufi) ? MX_KB1 : MX_KB0) + row * KP + 16 * cc) = KR[i_]; } \
        _Pragma("unroll") for (int i_ = 0; i_ < VLD; ++i_) { const int cid = tid + 512 * i_, row = cid / VCH, cc = cid % VCH; *(LAS v4u*)(lds + ((bufi) ? MX_VB1 : MX_VB0) + row * VP + 16 * cc) = VR[i_]; } } while (0)
    MX_LOADG(kr1, vr1, j_lo); MX_STORE(kr1, vr1, 0);
    MX_LOADG(kr1, vr1, j_lo + 1);
    __syncthreads();
#pragma unroll
    for (int kd = 0; kd < NKD; ++kd) asm volatile("" : "+v"(qf[kd]));
    const int kbase = c * KP + 16 * hi;
    const int vbase = (4 * hi + ((lane & 15) >> 2)) * VP + (16 * ((lane >> 4) & 1) + 4 * (lane & 3)) * 2;
    auto step = [&](const int j, v4u (&ka)[KLD], v4u (&va)[VLD], v4u (&kb_)[KLD], v4u (&vb_)[VLD]) __attribute__((always_inline)) {
        const int cur = (j - j_lo) & 1;
        { const int jn = (j + 2 < j_hi) ? j + 2 : j_hi - 1; MX_LOADG(ka, va, jn); }
        bool active = 64 * j <= q0w + 31;
        if (MODE == 0) active = active && (64 * j + 63 >= q0w - 127);
        if (active) {
            const LAS unsigned char* Kb = lds + (cur ? MX_KB1 : MX_KB0) + kbase;
            const LAS unsigned char* Vb = lds + (cur ? MX_VB1 : MX_VB0) + vbase;
            f32x16 p[2];
#pragma unroll
            for (int kb = 0; kb < 2; ++kb) {
#pragma unroll
                for (int r = 0; r < 16; ++r) p[kb][r] = 0.f;
                { s16x8 kf[NKD];
#pragma unroll
                  for (int kd = 0; kd < NKD; ++kd) kf[kd] = *(const LAS s16x8*)(Kb + (32 * kb) * KP + 32 * kd);
                  __builtin_amdgcn_sched_barrier(0);
#pragma unroll
                  for (int kd = 0; kd < NKD; ++kd) p[kb] = __builtin_amdgcn_mfma_f32_32x32x16_bf16(kf[kd], qf[kd], p[kb], 0, 0, 0); }
            }
            const bool need_mask = (64 * j + 63 > q0w) || (MODE == 0 && 64 * j < q0w + 31 - 127);
            const int krel = qabs - 64 * j - 4 * hi;
            float den_t = 0.f;
            if (MODE == 1) {
#pragma unroll
                for (int kb = 0; kb < 2; ++kb) { const LAS float* bp = bias + 64 * j + 32 * kb + 4 * hi;
#pragma unroll
                    for (int g = 0; g < 4; ++g) { const f32x4 a4 = *(const LAS f32x4*)(bp + 8 * g);
#pragma unroll
                        for (int e = 0; e < 4; ++e) { const int r = 4 * g + e; float v = p[kb][r] * __builtin_amdgcn_exp2f(a4[e] - RL);
                            if (need_mask && (32 * kb + 8 * g + e) > krel) v = 0.f;
                            den_t += v; p[kb][r] = v; } } }
                lsum += den_t;
            } else {
                float tmax = -__builtin_inff();
#pragma unroll
                for (int kb = 0; kb < 2; ++kb) {
                    f32x4 b4[4];
                    if (MODE == 2) { const LAS float* bp = bias + 64 * j + 32 * kb + 4 * hi;
#pragma unroll
                        for (int g = 0; g < 4; ++g) b4[g] = *(const LAS f32x4*)(bp + 8 * g); }
#pragma unroll
                    for (int r = 0; r < 16; ++r) { const int ko = 32 * kb + 8 * (r >> 2) + (r & 3);
                        float s = p[kb][r];
                        if (MODE == 2) { s += b4[r >> 2][r & 3]; if (need_mask && ko > krel) s = -__builtin_inff(); }
                        else { const int dist = krel - ko; s -= slope * (float)dist; if (need_mask && (unsigned)dist >= 128u) s = -__builtin_inff(); }
                        p[kb][r] = s; tmax = fmaxf(tmax, s); }
                }
                tmax = swap32_max(tmax);
                if (!__all(tmax <= m + MX_THR)) {
                    const float mn = fmaxf(m, tmax), alpha = __builtin_amdgcn_exp2f(m - mn); m = mn; lsum *= alpha;
#pragma unroll
                    for (int db = 0; db < NDB; ++db)
#pragma unroll
                        for (int r = 0; r < 16; ++r) O[db][r] *= alpha;
                }
#pragma unroll
                for (int kb = 0; kb < 2; ++kb)
#pragma unroll
                    for (int r = 0; r < 16; ++r) { const float e = __builtin_amdgcn_exp2f(p[kb][r] - m); den_t += e; p[kb][r] = e; }
                lsum += den_t;
            }
            s16x8 pb[2][2];
#pragma unroll
            for (int kb = 0; kb < 2; ++kb)
#pragma unroll
                for (int s = 0; s < 2; ++s) { v4u w; w.x = cvt_pk_bf16(p[kb][8 * s + 0], p[kb][8 * s + 1]); w.y = cvt_pk_bf16(p[kb][8 * s + 2], p[kb][8 * s + 3]); w.z = cvt_pk_bf16(p[kb][8 * s + 4], p[kb][8 * s + 5]); w.w = cvt_pk_bf16(p[kb][8 * s + 6], p[kb][8 * s + 7]);
                    pb[kb][s] = __builtin_bit_cast(s16x8, w); }
#pragma unroll
            for (int db = 0; db < NDB; ++db) { s16x4 vlo[2][2], vhi[2][2];
#pragma unroll
                for (int kb = 0; kb < 2; ++kb)
#pragma unroll
                    for (int s = 0; s < 2; ++s) { vlo[kb][s] = vtr(Vb + (32 * kb + 16 * s) * VP + 64 * db); vhi[kb][s] = vtr(Vb + (32 * kb + 16 * s + 8) * VP + 64 * db); }
                __builtin_amdgcn_sched_barrier(0);
#pragma unroll
                for (int kb = 0; kb < 2; ++kb)
#pragma unroll
                    for (int s = 0; s < 2; ++s) { const s16x4 lo = vlo[kb][s], hh = vhi[kb][s];
                        const s16x8 a = (s16x8){lo[0], lo[1], lo[2], lo[3], hh[0], hh[1], hh[2], hh[3]};
                        O[db] = __builtin_amdgcn_mfma_f32_32x32x16_bf16(a, pb[kb][s], O[db], 0, 0, 0); } }
        }
        MX_STORE(kb_, vb_, cur ^ 1);
        __syncthreads();
    };
    for (int j = j_lo; j < j_hi; j += 2) { step(j, kr0, vr0, kr1, vr1); step(j + 1, kr1, vr1, kr0, vr0); }
#undef MX_LOADG
#undef MX_STORE
    const float tot = swap32_add(lsum);
    float inv;
    if (MODE == 1) inv = 1.f / fmaxf(fabsf(tot), ((const LAS float*)(lds + MX_SC_E))[32 * wave + c]);
    else inv = 1.f / tot;
    unsigned char* yp = (unsigned char*)Y + (rowb + qabs) * NY + yc + 4 * hi;
    const bf16* op = Z + (rowb + qabs) * NZ + ZC_MO + h * 128 + 4 * hi;
#pragma unroll
    for (int db = 0; db < NDB; ++db)
#pragma unroll
        for (int g = 0; g < 4; ++g) { float o0 = O[db][4 * g] * inv, o1 = O[db][4 * g + 1] * inv, o2 = O[db][4 * g + 2] * inv, o3 = O[db][4 * g + 3] * inv;
            if (MODE == 1) { const v2u gw = *(const v2u*)(op + 32 * db + 8 * g);
                o0 *= __builtin_amdgcn_rcpf(1.f + __builtin_amdgcn_exp2f(-LOG2E * bf_lo(gw.x))); o1 *= __builtin_amdgcn_rcpf(1.f + __builtin_amdgcn_exp2f(-LOG2E * bf_hi(gw.x)));
                o2 *= __builtin_amdgcn_rcpf(1.f + __builtin_amdgcn_exp2f(-LOG2E * bf_lo(gw.y))); o3 *= __builtin_amdgcn_rcpf(1.f + __builtin_amdgcn_exp2f(-LOG2E * bf_hi(gw.y))); }
            *(int*)(yp + 32 * db + 8 * g) = pk4_e4m3(o0 * Y8_SCALE, o1 * Y8_SCALE, o2 * Y8_SCALE, o3 * Y8_SCALE); }
}

constexpr int CW_QUEUE = 8192;
constexpr int MX_UNITS = 512 + 512;
constexpr int CV_CHUNK = 64;
__device__ __forceinline__ void mixers_mfma(Frame& F, KArgs A_, int l) {
    KArgs A = A_; OPQ_S(A);
    int lane = lane_id(); OPQ_V(lane);
    const bf16* Z = (const bf16*)(A->ws + WS_Z); bf16* Y = (bf16*)(A->ws + WS_Y); const float* G = (const float*)(A->ws + WS_G);
    unsigned* qhead = (unsigned*)(A->ws + WS_CTL) + CW_QUEUE + 64 * l;
    volatile LAS unsigned* qw = F.MISC + 16;
    LAS float* scr = (LAS float*)(F.lds) + F.wave * (64 * 65);
    const int cv_lo = l ? I_LAYER + I_IN : I_IN, cv_n = ((l ? 2 * I_LAYER : I_LAYER + I_IN) - cv_lo) / CV_CHUNK;
    static_assert(I_IN % CV_CHUNK == 0 && I_LAYER % CV_CHUNK == 0 && (I_LAYER - I_IN) / CV_CHUNK <= MX_UNITS, "queue layout");
    const unsigned long long order = 0x081923A4B5C67DEFull;
    unsigned pend = 0u;
    if (F.wave == 0 && lane == 0) qw[0] = __hip_atomic_fetch_add(qhead, 1u, __ATOMIC_RELAXED, __HIP_MEMORY_SCOPE_AGENT);
    __syncthreads();
    for (;;) {
        const unsigned e = qw[0];
        if (e >= (unsigned)(MX_UNITS + cv_n)) break;
        OPQ_V(lane);
        if (F.wave == 0 && lane == 0) pend = __hip_atomic_fetch_add(qhead, 1u, __ATOMIC_RELAXED, __HIP_MEMORY_SCOPE_AGENT);
        int u = -1, c = -1;
        if (e < 2u * (unsigned)cv_n) { if (e & 1u) c = (int)(e >> 1); else u = (int)(e >> 1); } else u = (int)e - cv_n;
        if (c >= 0) {
#pragma unroll 1
            for (int k = 0; k < CV_CHUNK / NWAVES; ++k) conv_item(A, cv_lo + c * CV_CHUNK + k * NWAVES + F.wave, scr, lane);
        } else if (u < 512) {
            const unsigned code = (unsigned)(order >> (4 * (u >> 5))) & 15u; const int bh = u & 31, qb = code & 7;
            if (code & 8u) mixer_unit<2>(F.lds, Z, Y, G, A->in[4][l * 8 + (bh & 7)], 0.f, 0.f, bh >> 3, bh & 7, qb, F.wave, lane);
            else mixer_unit<1>(F.lds, Z, Y, G, A->in[3][l * 8 + (bh & 7)], A->in[2][l * 8 + (bh & 7)], 0.f, bh >> 3, bh & 7, qb, F.wave, lane);
        } else {
            const unsigned v = (unsigned)u - 512u; const int qb = 7 - (int)(v >> 6), bh = v & 63;
            mixer_unit<0>(F.lds, Z, Y, G, 0.f, 0.f, A->in[5][l * 16 + (bh & 15)] * LOG2E, bh >> 4, bh & 15, qb, F.wave, lane);
        }
        __syncthreads();
        if (F.wave == 0 && lane == 0) qw[0] = pend;
        __syncthreads();
    }
}

constexpr int PH_PER_LAYER = 7, N_PHASES = 2 + DEPTH * PH_PER_LAYER;
__global__ void __launch_bounds__(NWAVES * 64, 2) hyb_fwd(Args args) {
    extern __shared__ __attribute__((aligned(16))) unsigned char lds[];
    Frame F;
    F.lds = (LAS unsigned char*)lds;
    F.MISC = (volatile LAS unsigned*)(F.lds + MISC_OFF);
    F.wave = __builtin_amdgcn_readfirstlane((int)threadIdx.x >> 6);
    F.G = gridDim.x; { const int bx = blockIdx.x; F.vcu = (F.G % 8 == 0) ? (bx % 8) * (F.G / 8) + bx / 8 : bx; }
    const KArgs ka = (KArgs)__builtin_amdgcn_kernarg_segment_ptr();
    F.ctl = (gu32*)(args.ws + WS_CTL);
    for (int u = threadIdx.x; u < (LDS_BYTES - LDSCTL_OFF) / 4; u += NWAVES * 64) ((LAS unsigned*)(F.lds + LDSCTL_OFF))[u] = 0u;
    __syncthreads();
    const int lo = args.ph_lo, hi = args.ph_hi;
    XcdBarrier bar; bar.bar = (unsigned*)(F.ctl + CW_BAR); bar.x = 0; bar.st = F.MISC + 8; bar.wave = F.wave;
    if (hi - lo > 1) { bar = xcd_barrier_post((unsigned*)(F.ctl + CW_BAR), F.MISC + 8); bar.wave = F.wave; }
#define IN(k) (lo <= (k) && (k) < hi)
#define SEAM(k) do { if (IN(k) && IN((k) + 1)) xcd_barrier(bar); } while (0)
#define PHASE_PTRS KArgs A = ka; OPQ_S(A); unsigned char* ws = A->ws; int bx = blockIdx.x; OPQ_S(bx); unsigned* ctlw = (unsigned*)(ws + WS_CTL)
#define FXP(word_off) ((pg8::fx64*)(ctlw + (word_off)))
#define STATP(layer, which) FXP(CW_STAT + ((layer) * 2 + (which)) * 4 * M)

    if (IN(0)) { p0_prologue(F, ka); } SEAM(0);

    for (int l = 0; l < DEPTH; ++l) {
        const int pb = 1 + l * PH_PER_LAYER;
        if (IN(pb + 0)) {
            PHASE_PTRS;
            pg8::Gemm g{(const pg8::bf16_t*)(ws + (l ? WS_TB : WS_XB)), (const pg8::bf16_t*)(ws + WS_WIN + l * SZ_WIN), M, NZB, D}; pg8::StaticOrder S; S.init(M, NZB, F.G, bx);
            pg8::EpiZ<false> E{(pg8::bf16_t*)(ws + WS_Z), (float*)(ws + WS_G), NZ, M, pg8::LnFold{STATP(l ? l - 1 : 0, 1), l ? (const float*)(ws + WS_SC) : (const float*)(ctlw + CW_ZERO), l ? (const float*)(ws + WS_SC) + NZP : (const float*)(ctlw + CW_ZERO), l}};
            pg8::gemm_phase<pg8::EpiZ<false>, pg8::StaticOrder, PG8_ALIGN, PG8_SP2>(F.lds + RING_OFF, g, S, E, F.wave);
        }
        if (IN(pb + 0) && fp6_layer(l)) {
            PHASE_PTRS;
            pg8::Gemm g{(const pg8::bf16_t*)(ws + WS_A6), (const pg8::bf16_t*)(ws + WS_WIN8 + l * SZ_WIN8), M, NZ8, D / 2}; pg8::ExtraOrder S; S.init(M, NZ8, F.G, bx);
            if (F.G == 256) { S.n_full = 7; S.n_extra = 2; S.c_min = 64; } else { S.n_full = (M / 256) * (NZ8 / 256) / F.G + 1; S.n_extra = 0; S.c_min = 0; }
            if (l == 0) { pg8::EpiZ<true, 0, 1> E{(pg8::bf16_t*)(ws + WS_Z), (float*)(ws + WS_G), NZ, M, pg8::LnFold{STATP(0, 1), (const float*)(ctlw + CW_ZERO), (const float*)(ctlw + CW_ZERO), 0}};
                pg8::gemm_phase_fp6d<pg8::EpiZ<true, 0, 1>, pg8::ExtraOrder, PG8_ALIGN>(F.lds + RING_OFF, g, S, E, F.wave); }
            else { pg8::EpiZ<true, 0, 2> E{(pg8::bf16_t*)(ws + WS_Z), (float*)(ws + WS_G), NZ, M, pg8::LnFold{STATP(l - 1, 1), (const float*)(ws + WS_SC), (const float*)(ws + WS_SC) + NZP, 1}};
                pg8::gemm_phase_fp6d<pg8::EpiZ<true, 0, 2>, pg8::ExtraOrder, PG8_ALIGN>(F.lds + RING_OFF, g, S, E, F.wave); }
        }
        if (IN(pb + 0) && !fp6_layer(l)) {
            PHASE_PTRS;
            pg8::Gemm g{(const pg8::bf16_t*)(ws + WS_A8), (const pg8::bf16_t*)(ws + WS_WIN8 + l * SZ_WIN8), M, NZ8, D / 2}; pg8::ExtraOrder S; S.init(M, NZ8, F.G, bx);
            if (F.G == 256) { S.n_full = 7; S.n_extra = 2; S.c_min = 64; } else { S.n_full = (M / 256) * (NZ8 / 256) / F.G + 1; S.n_extra = 0; S.c_min = 0; }
            pg8::EpiZ<true> E{(pg8::bf16_t*)(ws + WS_Z), (float*)(ws + WS_G), NZ, M, pg8::LnFold{STATP(l ? l - 1 : 0, 1), l ? (const float*)(ws + WS_SC) : (const float*)(ctlw + CW_ZERO), l ? (const float*)(ws + WS_SC) + NZP : (const float*)(ctlw + CW_ZERO), l}};
            pg8::gemm_phase<pg8::EpiZ<true>, pg8::ExtraOrder, PG8_ALIGN, PG8_SP2, true>(F.lds + RING_OFF, g, S, E, F.wave);
        }
        SEAM(pb + 0);
#if defined(MIX_NAIVE)
        if (IN(pb + 1)) { scan_phase(F, ka, l); }
        SEAM(pb + 1);
#endif
#if defined(MIX_NAIVE)
        if (IN(pb + 2)) { mixers_naive(F, ka, l); }
#else
        if (IN(pb + 2)) { mixers_mfma(F, ka, l); }
#endif
        SEAM(pb + 2);
        if (IN(pb + 3)) {
            PHASE_PTRS;
            {
                float* cf = (float*)(ws + WS_SC); int tl_ = F.wave * 64 + lane_id(); OPQ_V(tl_); const int t0 = bx * 512 + tl_, nt_ = F.G * 512;
                if (l == 0) for (int i = t0; i < 2 * NZP; i += nt_) cf[i] = (float)FXP(CW_CIN)[i] * (1.f / FX_C);
                for (int i = t0; i < 2 * DFF; i += nt_) cf[2 * NZP + l * 2 * DFF + i] = (float)(FXP(CW_CF1) + l * 2 * DFF)[i] * (1.f / FX_C);
            }
            pg8::Gemm g{(const pg8::bf16_t*)(ws + WS_Y), (const pg8::bf16_t*)(ws + WS_WUP + l * SZ_WUP), M, D, NY / 2}; pg8::StaticOrder S; S.init(M, D, F.G, bx);
            pg8::EpiMix<true> E{(const pg8::bf16_t*)(ws + WS_Z) + ZC_GA, (pg8::bf16_t*)(ws + WS_MIX), NZ, D, MIX8_SCALE / (Y8_SCALE * W8_SCALE)};
            pg8::gemm_phase<pg8::EpiMix<true>, pg8::StaticOrder, PG8_ALIGN, PG8_SP2, true>(F.lds + RING_OFF, g, S, E, F.wave);
        }
        SEAM(pb + 3);
        if (IN(pb + 4)) {
            PHASE_PTRS;
            pg8::Gemm g{(const pg8::bf16_t*)(ws + WS_MIX), (const pg8::bf16_t*)(ws + WS_WO + l * SZ_WO), M, D, D / 2}; pg8::StaticOrder S; S.init(M, D, F.G, bx);
            if (l == 0) { pg8::EpiRes<0, true> E{A->in[0], nullptr, nullptr, A->in[14], A->in[15], (pg8::bf16_t*)(ws + WS_TA), STATP(l, 0), nullptr, nullptr, D};
                pg8::gemm_phase<pg8::EpiRes<0, true>, pg8::StaticOrder, PG8_ALIGN, PG8_SP2, true>(F.lds + RING_OFF, g, S, E, F.wave); }
            else { pg8::EpiRes<1, true> E{nullptr, (const pg8::bf16_t*)(ws + WS_TB), STATP(l - 1, 1), A->in[14] + (l - 1) * D, A->in[15] + (l - 1) * D, (pg8::bf16_t*)(ws + WS_TA), STATP(l, 0), nullptr, nullptr, D};
                pg8::gemm_phase<pg8::EpiRes<1, true>, pg8::StaticOrder, PG8_ALIGN, PG8_SP2, true>(F.lds + RING_OFF, g, S, E, F.wave); }
        }
        SEAM(pb + 4);
        if (IN(pb + 5)) {
            PHASE_PTRS;
            pg8::Gemm g{(const pg8::bf16_t*)(ws + WS_TA), (const pg8::bf16_t*)(ws + WS_WF1 + l * SZ_WF), M, DFF, D}; pg8::StaticOrder S; S.init(M, DFF, F.G, bx);
            pg8::EpiRelu2 E{(pg8::bf16_t*)(ws + WS_Z), DFF, pg8::LnFold{STATP(l, 0), (const float*)(ws + WS_SC) + 2 * NZP + l * 2 * DFF, (const float*)(ws + WS_SC) + 2 * NZP + l * 2 * DFF + DFF, 1}};
            pg8::gemm_phase<pg8::EpiRelu2, pg8::StaticOrder, PG8_ALIGN, PG8_SP2>(F.lds + RING_OFF, g, S, E, F.wave);
        }
        SEAM(pb + 5);
        if (IN(pb + 6)) {
            PHASE_PTRS;
            pg8::Gemm g{(const pg8::bf16_t*)(ws + WS_Z), (const pg8::bf16_t*)(ws + WS_WF2 + l * SZ_WF), M, D, DFF}; pg8::StaticOrder S; S.init(M, D, F.G, bx);
            pg8::EpiRes<1, false> E{nullptr, (const pg8::bf16_t*)(ws + WS_TA), STATP(l, 0), A->in[10] + l * D, A->in[11] + l * D,
                             (pg8::bf16_t*)(ws + WS_TB), STATP(l, 1), nullptr, (l + 1 < DEPTH) ? ws + WS_A6 : nullptr, D};
            pg8::gemm_phase<pg8::EpiRes<1, false>, pg8::StaticOrder, PG8_ALIGN, PG8_SP2>(F.lds + RING_OFF, g, S, E, F.wave);
        }
        SEAM(pb + 6);
    }
    if (IN(N_PHASES - 1)) { PHASE_PTRS; (void)bx; lnout_phase(F, (const bf16*)(ws + WS_TB), STATP(DEPTH - 1, 1), A->in[14] + (DEPTH - 1) * D, A->in[15] + (DEPTH - 1) * D, A->out); }
#undef IN
#undef SEAM
#undef PHASE_PTRS
#undef FXP
#undef STATP
}

extern "C" void kernel_launch(void* const* d_in, const int* in_sizes, int n_in, void* d_out, int out_size, void* d_ws, size_t ws_size, hipStream_t stream) {
    static int grid = 0;
    if (grid == 0) {
        if (n_in != 16 || in_sizes[0] != M * D || out_size != M * D || ws_size < WS_END) { fprintf(stderr, "kernel_launch: unexpected shapes (n_in %d, in0 %d, out %d, ws %zu < %zu)\n", n_in, n_in > 0 ? in_sizes[0] : -1, out_size, ws_size, (size_t)WS_END); grid = -1; return; }
        int dev = 0, cus = 0, per_cu = 0;
        if (hipGetDevice(&dev) != hipSuccess || hipDeviceGetAttribute(&cus, hipDeviceAttributeMultiprocessorCount, dev) != hipSuccess) { grid = -1; return; }
        if (hipFuncSetAttribute((const void*)hyb_fwd, hipFuncAttributeMaxDynamicSharedMemorySize, LDS_BYTES) != hipSuccess) { fprintf(stderr, "kernel_launch: hipFuncSetAttribute failed\n"); grid = -1; return; }
        if (hipOccupancyMaxActiveBlocksPerMultiprocessor(&per_cu, (const void*)hyb_fwd, NWAVES * 64, LDS_BYTES) != hipSuccess || per_cu < 1) { fprintf(stderr, "kernel_launch: occupancy query says %d blocks per CU\n", per_cu); (void)hipGetLastError(); grid = -1; return; }
        grid = cus;
    }
    if (grid < 0) return;
    (void)hipMemsetAsync((char*)d_ws + WS_CTL, 0, CTL_ZERO_BYTES, stream);
    Args a{};
    for (int i = 0; i < 16; ++i) a.in[i] = (const float*)d_in[i];
    a.out = (float*)d_out; a.ws = (unsigned char*)d_ws;
#if MK_N_LAUNCHES == 1
    a.ph_lo = 0; a.ph_hi = N_PHASES;
    hipLaunchKernelGGL(hyb_fwd, dim3(grid), dim3(NWAVES * 64), LDS_BYTES, stream, a);
#else
    for (int p = 0; p < N_PHASES; ++p) { a.ph_lo = p; a.ph_hi = p + 1; hipLaunchKernelGGL(hyb_fwd, dim3(grid), dim3(NWAVES * 64), LDS_BYTES, stream, a); }
#endif
}
```

```cpp
#include <hip/hip_runtime.h>
#include <cstdio>
#include <cstdint>

#define OPQ_V(x) asm volatile("" : "+v"(x))
#define OPQ_S(x) asm volatile("" : "+s"(x))
__device__ __forceinline__ int lane_id() { unsigned z = 0u; asm volatile("" : "+v"(z)); return (int)__builtin_amdgcn_mbcnt_hi(~0u, __builtin_amdgcn_mbcnt_lo(~0u, z)); }
__device__ __forceinline__ int pk4_e4m3(float a, float b, float c, float d) {
    a = __builtin_amdgcn_fmed3f(a, -448.f, 448.f); b = __builtin_amdgcn_fmed3f(b, -448.f, 448.f); c = __builtin_amdgcn_fmed3f(c, -448.f, 448.f); d = __builtin_amdgcn_fmed3f(d, -448.f, 448.f);
    int p = __builtin_amdgcn_cvt_pk_fp8_f32(a, b, 0, false); return __builtin_amdgcn_cvt_pk_fp8_f32(c, d, p, true);
}
__device__ __forceinline__ unsigned q_e2m3(float x) {
    const float a = fminf(fabsf(x), 7.5f); const float s = a < 2.f ? 8.f : (a < 4.f ? 4.f : 2.f); const unsigned o = a < 2.f ? 0u : (a < 4.f ? 8u : 16u);
    return ((unsigned)(int)__builtin_rintf(a * s) + o) | (x < 0.f ? 32u : 0u);
}
__device__ __forceinline__ float v_e2m3(float x) {
    const float a = fminf(fabsf(x), 7.5f); const float s = a < 2.f ? 8.f : (a < 4.f ? 4.f : 2.f), si = a < 2.f ? 0.125f : (a < 4.f ? 0.25f : 0.5f);
    return __builtin_copysignf(__builtin_rintf(a * s) * si, x);
}
typedef unsigned pk6x4_t __attribute__((ext_vector_type(4)));
__device__ __forceinline__ pk6x4_t pack16_e2m3(const unsigned (&c)[16]) {
    pk6x4_t d;
    d.x = c[0] | (c[1] << 6) | (c[2] << 12) | (c[3] << 18) | (c[4] << 24) | (c[5] << 30);
    d.y = (c[5] >> 2) | (c[6] << 4) | (c[7] << 10) | (c[8] << 16) | (c[9] << 22) | (c[10] << 28);
    d.z = (c[10] >> 4) | (c[11] << 2) | (c[12] << 8) | (c[13] << 14) | (c[14] << 20) | (c[15] << 26);
    d.w = 0u; return d;
}
__device__ __forceinline__ unsigned char* e2m3_ktile(unsigned char* img, int row, int kt, bool perm) {
    int rin = row & 255; if (perm) { const int w = rin & 31; rin = (rin & ~31) + 16 * ((w >> 2) & 1) + 4 * (w >> 3) + (w & 3); }
    return img + ((size_t)((row >> 8) * 32 + kt) * 256 + rin) * 96;
}
__device__ __forceinline__ void store_e2m3_group(unsigned char* ktile, int c16, pk6x4_t d) { unsigned* p = (unsigned*)(ktile + 12 * c16); p[0] = d.x; p[1] = d.y; p[2] = d.z; }
#ifndef MK_N_LAUNCHES
#define MK_N_LAUNCHES 1
#endif

namespace pg8 {
#define PG8_LAS __attribute__((address_space(3)))
typedef unsigned short bf16_t;
typedef short bf16x8 __attribute__((ext_vector_type(8)));
typedef float f32x4 __attribute__((ext_vector_type(4)));
typedef unsigned u32x4 __attribute__((ext_vector_type(4)));
constexpr int BM = 256, BK = 64, HALF = 128, HTB = HALF * BK * 2, STAGE_BYTES = 8 * HTB, NXCD = 8, WGM = 8;

__host__ __device__ __forceinline__ int lds_byte(int r, int c) { const int st = (r >> 4) * 2 + (c >> 5), rr = r & 15, cc = c & 31, ob = rr * 64 + cc * 2; return st * 1024 + (ob ^ (((ob >> 9) & 1) << 5)); }
__host__ __device__ __forceinline__ void stage_rc(int b, int& R, int& C) { const int st = b / 1024, sb = b % 1024, swz = sb ^ (((sb >> 9) & 1) << 5); R = (st >> 1) * 16 + swz / 64; C = (st & 1) * 32 + (swz % 64) / 2; }
__host__ __device__ __forceinline__ int perm32(int rho) { const int n = rho >> 4, i = rho & 15; return 8 * (i >> 2) + 4 * n + (i & 3); }

struct Unit { int pm, pn; };
struct Gemm { const bf16_t* A; const bf16_t* Bt; int M, N, K; };

struct StaticOrder {
    int nM, nN, nwg, G, c;
    __host__ __device__ void init(int M, int N, int G_, int c_) { nM = M / BM; nN = N / BM; nwg = nM * nN; G = G_; c = c_; }
    __host__ __device__ bool next(int i, Unit& u) const {
        const long L = (long)i * G + c; if (L >= nwg) return false;
        int wgid = (int)L; { const int q = nwg / NXCD, r = nwg % NXCD, xcd = wgid % NXCD, off = wgid / NXCD; wgid = (xcd < r ? xcd * (q + 1) : r * (q + 1) + (xcd - r) * q) + off; }
        const int nig = WGM * nN, gid = wgid / nig, fm = gid * WGM, gsz = (nM - fm) < WGM ? (nM - fm) : WGM;
        u.pm = fm + ((wgid % nig) % gsz); u.pn = (wgid % nig) / gsz; return true;
    }
    __device__ __forceinline__ void a_ready(const Unit&) const {}
    __device__ __forceinline__ void done(const Unit&) const {}
};

struct ExtraOrder : StaticOrder {
    int n_full, n_extra, c_min;
    __host__ __device__ bool next(int i, Unit& u) const {
        long L;
        if (i < n_full) L = (long)i * G + c;
        else if (c >= c_min && i < n_full + n_extra) L = (long)n_full * G + (long)(i - n_full) * (G - c_min) + (c - c_min);
        else return false;
        if (L >= nwg) return false;
        int wgid = (int)L; { const int q = nwg / NXCD, r = nwg % NXCD, xcd = wgid % NXCD, off = wgid / NXCD; wgid = (xcd < r ? xcd * (q + 1) : r * (q + 1) + (xcd - r) * q) + off; }
        const int nig = WGM * nN, gid = wgid / nig, fm = gid * WGM, gsz = (nM - fm) < WGM ? (nM - fm) : WGM;
        u.pm = fm + ((wgid % nig) % gsz); u.pn = (wgid % nig) / gsz; return true;
    }
};

__device__ __forceinline__ unsigned cvt_pk_bf16(float lo, float hi) { unsigned r; asm volatile("v_cvt_pk_bf16_f32 %0, %1, %2" : "=v"(r) : "v"(lo), "v"(hi)); return r; }
__device__ __forceinline__ float bf_lo(unsigned w) { return __uint_as_float(w << 16); }
__device__ __forceinline__ float bf_hi(unsigned w) { return __uint_as_float(w & 0xffff0000u); }


typedef float f32x2 __attribute__((ext_vector_type(2)));
typedef long long fx64;
__device__ __forceinline__ void fx_add(fx64* p, float v, float scale) { __hip_atomic_fetch_add(p, (fx64)__float2ll_rn(v * scale), __ATOMIC_RELAXED, __HIP_MEMORY_SCOPE_AGENT); }
struct LnFold {
    const fx64* st; const float* c1; const float* c2; int on;
    static constexpr float INV_D = 1.f / 4096.f, EPS = 1e-5f;
    __device__ __forceinline__ void row(int r, float& rr, float& rm) const {
        if (on) { const fx64 a = st[2 * (size_t)r], b = st[2 * (size_t)r + 1]; const float mu = (float)a * (INV_D / 16777216.f), var = fmaxf((float)b * (INV_D / 1048576.f) - mu * mu, 0.f); rr = __builtin_amdgcn_rsqf(var + EPS); rm = rr * mu; }
        else { rr = 1.f; rm = 0.f; }
    }
    __device__ __forceinline__ void cols(int c0, f32x4 (&k1)[2][2], f32x4 (&k2)[2][2]) const {
#pragma unroll
        for (int bj = 0; bj < 2; ++bj)
#pragma unroll
            for (int n = 0; n < 2; ++n) { k1[bj][n] = *(const f32x4*)(c1 + c0 + bj * HALF + 4 * n); k2[bj][n] = *(const f32x4*)(c2 + c0 + bj * HALF + 4 * n); }
    }
};
constexpr float A6_SCALE = 2.f, A6_SCALE1 = 1.f, W6_SCALE = 128.f;
template <bool F8, int PN0 = 0, int F6 = 0> struct EpiZ {
    static constexpr bool PERM = true, AFTER_DRAIN = false, HAS_MID = false, WAIT_AFTER_EPI = !F8;
    bf16_t* Z; float* G; int ldz, Mrows; LnFold ln;
    static constexpr int gate_pn = F8 ? -1 : 9, seg_pn = F8 ? 4 : 9, off_lo = F8 ? 0 : 1024, off_hi = F8 ? 2304 : 1024, gate_coff = 19712 - 9 * 256; static constexpr float ascale = F6 == 1 ? 1.f / (A6_SCALE * W6_SCALE) : F6 == 2 ? 1.f / (A6_SCALE1 * W6_SCALE) : F8 ? 1.f / 64.f : 1.f;
    __device__ __forceinline__ void operator()(const f32x4 (&acc)[2][2][4][2], const Unit& u, int wr, int wc, int fr, int fq) const {
        OPQ_V(fr); OPQ_V(fq);
        const int pn = u.pn + PN0;
        const int row0 = u.pm * BM + wr * 64 + fr, col0 = pn * BM + wc * 32 + 8 * fq + (pn == gate_pn ? gate_coff : (pn < seg_pn ? off_lo : off_hi));
        f32x4 k1[2][2], k2[2][2]; ln.cols(col0, k1, k2);
        const float asc = F6 ? (F6 == 1 ? 1.f / A6_SCALE : 1.f / A6_SCALE1) * (pn < 4 ? 1.f / 512.f : pn < 8 ? 1.f / 128.f : pn < 12 ? 1.f / 1024.f : pn < 16 ? 1.f / 128.f : pn < 20 ? 1.f / 256.f : 1.f / 128.f) : ascale;
        if (pn == gate_pn) {
#pragma unroll
            for (int bj = 0; bj < 2; ++bj)
#pragma unroll
                for (int n = 0; n < 2; ++n) asm volatile("" :: "v"(k1[bj][n]), "v"(k2[bj][n]));
            if (wc == 0 && fq < 3) {
#pragma unroll
                for (int ai = 0; ai < 2; ++ai)
#pragma unroll
                    for (int m = 0; m < 4; ++m) { const int r = row0 + ai * HALF + m * 16; float rr, rm; ln.row(r, rr, rm); rr *= asc;
#pragma unroll
                        for (int n = 0; n < 2; ++n)
#pragma unroll
                            for (int j = 0; j < 4; ++j) G[(size_t)(8 * fq + 4 * n + j) * Mrows + r] = rr * acc[ai][0][m][n][j] - rm * k1[0][n][j] + k2[0][n][j]; }
            }
            return;
        }
#pragma unroll
        for (int ai = 0; ai < 2; ++ai)
#pragma unroll
            for (int m = 0; m < 4; ++m) { const int r = row0 + ai * HALF + m * 16; float rr, rm; ln.row(r, rr, rm); rr *= asc; bf16_t* rowp = Z + (size_t)r * ldz + col0;
#pragma unroll
                for (int bj = 0; bj < 2; ++bj) { f32x4 v0 = acc[ai][bj][m][0] * rr - k1[bj][0] * rm + k2[bj][0], v1 = acc[ai][bj][m][1] * rr - k1[bj][1] * rm + k2[bj][1];
                    if (F8 && pn >= 20) {
#pragma unroll
                        for (int j = 0; j < 4; ++j) { v0[j] = __builtin_amdgcn_exp2f(__builtin_amdgcn_fmed3f(v0[j], -40.f, 40.f) * -1.4426950408889634f); v1[j] = __builtin_amdgcn_exp2f(__builtin_amdgcn_fmed3f(v1[j], -40.f, 40.f) * -1.4426950408889634f); } }
                    u32x4 w; w.x = cvt_pk_bf16(v0[0], v0[1]); w.y = cvt_pk_bf16(v0[2], v0[3]); w.z = cvt_pk_bf16(v1[0], v1[1]); w.w = cvt_pk_bf16(v1[2], v1[3]);
                    *(u32x4*)(rowp + bj * HALF) = w; } }
    }
};
struct EpiRelu2 {
    static constexpr bool PERM = true, AFTER_DRAIN = false, HAS_MID = false, WAIT_AFTER_EPI = false;
    bf16_t* O; int ldc; LnFold ln;
    __device__ __forceinline__ void operator()(const f32x4 (&acc)[2][2][4][2], const Unit& u, int wr, int wc, int fr, int fq) const {
        OPQ_V(fr); OPQ_V(fq);
        const int row0 = u.pm * BM + wr * 64 + fr, col0 = u.pn * BM + wc * 32 + 8 * fq;
        f32x4 k1[2][2], k2[2][2]; ln.cols(col0, k1, k2);
#pragma unroll
        for (int ai = 0; ai < 2; ++ai)
#pragma unroll
            for (int m = 0; m < 4; ++m) { const int r = row0 + ai * HALF + m * 16; float rr, rm; ln.row(r, rr, rm); bf16_t* rowp = O + (size_t)r * ldc + col0;
#pragma unroll
                for (int bj = 0; bj < 2; ++bj) { f32x4 v0 = acc[ai][bj][m][0] * rr - k1[bj][0] * rm + k2[bj][0], v1 = acc[ai][bj][m][1] * rr - k1[bj][1] * rm + k2[bj][1];
#pragma unroll
                    for (int j = 0; j < 4; ++j) { const float a = fmaxf(v0[j], 0.f), b = fmaxf(v1[j], 0.f); v0[j] = a * a; v1[j] = b * b; }
                    u32x4 w; w.x = cvt_pk_bf16(v0[0], v0[1]); w.y = cvt_pk_bf16(v0[2], v0[3]); w.z = cvt_pk_bf16(v1[0], v1[1]); w.w = cvt_pk_bf16(v1[2], v1[3]);
                    *(u32x4*)(rowp + bj * HALF) = w; } }
    }
};
template <int mode, bool F8> struct EpiRes {
    static constexpr bool PERM = true, AFTER_DRAIN = false, HAS_MID = false, WAIT_AFTER_EPI = false;
    const float* X; const bf16_t* Tp; const fx64* stp; const float* g; const float* b; bf16_t* T; fx64* sto; unsigned char* T8; unsigned char* T6; int ldc; static constexpr float alpha = 1.41421356237309515f  , ascale = F8 ? 1.f / 2048.f : 1.f;
    __device__ __forceinline__ void operator()(const f32x4 (&acc)[2][2][4][2], const Unit& u, int wr, int wc, int fr, int fq) const {
        OPQ_V(fr); OPQ_V(fq);
        const int row0 = u.pm * BM + wr * 64 + fr, col0 = u.pn * BM + wc * 32 + 8 * fq;
        f32x4 gv[2][2], bv[2][2];
#pragma unroll
        for (int bj = 0; bj < 2; ++bj)
#pragma unroll
            for (int n = 0; n < 2; ++n) { if (mode) { gv[bj][n] = *(const f32x4*)(g + col0 + bj * HALF + 4 * n); bv[bj][n] = *(const f32x4*)(b + col0 + bj * HALF + 4 * n); } }
        LnFold lp{stp, nullptr, nullptr, mode};
        const int lane = fr + 16 * fq;
#pragma unroll
        for (int ai = 0; ai < 2; ++ai) {
            u32x4 tw[4][2];
            if (mode) {
#pragma unroll
                for (int m = 0; m < 4; ++m)
#pragma unroll
                    for (int bj = 0; bj < 2; ++bj) tw[m][bj] = *(const u32x4*)(Tp + (size_t)(row0 + ai * HALF + m * 16) * ldc + col0 + bj * HALF);
            }
#pragma unroll
            for (int mp = 0; mp < 2; ++mp) {
                f32x4 xf[2][2][2];
                if (!mode) {
#pragma unroll
                    for (int mm = 0; mm < 2; ++mm)
#pragma unroll
                        for (int bj = 0; bj < 2; ++bj)
#pragma unroll
                            for (int n = 0; n < 2; ++n) xf[mm][bj][n] = *(const f32x4*)(X + (size_t)(row0 + ai * HALF + (2 * mp + mm) * 16) * ldc + col0 + bj * HALF + 4 * n);
                }
#pragma unroll
                for (int mm = 0; mm < 2; ++mm) { const int m = 2 * mp + mm, r = row0 + ai * HALF + m * 16; bf16_t* rowp = T + (size_t)r * ldc + col0; float s1 = 0.f, s2 = 0.f;
                    float rr = 1.f, rm = 0.f; if (mode) lp.row(r, rr, rm);
                    unsigned p6lo[2], p6hi[2];
#pragma unroll
                    for (int bj = 0; bj < 2; ++bj) { f32x4 x0, x1;
                        if (mode) { const u32x4 w = tw[m][bj];
                            x0 = ((f32x4){bf_lo(w.x), bf_hi(w.x), bf_lo(w.y), bf_hi(w.y)} * rr - rm) * gv[bj][0] + bv[bj][0];
                            x1 = ((f32x4){bf_lo(w.z), bf_hi(w.z), bf_lo(w.w), bf_hi(w.w)} * rr - rm) * gv[bj][1] + bv[bj][1]; }
                        else { x0 = xf[mm][bj][0]; x1 = xf[mm][bj][1]; }
                        const f32x4 v0 = x0 * alpha + acc[ai][bj][m][0] * ascale, v1 = x1 * alpha + acc[ai][bj][m][1] * ascale;
                        u32x4 w; w.x = cvt_pk_bf16(v0[0], v0[1]); w.y = cvt_pk_bf16(v0[2], v0[3]); w.z = cvt_pk_bf16(v1[0], v1[1]); w.w = cvt_pk_bf16(v1[2], v1[3]);
                        *(u32x4*)(rowp + bj * HALF) = w;
                        if (T6) { unsigned cd[8];
#pragma unroll
                            for (int e = 0; e < 4; ++e) { cd[e] = q_e2m3(v0[e] * A6_SCALE1); cd[4 + e] = q_e2m3(v1[e] * A6_SCALE1); }
                            p6lo[bj] = cd[0] | (cd[1] << 6) | (cd[2] << 12) | (cd[3] << 18) | (cd[4] << 24) | (cd[5] << 30); p6hi[bj] = (cd[5] >> 2) | (cd[6] << 4) | (cd[7] << 10); }
#pragma unroll
                        for (int d = 0; d < 4; ++d) { const float a = bf_lo(w[d]), c = bf_hi(w[d]); s1 += a + c; s2 += a * a + c * c; } }
                    if (T6) {
                        const bool odd = (fq & 1) != 0;
                        const unsigned rlo = (unsigned)__builtin_amdgcn_ds_bpermute((lane ^ 16) << 2, (int)(odd ? p6lo[0] : p6lo[1])), rhi = (unsigned)__builtin_amdgcn_ds_bpermute((lane ^ 16) << 2, (int)(odd ? p6hi[0] : p6hi[1]));
                        const unsigned flo = odd ? rlo : p6lo[0], fhi = odd ? rhi : p6hi[0], slo = odd ? p6lo[1] : rlo, shi = odd ? p6hi[1] : rhi;
                        pk6x4_t d6; d6.x = flo; d6.y = fhi | (slo << 16); d6.z = (slo >> 16) | (shi << 16); d6.w = 0u;
                        store_e2m3_group(e2m3_ktile(T6, r, 2 * u.pn + (odd ? 1 : 0), false), 2 * wc + (fq >> 1), d6); }
                    s1 += __int_as_float(__builtin_amdgcn_ds_bpermute((lane ^ 16) << 2, __float_as_int(s1))); s2 += __int_as_float(__builtin_amdgcn_ds_bpermute((lane ^ 16) << 2, __float_as_int(s2)));
                    s1 += __int_as_float(__builtin_amdgcn_ds_bpermute((lane ^ 32) << 2, __float_as_int(s1))); s2 += __int_as_float(__builtin_amdgcn_ds_bpermute((lane ^ 32) << 2, __float_as_int(s2)));
                    if (fq == 0) { fx_add(sto + 2 * (size_t)r, s1, 16777216.f); fx_add(sto + 2 * (size_t)r + 1, s2, 1048576.f); } }
                asm volatile("" ::: "memory");
            }
        }
    }
};
template <bool F8> struct EpiMix {
    static constexpr bool PERM = true, AFTER_DRAIN = false, HAS_MID = true, WAIT_AFTER_EPI = false; static constexpr int MID_T = F8 ? 8 : 16;
    const bf16_t* Zg; bf16_t* O; int ldz, ldc; float ascale;
    static __device__ __forceinline__ float e_neg(float e) { return e; }
    __device__ __forceinline__ void mid(f32x4 (&acc)[2][2][4][2], const Unit& u, int wr, int wc, int fr, int fq, int seg) const {
        OPQ_V(fr); OPQ_V(fq);
        const int row0 = u.pm * BM + wr * 64 + fr, col0 = u.pn * BM + wc * 32 + 8 * fq;
#pragma unroll
        for (int ai = 0; ai < 2; ++ai) {
            u32x4 gx[4][2], gy[4][2];
#pragma unroll
            for (int m = 0; m < 4; ++m) { const bf16_t* zr = Zg + (size_t)(row0 + ai * HALF + m * 16) * ldz + col0 + seg * 4096;
#pragma unroll
                for (int bj = 0; bj < 2; ++bj) { gx[m][bj] = *(const u32x4*)(zr + bj * HALF); gy[m][bj] = *(const u32x4*)(zr + bj * HALF + 4096); } }
#pragma unroll
            for (int m = 0; m < 4; ++m)
#pragma unroll
                for (int bj = 0; bj < 2; ++bj)
#pragma unroll
                    for (int d = 0; d < 4; ++d) { const int n = d >> 1, j = (d & 1) * 2;
                        const float r0 = (1.f + e_neg(bf_lo(gy[m][bj][d]))) * __builtin_amdgcn_rcpf(1.f + e_neg(bf_lo(gx[m][bj][d])));
                        const float r1 = (1.f + e_neg(bf_hi(gy[m][bj][d]))) * __builtin_amdgcn_rcpf(1.f + e_neg(bf_hi(gx[m][bj][d])));
                        acc[ai][bj][m][n][j] *= r0; acc[ai][bj][m][n][j + 1] *= r1; }
            asm volatile("" ::: "memory"); }
    }
    __device__ __forceinline__ void operator()(const f32x4 (&acc)[2][2][4][2], const Unit& u, int wr, int wc, int fr, int fq) const {
        OPQ_V(fr); OPQ_V(fq);
        const int row0 = u.pm * BM + wr * 64 + fr, col0 = u.pn * BM + wc * 32 + 8 * fq;
#pragma unroll
        for (int ai = 0; ai < 2; ++ai) {
            u32x4 gcv[4][2];
#pragma unroll
            for (int m = 0; m < 4; ++m) { const bf16_t* zr = Zg + (size_t)(row0 + ai * HALF + m * 16) * ldz + col0 + 8192; gcv[m][0] = *(const u32x4*)(zr); gcv[m][1] = *(const u32x4*)(zr + HALF); }
#pragma unroll
            for (int m = 0; m < 4; ++m) { bf16_t* rowp = O + (size_t)(row0 + ai * HALF + m * 16) * ldc + col0;
#pragma unroll
                for (int bj = 0; bj < 2; ++bj) { const u32x4 gc = gcv[m][bj]; const f32x4 v0 = acc[ai][bj][m][0], v1 = acc[ai][bj][m][1]; float o[8];
                    o[0] = v0[0] * __builtin_amdgcn_rcpf(1.f + e_neg(bf_lo(gc[0]))); o[1] = v0[1] * __builtin_amdgcn_rcpf(1.f + e_neg(bf_hi(gc[0])));
                    o[2] = v0[2] * __builtin_amdgcn_rcpf(1.f + e_neg(bf_lo(gc[1]))); o[3] = v0[3] * __builtin_amdgcn_rcpf(1.f + e_neg(bf_hi(gc[1])));
                    o[4] = v1[0] * __builtin_amdgcn_rcpf(1.f + e_neg(bf_lo(gc[2]))); o[5] = v1[1] * __builtin_amdgcn_rcpf(1.f + e_neg(bf_hi(gc[2])));
                    o[6] = v1[2] * __builtin_amdgcn_rcpf(1.f + e_neg(bf_lo(gc[3]))); o[7] = v1[3] * __builtin_amdgcn_rcpf(1.f + e_neg(bf_hi(gc[3])));
                    if constexpr (F8) {
#pragma unroll
                        for (int e = 0; e < 8; ++e) o[e] *= ascale;
                        const int p0 = pk4_e4m3(o[0], o[1], o[2], o[3]), p1 = pk4_e4m3(o[4], o[5], o[6], o[7]);
                        typedef int v2i_t __attribute__((ext_vector_type(2))); *(v2i_t*)((unsigned char*)O + (size_t)(row0 + ai * HALF + m * 16) * ldc + col0 + bj * HALF) = (v2i_t){p0, p1};
                    } else {
                    u32x4 w; w.x = cvt_pk_bf16(o[0], o[1]); w.y = cvt_pk_bf16(o[2], o[3]); w.z = cvt_pk_bf16(o[4], o[5]); w.w = cvt_pk_bf16(o[6], o[7]);
                    *(u32x4*)(rowp + bj * HALF) = w; } } }
            asm volatile("" ::: "memory"); }
    }
};

typedef int v4i_t __attribute__((ext_vector_type(4)));
typedef int v8i_t __attribute__((ext_vector_type(8)));
typedef int v6i_t __attribute__((ext_vector_type(6)));
template <class Epi, class Sched, bool ALIGN_EPI = false, bool SP2 = false, bool FP8 = false, bool FP6 = false>
__device__ __forceinline__ void gemm_phase(PG8_LAS unsigned char* lds, const Gemm g, const Sched& S, const Epi& E, int wave) {
    int tid_ = wave * 64 + lane_id(); OPQ_V(tid_);
    const int tid = tid_, wid = __builtin_amdgcn_readfirstlane(tid >> 6), lane = tid & 63, wr = wid >> 2, wc = wid & 3, fr = lane & 15, fq = lane >> 4;
    int K_ = g.K; OPQ_S(K_); const int K = K_, nt = K / BK;
    unsigned voffA[2], voffB[2];
#pragma unroll
    for (int i = 0; i < 2; ++i) { int R, C; stage_rc(tid * 16 + i * 8192, R, C); const int Rb = Epi::PERM ? ((R & ~31) + perm32(R & 31)) : R;
        voffA[i] = (unsigned)(R * K + C) * 2u; voffB[i] = (unsigned)(Rb * K + C) * 2u; }
    const size_t kstep = (size_t)(BK * 2);
    const size_t hstep = (size_t)HALF * K * 2;
    const size_t tstep = 2 * hstep;
    const unsigned ldsw = (unsigned)wid * 1024u;
    const int aoff = lds_byte(wr * 64 + fr, fq * 8), boff = lds_byte(wc * 32 + fr, fq * 8);
#define PG8_SA(b, h) (((b) * 2 + (h)) * HTB)
#define PG8_SB(b, h) ((4 + (b) * 2 + (h)) * HTB)
#define PG8_STAGE(bufoff, gbase, voff) do { _Pragma("unroll") for (int _i = 0; _i < 2; ++_i) \
        __builtin_amdgcn_global_load_lds((const unsigned*)((const char*)(gbase) + (voff)[_i]), (PG8_LAS unsigned*)(lds + (bufoff) + ldsw + _i * 8192), 16, 0, 0); } while (0)
#define PG8_LDF(p) ([&](const PG8_LAS unsigned char* p_, int k_) -> bf16x8 { if constexpr (FP6) { if (k_ == 1) { typedef short s4_t __attribute__((ext_vector_type(4))); const s4_t h_ = *(const volatile PG8_LAS s4_t*)p_;   return __builtin_shufflevector(h_, h_, 0, 1, 2, 3, -1, -1, -1, -1); } } return *(const PG8_LAS bf16x8*)p_; })
#define PG8_LDA(dst, b, h) do { _Pragma("unroll") for (int m = 0; m < 4; ++m) _Pragma("unroll") for (int k = 0; k < 2; ++k) dst[m][k] = PG8_LDF(0)(lds + PG8_SA(b, h) + aoff + m * 2048 + k * 1024, k); } while (0)
#define PG8_LDB(dst, b, h) do { _Pragma("unroll") for (int n = 0; n < 2; ++n) _Pragma("unroll") for (int k = 0; k < 2; ++k) dst[n][k] = PG8_LDF(0)(lds + PG8_SB(b, h) + boff + n * 2048 + k * 1024, k); } while (0)
#define PG8_CAT(x) __builtin_shufflevector(__builtin_bit_cast(v4i_t, (x)[0]), __builtin_bit_cast(v4i_t, (x)[1]), 0, 1, 2, 3, 4, 5, 6, 7)
#define PG8_CAT6(x) __builtin_shufflevector(__builtin_bit_cast(v4i_t, (x)[0]), __builtin_bit_cast(v4i_t, (x)[1]), 0, 1, 2, 3, 4, 5)
#define PG8_MMA(ai, bj, At, Bt) do { __builtin_amdgcn_s_setprio(1); if constexpr (FP6) { v6i_t a6_[4], b6_[2]; _Pragma("unroll") for (int m = 0; m < 4; ++m) a6_[m] = PG8_CAT6(At[m]); _Pragma("unroll") for (int n = 0; n < 2; ++n) b6_[n] = PG8_CAT6(Bt[n]); \
        _Pragma("unroll") for (int m = 0; m < 4; ++m) _Pragma("unroll") for (int n = 0; n < 2; ++n) \
        asm volatile("v_mfma_f32_16x16x128_f8f6f4 %0, %1, %2, %0 cbsz:2 blgp:2" : "+v"(acc[ai][bj][m][n]) : "v"(b6_[n]), "v"(a6_[m])); } \
        else if constexpr (FP8) { _Pragma("unroll") for (int m = 0; m < 4; ++m) _Pragma("unroll") for (int n = 0; n < 2; ++n) \
        asm volatile("v_mfma_f32_16x16x128_f8f6f4 %0, %1, %2, %0" : "+v"(acc[ai][bj][m][n]) : "v"(PG8_CAT(Bt[n])), "v"(PG8_CAT(At[m]))); } \
        else { _Pragma("unroll") for (int m = 0; m < 4; ++m) _Pragma("unroll") for (int n = 0; n < 2; ++n) _Pragma("unroll") for (int k = 0; k < 2; ++k) \
        acc[ai][bj][m][n] = __builtin_amdgcn_mfma_f32_16x16x32_bf16(Bt[n][k], At[m][k], acc[ai][bj][m][n], 0, 0, 0); } __builtin_amdgcn_s_setprio(0); } while (0)
#define PG8_WAIT_V(n) asm volatile("s_waitcnt vmcnt(" #n ")" ::: "memory")
#define PG8_WAIT_L(n) asm volatile("s_waitcnt lgkmcnt(" #n ")" ::: "memory")
#define PG8_BAR __builtin_amdgcn_s_barrier()
#define PG8_SCHED __builtin_amdgcn_sched_barrier(0)
    Unit cur, nxt; int ui = 0;
    __builtin_amdgcn_s_waitcnt(0x0F70);
    if (!S.next(0, cur)) return;
    f32x4 acc[2][2][4][2];
#pragma unroll
    for (int a = 0; a < 2; ++a)
#pragma unroll
        for (int b = 0; b < 2; ++b)
#pragma unroll
            for (int m = 0; m < 4; ++m)
#pragma unroll
                for (int n = 0; n < 2; ++n) acc[a][b][m][n] = (f32x4){0.f, 0.f, 0.f, 0.f};
    bf16x8 At[4][2], B0[2][2], B1[2][2];
    const char* cA = (const char*)g.A + (size_t)cur.pm * tstep; const char* cB = (const char*)g.Bt + (size_t)cur.pn * tstep;
    S.a_ready(cur);
    if constexpr (SP2) {
        PG8_STAGE(PG8_SB(0, 0), cB, voffB); PG8_STAGE(PG8_SB(0, 1), cB + hstep, voffB); PG8_STAGE(PG8_SA(0, 0), cA, voffA); PG8_STAGE(PG8_SA(0, 1), cA + hstep, voffA);
        if (wr == 1) PG8_BAR;
        PG8_WAIT_V(2); PG8_BAR;
        PG8_STAGE(PG8_SB(1, 0), cB + kstep, voffB); PG8_STAGE(PG8_SA(1, 0), cA + kstep, voffA); PG8_STAGE(PG8_SB(1, 1), cB + hstep + kstep, voffB);
        PG8_WAIT_V(6); PG8_BAR;
    } else {
        PG8_STAGE(PG8_SB(0, 0), cB, voffB); PG8_STAGE(PG8_SA(0, 0), cA, voffA); PG8_STAGE(PG8_SB(0, 1), cB + hstep, voffB); PG8_STAGE(PG8_SA(0, 1), cA + hstep, voffA);
        if (wr == 1) PG8_BAR;
        PG8_WAIT_V(4); PG8_BAR;
        PG8_STAGE(PG8_SB(1, 0), cB + kstep, voffB); PG8_STAGE(PG8_SA(1, 0), cA + kstep, voffA); PG8_STAGE(PG8_SB(1, 1), cB + hstep + kstep, voffB);
        PG8_WAIT_V(6); PG8_BAR;
    }
    for (;;) {
        const bool has_next = S.next(ui + 1, nxt);
        const char* nA = has_next ? (const char*)g.A + (size_t)nxt.pm * tstep : cA; const char* nB = has_next ? (const char*)g.Bt + (size_t)nxt.pn * tstep : cB;
        for (int t = 0; t < nt; t += 2) {
            const bool last = (t == nt - 2);
            const char* a1 = cA + (size_t)(t + 1) * kstep;
            const char* a2 = last ? nA : cA + (size_t)(t + 2) * kstep; const char* b2 = last ? nB : cB + (size_t)(t + 2) * kstep;
            const char* a3 = a2 + kstep; const char* b3 = b2 + kstep;
            if (last && has_next) S.a_ready(nxt);
            if constexpr (Epi::HAS_MID) { if (t == Epi::MID_T || t == 2 * Epi::MID_T) E.mid(acc, cur, wr, wc, fr, fq, t / Epi::MID_T - 1); }
            if constexpr (SP2) {
            PG8_LDB(B0, 0, 0); PG8_LDB(B1, 0, 1); PG8_SCHED; PG8_LDA(At, 0, 0); PG8_STAGE(PG8_SA(1, 1), a1 + hstep, voffA);
            PG8_WAIT_V(8); PG8_WAIT_L(0); __builtin_amdgcn_s_setprio(1); PG8_BAR; PG8_MMA(0, 0, At, B0); PG8_MMA(0, 1, At, B1); PG8_BAR; PG8_SCHED;
            PG8_LDA(At, 0, 1); PG8_STAGE(PG8_SB(0, 0), b2, voffB); PG8_STAGE(PG8_SB(0, 1), b2 + hstep, voffB); PG8_STAGE(PG8_SA(0, 0), a2, voffA);
            PG8_WAIT_V(8); PG8_WAIT_L(0); __builtin_amdgcn_s_setprio(1); PG8_BAR; PG8_MMA(1, 0, At, B0); PG8_MMA(1, 1, At, B1); PG8_BAR; PG8_SCHED;
            PG8_LDB(B0, 1, 0); PG8_LDB(B1, 1, 1); PG8_SCHED; PG8_LDA(At, 1, 0); PG8_STAGE(PG8_SA(0, 1), a2 + hstep, voffA);
            PG8_WAIT_V(8); PG8_WAIT_L(0); __builtin_amdgcn_s_setprio(1); PG8_BAR; PG8_MMA(0, 0, At, B0); PG8_MMA(0, 1, At, B1); PG8_BAR; PG8_SCHED;
            PG8_LDA(At, 1, 1); PG8_STAGE(PG8_SB(1, 0), b3, voffB); PG8_STAGE(PG8_SB(1, 1), b3 + hstep, voffB); PG8_STAGE(PG8_SA(1, 0), a3, voffA);
            PG8_WAIT_V(8); PG8_WAIT_L(0); __builtin_amdgcn_s_setprio(1); PG8_BAR; PG8_MMA(1, 0, At, B0); PG8_MMA(1, 1, At, B1); PG8_BAR; PG8_SCHED;
            } else {
            PG8_LDB(B0, 0, 0); PG8_SCHED; PG8_LDA(At, 0, 0); PG8_STAGE(PG8_SA(1, 1), a1 + hstep, voffA);
            PG8_WAIT_L(8); PG8_BAR; PG8_WAIT_L(0); PG8_MMA(0, 0, At, B0); PG8_BAR; PG8_SCHED;
            PG8_LDB(B1, 0, 1); PG8_STAGE(PG8_SB(0, 0), b2, voffB);
            PG8_BAR; PG8_WAIT_L(0); PG8_MMA(0, 1, At, B1); PG8_BAR;
            PG8_LDA(At, 0, 1); PG8_STAGE(PG8_SA(0, 0), a2, voffA);
            PG8_BAR; PG8_WAIT_L(0); PG8_MMA(1, 0, At, B0); PG8_BAR; PG8_SCHED;
            PG8_STAGE(PG8_SB(0, 1), b2 + hstep, voffB);
            PG8_WAIT_V(6); PG8_BAR; PG8_MMA(1, 1, At, B1); PG8_BAR;
            PG8_LDB(B0, 1, 0); PG8_SCHED; PG8_LDA(At, 1, 0); PG8_STAGE(PG8_SA(0, 1), a2 + hstep, voffA);
            PG8_WAIT_L(8); PG8_BAR; PG8_WAIT_L(0); PG8_MMA(0, 0, At, B0); PG8_BAR; PG8_SCHED;
            PG8_LDB(B1, 1, 1); PG8_STAGE(PG8_SB(1, 0), b3, voffB);
            PG8_BAR; PG8_WAIT_L(0); PG8_MMA(0, 1, At, B1); PG8_BAR;
            PG8_LDA(At, 1, 1); PG8_STAGE(PG8_SA(1, 0), a3, voffA);
            PG8_BAR; PG8_WAIT_L(0); PG8_MMA(1, 0, At, B0); PG8_BAR; PG8_SCHED;
            PG8_STAGE(PG8_SB(1, 1), b3 + hstep, voffB);
            PG8_WAIT_V(6); PG8_BAR; PG8_MMA(1, 1, At, B1); PG8_BAR;
            }
        }
        if constexpr (ALIGN_EPI) { if (wr == 0) PG8_BAR; }
        E(acc, cur, wr, wc, fr, fq); S.done(cur);
        if constexpr (Epi::WAIT_AFTER_EPI) __builtin_amdgcn_s_waitcnt(0x0F70);
        if (!has_next) break;
#pragma unroll
        for (int a = 0; a < 2; ++a)
#pragma unroll
            for (int b = 0; b < 2; ++b)
#pragma unroll
                for (int m = 0; m < 4; ++m)
#pragma unroll
                    for (int n = 0; n < 2; ++n) acc[a][b][m][n] = (f32x4){0.f, 0.f, 0.f, 0.f};
        cur = nxt; cA = nA; cB = nB; ++ui;
        if constexpr (ALIGN_EPI) { if (wr == 1) PG8_BAR; }
    }
    PG8_WAIT_V(0);
    if constexpr (!ALIGN_EPI) { if (wr == 0) PG8_BAR; }
    PG8_BAR;
#undef PG8_SA
#undef PG8_SB
#undef PG8_STAGE
#undef PG8_LDA
#undef PG8_LDF
#undef PG8_LDB
#undef PG8_MMA
#undef PG8_CAT
#undef PG8_CAT6
#undef PG8_WAIT_V
#undef PG8_WAIT_L
#undef PG8_BAR
#undef PG8_SCHED
}

template <class Epi, class Sched, bool ALIGN_EPI>
__device__ __forceinline__ void gemm_phase_fp6d(PG8_LAS unsigned char* lds, const Gemm g, const Sched& S, const Epi& E, int wave) {
    int tid_ = wave * 64 + lane_id(); OPQ_V(tid_);
    const int tid = tid_, wid = __builtin_amdgcn_readfirstlane(tid >> 6), lane = tid & 63, wr = wid >> 2, wc = wid & 3, fr = lane & 15, fq = lane >> 4;
    int K_ = g.K; OPQ_S(K_); const int K = K_, nt = K / BK;
    const size_t tstep = (size_t)nt * 24576;
    constexpr int SLOT = 49152, BOFF = 24576, KT = 96, KTG = 24576;
    unsigned voffA[3], voffB[3];
#pragma unroll
    for (int i = 0; i < 3; ++i) { voffA[i] = (unsigned)(i * 512 + tid) * 16u; voffB[i] = voffA[i]; }
    const unsigned ldsw = (unsigned)wid * 1024u;
    const int aoff = (wr * 64 + fr) * KT + 24 * fq, boff = BOFF + (wc * 32 + fr) * KT + 24 * fq;
    typedef int v2i_t __attribute__((ext_vector_type(2)));
    typedef int v4a8_t __attribute__((ext_vector_type(4), aligned(8)));
#define F6_STAGE(slot, pa, pb) do { _Pragma("unroll") for (int _i = 0; _i < 3; ++_i) { \
        __builtin_amdgcn_global_load_lds((const unsigned*)((pa) + voffA[_i]), (PG8_LAS unsigned*)(lds + (slot) * SLOT + ldsw + _i * 8192), 16, 0, 0); \
        __builtin_amdgcn_global_load_lds((const unsigned*)((pb) + voffB[_i]), (PG8_LAS unsigned*)(lds + (slot) * SLOT + BOFF + ldsw + _i * 8192), 16, 0, 0); } } while (0)
#define F6_LD(dst, p) do { const PG8_LAS unsigned char* p_ = (p); const v2i_t a_ = *(const volatile PG8_LAS v2i_t*)p_, b_ = *(const volatile PG8_LAS v2i_t*)(p_ + 8), c_ = *(const volatile PG8_LAS v2i_t*)(p_ + 16); \
        dst = __builtin_shufflevector(__builtin_shufflevector(a_, b_, 0, 1, 2, 3), __builtin_shufflevector(c_, c_, 0, 1, -1, -1), 0, 1, 2, 3, 4, 5); } while (0)
#define F6_WAIT_V(n) asm volatile("s_waitcnt vmcnt(" #n ")" ::: "memory")
#define F6_WAIT_L0 asm volatile("s_waitcnt lgkmcnt(0)" ::: "memory")
#define F6_BAR __builtin_amdgcn_s_barrier()
    Unit cur, nxt; int ui = 0;
    __builtin_amdgcn_s_waitcnt(0x0F70);
    if (!S.next(0, cur)) return;
    f32x4 acc[2][2][4][2];
#pragma unroll
    for (int a = 0; a < 2; ++a)
#pragma unroll
        for (int b = 0; b < 2; ++b)
#pragma unroll
            for (int m = 0; m < 4; ++m)
#pragma unroll
                for (int n = 0; n < 2; ++n) acc[a][b][m][n] = (f32x4){0.f, 0.f, 0.f, 0.f};
    const char* cA = (const char*)g.A + (size_t)cur.pm * tstep; const char* cB = (const char*)g.Bt + (size_t)cur.pn * tstep;
    F6_STAGE(0, cA, cB); F6_STAGE(1, cA + KTG, cB + KTG);
    F6_WAIT_V(0); F6_BAR;
    if (wr == 1) F6_BAR;
    int sr = 0;
    for (;;) {
        const bool has_next = S.next(ui + 1, nxt);
        const char* nA = has_next ? (const char*)g.A + (size_t)nxt.pm * tstep : cA; const char* nB = has_next ? (const char*)g.Bt + (size_t)nxt.pn * tstep : cB;
#pragma unroll 1
        for (int t = 0; t < nt; ++t) {
            const int t2 = t + 2; const char* ta = t2 < nt ? cA + (size_t)t2 * KTG : nA + (size_t)(t2 - nt) * KTG; const char* tb = t2 < nt ? cB + (size_t)t2 * KTG : nB + (size_t)(t2 - nt) * KTG;
            int sw = sr + 2; if (sw >= 3) sw -= 3;
            F6_STAGE(sw, ta, tb);
            v6i_t A6[2][4], B6[2][2];
            const PG8_LAS unsigned char* sp = lds + sr * SLOT;
#pragma unroll
            for (int bj = 0; bj < 2; ++bj)
#pragma unroll
                for (int n = 0; n < 2; ++n) F6_LD(B6[bj][n], sp + boff + (bj * 128 + n * 16) * KT);
#pragma unroll
            for (int ai = 0; ai < 2; ++ai)
#pragma unroll
                for (int m = 0; m < 4; ++m) F6_LD(A6[ai][m], sp + aoff + (ai * 128 + m * 16) * KT);
            if (wr == 1) F6_WAIT_V(6);
            F6_WAIT_L0; F6_BAR;
            __builtin_amdgcn_s_setprio(1);
#pragma unroll
            for (int ai = 0; ai < 2; ++ai)
#pragma unroll
                for (int bj = 0; bj < 2; ++bj)
#pragma unroll
                    for (int m = 0; m < 4; ++m)
#pragma unroll
                        for (int n = 0; n < 2; ++n) asm volatile("v_mfma_f32_16x16x128_f8f6f4 %0, %1, %2, %0 cbsz:2 blgp:2" : "+v"(acc[ai][bj][m][n]) : "v"(B6[bj][n]), "v"(A6[ai][m]));
            __builtin_amdgcn_s_setprio(0);
            if (wr == 0) F6_WAIT_V(6);
            F6_BAR; __builtin_amdgcn_sched_barrier(0);
            sr = sr == 2 ? 0 : sr + 1;
        }
        if constexpr (ALIGN_EPI) { if (wr == 0) F6_BAR; }
        E(acc, cur, wr, wc, fr, fq); S.done(cur);
        if constexpr (Epi::WAIT_AFTER_EPI) __builtin_amdgcn_s_waitcnt(0x0F70);
        if (!has_next) break;
#pragma unroll
        for (int a = 0; a < 2; ++a)
#pragma unroll
            for (int b = 0; b < 2; ++b)
#pragma unroll
                for (int m = 0; m < 4; ++m)
#pragma unroll
                    for (int n = 0; n < 2; ++n) acc[a][b][m][n] = (f32x4){0.f, 0.f, 0.f, 0.f};
        cur = nxt; cA = nA; cB = nB; ++ui;
        if constexpr (ALIGN_EPI) { if (wr == 1) F6_BAR; }
    }
    F6_WAIT_V(0);
    if constexpr (!ALIGN_EPI) { if (wr == 0) F6_BAR; }
    F6_BAR;
#undef F6_STAGE
#undef F6_LD
#undef F6_WAIT_V
#undef F6_WAIT_L0
#undef F6_BAR
}
}

#ifndef PG8_SP2
#define PG8_SP2 true
#endif
#ifndef PG8_ALIGN
#define PG8_ALIGN true
#endif

constexpr int NWAVES = 8;
constexpr int BATCH = 4, SEQ = 2048, D = 4096, DEPTH = 2, M = BATCH * SEQ;
constexpr int DIN = 19736;
constexpr int NZ = 19712;
constexpr int NZP = 19968;
constexpr int GATE_PN = 77;
constexpr int DFF = 16384, NY = 3072;
constexpr int ZC_AQ = 0, ZC_AK = 1024, ZC_AV = 1152, ZC_MQ = 1280, ZC_MK = 1792, ZC_MV = 2304, ZC_MO = 3328, ZC_CQ = 4352, ZC_CK = 5376, ZC_CV = 6400, ZC_GA = 7424;
constexpr float LN_EPS = 1e-5f, DN_ALPHA = 1.41421356237309515f, LOG2E = 1.4426950408889634f;

constexpr size_t MiB = 1u << 20;
constexpr size_t WS_CTL = 0, CTL_ZERO_BYTES = 2 * MiB;
constexpr int NZB = 2560, NZ8 = 17408;
__host__ __device__ constexpr bool z_is_fp8(int n0) { return n0 < 1024 || (n0 >= 3328 && n0 < 19712); }
__host__ __device__ constexpr int z_row(int n0) { return n0 < 1024 ? n0 : n0 < 3328 ? n0 - 1024 : n0 < 19712 ? n0 - 2304 : n0 - 19712 + 2304; }
__host__ __device__ constexpr bool fp6_layer(int l) { return l >= 0; }
__host__ __device__ constexpr float w6_scale(int n0) { return n0 < 1024 ? 512.f : n0 < 4352 ? 128.f : n0 < 5376 ? 1024.f : n0 < 6400 ? 128.f : n0 < 7424 ? 256.f : 128.f; }
constexpr float W8_SCALE = 64.f;
constexpr size_t SZ_WIN = (size_t)NZB * D * 2, SZ_WIN8 = (size_t)NZ8 * D, SZ_WUP = (size_t)D * NY * 2, SZ_WO = (size_t)D * D * 2, SZ_WF = (size_t)DFF * D * 2;
constexpr size_t WS_WIN = 2 * MiB;
constexpr size_t WS_WIN8 = WS_WIN + 2 * SZ_WIN;
constexpr size_t WS_A8 = WS_WIN8 + 2 * SZ_WIN8;
constexpr size_t WS_WUP = WS_A8 + (size_t)M * D;
constexpr size_t WS_WO = WS_WUP + 2 * SZ_WUP;
constexpr size_t WS_WF1 = WS_WO + 2 * SZ_WO;
constexpr size_t WS_WF2 = WS_WF1 + 2 * SZ_WF;
constexpr size_t WS_XB = WS_WF2 + 2 * SZ_WF;
constexpr size_t WS_TA = WS_XB + (size_t)M * D * 2;
constexpr size_t WS_TB = WS_TA + (size_t)M * D * 2;
constexpr size_t WS_Z = WS_TB + (size_t)M * D * 2;
constexpr size_t WS_G = WS_Z + (size_t)M * NZ * 2;
constexpr size_t WS_SC = WS_G + 1 * MiB;
constexpr size_t WS_Y = WS_SC + 1 * MiB;
constexpr size_t WS_MIX = WS_Y + (size_t)M * NY * 2;
constexpr size_t WS_A6 = WS_MIX + (size_t)M * D * 2;
constexpr size_t WS_END = WS_A6 + (size_t)M * D;
static_assert(WS_WIN % 256 == 0 && WS_Z % 256 == 0 && WS_G % 256 == 0 && WS_Y % 256 == 0, "alignment");
constexpr int CW_TMO = 0, CW_BAR = 4096;
constexpr int CW_STAT = 16384, CW_CF1 = CW_STAT + 4 * M * 2 * 2, CW_CIN = CW_CF1 + 2 * 2 * DFF * 2, CW_ZERO = CW_CIN + 2 * NZP * 2, CW_END = CW_ZERO + NZP * 2;
constexpr float FX_S1 = 16777216.f, FX_S2 = 1048576.f, FX_C = 4294967296.f;
static_assert((size_t)CW_END * 4 <= CTL_ZERO_BYTES, "control region");

constexpr int RING_OFF = 0, RING_BYTES = 131072;
constexpr int SCR_BYTES = NWAVES * 64 * 65 * 4;
constexpr int LDSCTL_OFF = 147456, MISC_OFF = LDSCTL_OFF + 320;
constexpr int LDS_BYTES = 151552;
static_assert(SCR_BYTES <= LDSCTL_OFF && MISC_OFF + 128 <= LDS_BYTES, "LDS map");

#define GAS __attribute__((address_space(1)))
#define LAS __attribute__((address_space(3)))
typedef unsigned short bf16;
typedef unsigned v4u __attribute__((ext_vector_type(4)));
typedef unsigned v2u __attribute__((ext_vector_type(2)));
typedef float f32x4 __attribute__((ext_vector_type(4)));
typedef GAS unsigned gu32;
#define RLX_AGENT __ATOMIC_RELAXED, __HIP_MEMORY_SCOPE_AGENT
#define LDS_WAIT() asm volatile("s_waitcnt lgkmcnt(0)" ::: "memory")
#define VM_WAIT() asm volatile("s_waitcnt vmcnt(0)" ::: "memory")
using pg8::cvt_pk_bf16; using pg8::bf_lo; using pg8::bf_hi;

#define XB_TMO      128
#define XB_XCNT(j)  (256  + 64 * (j))
#define XB_XSUB(j)  (1280 + 64 * (j))
#define XB_XGEN(j)  (2304 + 64 * (j))
#define XB_TOP      3328
#define XB_TOPGEN   3392
#define XCD_BAR_WORDS 3456
#define XB_SPIN_CAP (1u << 18)

__device__ __forceinline__ unsigned xb_ld(unsigned* p)              { return __hip_atomic_load(p, __ATOMIC_RELAXED, __HIP_MEMORY_SCOPE_AGENT); }
__device__ __forceinline__ unsigned xb_add(unsigned* p, unsigned v) { return __hip_atomic_fetch_add(p, v, __ATOMIC_RELAXED, __HIP_MEMORY_SCOPE_AGENT); }
__device__ __forceinline__ unsigned xb_xcc_id() { return (unsigned)__builtin_amdgcn_s_getreg((3 << 11) | 20) & 0xFu; }
#define XB_SPIN(cond, bar) do { unsigned _sp = 0; while (cond) { __builtin_amdgcn_s_sleep(1); \
    if ((++_sp & 255u) == 0u) { if (xb_ld(&(bar)[XB_TMO])) break; if (_sp > XB_SPIN_CAP) { atomicAdd(&(bar)[XB_TMO], 1u); break; } } } } while (0)

struct XcdBarrier { unsigned* bar; unsigned x; volatile LAS unsigned* st; int wave; };

__device__ __forceinline__ XcdBarrier xcd_barrier_post(unsigned* bar, volatile LAS unsigned* st) {
    XcdBarrier b; b.bar = bar; b.x = xb_xcc_id(); b.st = st; b.wave = 0;
    if (threadIdx.x == 0) (void)xb_add(&bar[XB_XCNT(b.x)], 1u);
    return b;
}
__device__ __forceinline__ void xcd_barrier_complete(unsigned* bar, unsigned x, unsigned& nloc, unsigned& nx) {
    const unsigned G = gridDim.x * gridDim.y * gridDim.z;
    unsigned sum, cnt, mine, sp = 0u;
    for (;;) {
        sum = 0u; cnt = 0u; mine = 0u;
#pragma unroll
        for (unsigned j = 0; j < 16; ++j) { const unsigned c = xb_ld(&bar[XB_XCNT(j)]); sum += c; cnt += (c > 0u) ? 1u : 0u; mine = (j == x) ? c : mine; }
        if (sum == G) break;
        __builtin_amdgcn_s_sleep(1);
        if ((++sp & 255u) == 0u) { if (xb_ld(&bar[XB_TMO])) break; if (sp > XB_SPIN_CAP) { atomicAdd(&bar[XB_TMO], 1u); break; } }
    }
    nloc = mine > 0u ? mine : 1u; nx = cnt > 0u ? cnt : 1u;
}
__device__ __forceinline__ void xcd_barrier(const XcdBarrier& b) {
    asm volatile("s_waitcnt vmcnt(0)" ::: "memory");
    __syncthreads();
    if (b.wave == 0 && lane_id() == 0) {
        unsigned* bar = b.bar; OPQ_S(bar);
        __builtin_amdgcn_s_waitcnt(0);
        unsigned nloc = b.st[0], nx = b.st[1];
        if (nloc == 0u) { xcd_barrier_complete(bar, b.x, nloc, nx); b.st[0] = nloc; b.st[1] = nx; }
        const unsigned old = xb_add(&bar[XB_XSUB(b.x)], 1u);
        const unsigned gen = old / nloc;
        if (old + 1u == (gen + 1u) * nloc) {
            __builtin_amdgcn_fence(__ATOMIC_RELEASE, "agent");
            asm volatile("s_waitcnt vmcnt(0)" ::: "memory");
            const unsigned og = xb_add(&bar[XB_TOP], 1u);
            const unsigned tg = og / nx;
            if (og + 1u == (tg + 1u) * nx) xb_add(&bar[XB_TOPGEN], 1u);
            else XB_SPIN(xb_ld(&bar[XB_TOPGEN]) == tg, bar);
            __builtin_amdgcn_fence(__ATOMIC_ACQUIRE, "agent");
            xb_add(&bar[XB_XGEN(b.x)], 1u);
            asm volatile("s_waitcnt vmcnt(0)" ::: "memory");
        } else {
            XB_SPIN(xb_ld(&bar[XB_XGEN(b.x)]) == gen, bar);
            __builtin_amdgcn_fence(__ATOMIC_ACQUIRE, "agent");
            asm volatile("s_waitcnt vmcnt(0)" ::: "memory");
        }
    }
    __syncthreads();
}

struct Frame {
    LAS unsigned char* lds;
    volatile LAS unsigned* MISC;
    gu32* ctl;
    int wave;
    int vcu, G;
};

__device__ __forceinline__ float lane_get(float v, int src_lane) { return __int_as_float(__builtin_amdgcn_ds_bpermute(src_lane << 2, __float_as_int(v))); }
__device__ __forceinline__ float wave_sum(float v, int lane) {
#pragma unroll
    for (int o = 1; o < 64; o <<= 1) v += lane_get(v, lane ^ o);
    return v;
}
__device__ __forceinline__ float wave_max(float v, int lane) {
#pragma unroll
    for (int o = 1; o < 64; o <<= 1) v = fmaxf(v, lane_get(v, lane ^ o));
    return v;
}

__device__ __forceinline__ float rbf(float x) { return bf_lo(cvt_pk_bf16(x, x)); }
__device__ __forceinline__ void tr_item(const float* __restrict__ W, int ldw, int k0, int srccol, bf16* __restrict__ WT, size_t ldt, int n0, int kdst, float scale, LAS float* scr, int lane, f32x4& a1, f32x4& a2, bool flush,
                                        const float* __restrict__ gk, const float* __restrict__ bk, pg8::fx64* c1, pg8::fx64* c2, unsigned char* __restrict__ WT8 = nullptr, bool fp6 = false, float wsc = W8_SCALE) {
    const int i = lane & 15, kr = lane >> 4;
    const float c1s = WT8 ? 1.f / wsc : 1.f;
    if (srccol >= 0) {
        f32x4 v[16];
#pragma unroll
        for (int r = 0; r < 16; ++r) v[r] = __builtin_nontemporal_load((const f32x4*)(W + (size_t)(k0 + 4 * r + kr) * ldw + srccol + 4 * i));
#pragma unroll
        for (int r = 0; r < 16; ++r) { LAS float* s = scr + (4 * r + kr) * 65 + 4 * i; float gs = scale, bs = 0.f;
            if (gk) { gs *= gk[k0 + 4 * r + kr]; bs = bk[k0 + 4 * r + kr] * scale; }
#pragma unroll
            for (int j = 0; j < 4; ++j) { const float w = WT8 ? (fp6 ? v_e2m3(v[r][j] * gs) : __builtin_amdgcn_cvt_f32_fp8(__builtin_amdgcn_cvt_pk_fp8_f32(__builtin_amdgcn_fmed3f(v[r][j] * gs, -448.f, 448.f), 0.f, 0, false), 0)) : rbf(v[r][j] * gs); s[j] = w; a1[j] += w; a2[j] += v[r][j] * bs; } }
    } else {
#pragma unroll
        for (int r = 0; r < 16; ++r) { LAS float* s = scr + (4 * r + kr) * 65 + 4 * i; float gs = scale, bs = 0.f;
            if (gk) { gs *= gk[k0 + 4 * r + kr]; bs = bk[k0 + 4 * r + kr] * scale; }
#pragma unroll
            for (int j = 0; j < 4; ++j) { const int cc = 4 * i + j; float val = 0.f;
                if (srccol == -2 && cc < 24) { const int sc = cc < 16 ? 3328 + cc : 7440 + (cc - 16); val = W[(size_t)(k0 + 4 * r + kr) * ldw + sc]; }
                const float w = rbf(val * gs); s[j] = w; a1[j] += w; a2[j] += val * bs; } }
    }
    if (gk && flush) {
#pragma unroll
        for (int j = 0; j < 4; ++j) { a1[j] += lane_get(a1[j], lane ^ 16); a2[j] += lane_get(a2[j], lane ^ 16); a1[j] += lane_get(a1[j], lane ^ 32); a2[j] += lane_get(a2[j], lane ^ 32); }
        if (kr == 0) {
#pragma unroll
            for (int j = 0; j < 4; ++j) { pg8::fx_add(c1 + n0 + 4 * i + j, a1[j] * c1s, FX_C); pg8::fx_add(c2 + n0 + 4 * i + j, a2[j] * c1s, FX_C); } }
        a1 = (f32x4){0.f, 0.f, 0.f, 0.f}; a2 = a1;
    }
    LDS_WAIT(); asm volatile("" ::: "memory");
    if (WT8) {
        const int c = lane & 3, nn = lane >> 2;
#pragma unroll
        for (int jj = 0; jj < 4; ++jj) { const int n = nn + 16 * jj; const LAS float* s = scr + (16 * c) * 65 + n; v4u o;
            if (fp6) { unsigned cd[16];
#pragma unroll
                for (int e = 0; e < 16; ++e) cd[e] = q_e2m3(s[e * 65]);
                store_e2m3_group(e2m3_ktile(WT8, n0 + n, k0 >> 7, true), ((k0 & 64) >> 4) + c, pack16_e2m3(cd)); continue; }
#pragma unroll
            for (int d = 0; d < 4; ++d) { int p = __builtin_amdgcn_cvt_pk_fp8_f32(s[(4 * d) * 65], s[(4 * d + 1) * 65], 0, false); p = __builtin_amdgcn_cvt_pk_fp8_f32(s[(4 * d + 2) * 65], s[(4 * d + 3) * 65], p, true); o[d] = (unsigned)p; }
            __builtin_nontemporal_store(o, (v4u*)(WT8 + (size_t)(n0 + n) * ldt + kdst + k0 + 16 * c)); }
        LDS_WAIT(); asm volatile("" ::: "memory");
        return;
    }
    const int c = lane & 7, nn = lane >> 3;
#pragma unroll
    for (int jj = 0; jj < 8; ++jj) { const int n = nn + 8 * jj; const LAS float* s = scr + (8 * c) * 65 + n;
        v4u o; o.x = cvt_pk_bf16(s[0 * 65], s[1 * 65]); o.y = cvt_pk_bf16(s[2 * 65], s[3 * 65]); o.z = cvt_pk_bf16(s[4 * 65], s[5 * 65]); o.w = cvt_pk_bf16(s[6 * 65], s[7 * 65]);
        __builtin_nontemporal_store(o, (v4u*)(WT + (size_t)(n0 + n) * ldt + kdst + k0 + 8 * c)); }
    LDS_WAIT(); asm volatile("" ::: "memory");
}

struct Args {
    const float* in[16]; float* out; unsigned char* ws; int ph_lo, ph_hi;
};
typedef const __attribute__((address_space(4))) Args* KArgs;

constexpr int I_IN = (D / 64) * (NZP / 64), I_UP = (1024 / 64) * (D / 64), I_O = (D / 64) * (D / 64), I_F1 = (D / 64) * (DFF / 64), I_F2 = (DFF / 64) * (D / 64);
constexpr int I_LAYER = I_IN + 3 * I_UP + I_O + I_F1 + I_F2;
__device__ __forceinline__ void conv_kn(int r, int NB, int& kb, int& nb) { const int kg = r / (8 * NB), q = r - kg * (8 * NB); nb = q >> 3; kb = 8 * kg + (q & 7); }
__device__ __forceinline__ void conv_item(KArgs A, int it, LAS float* scr, int lane, f32x4& a1, f32x4& a2, bool flush) {
    const int l = it / I_LAYER; int r = it - l * I_LAYER;
    if (r < I_IN) {
        constexpr int NB = NZP / 64; int kb, nb; conv_kn(r, NB, kb, nb); const int n0 = nb * 64;
        int srccol; float scale = 1.f;
        if (n0 < 3328) { srccol = n0; if (n0 < 1024) scale = 0.125f * LOG2E; else if (n0 >= ZC_MK && n0 < ZC_MV) scale = 0.125f; }
        else if (n0 < 7424) { srccol = n0 + 16; if (n0 >= ZC_CQ && n0 < ZC_CK) scale = 0.08838834764831845f * LOG2E; }
        else if (n0 < NZ) srccol = n0 + 24;
        else if (n0 == NZ) srccol = -2;
        else srccol = -1;
        pg8::fx64* cf = (pg8::fx64*)((unsigned*)(A->ws + WS_CTL) + CW_CIN);
        if (z_is_fp8(n0)) {
            const int nd = z_row(n0); const float wsc = w6_scale(n0);
            tr_item(A->in[1] + (size_t)l * D * DIN, DIN, kb * 64, srccol, nullptr, D, nd, 0, scale * wsc, scr, lane, a1, a2, flush,
                    l ? A->in[14] : nullptr, l ? A->in[15] : nullptr, cf + (n0 - nd), cf + NZP + (n0 - nd), A->ws + WS_WIN8 + l * SZ_WIN8, true, wsc);
        } else {
            const int nd = z_row(n0);
            tr_item(A->in[1] + (size_t)l * D * DIN, DIN, kb * 64, srccol, (bf16*)(A->ws + WS_WIN + l * SZ_WIN), D, nd, 0, scale, scr, lane, a1, a2, flush,
                    l ? A->in[14] : nullptr, l ? A->in[15] : nullptr, cf + (n0 - nd), cf + NZP + (n0 - nd));
        }
        return;
    }
    r -= I_IN;
    if (r < 3 * I_UP) { const int br = r / I_UP; r -= br * I_UP; constexpr int NB = D / 64; int kb, nb; conv_kn(r, NB, kb, nb);
        tr_item(A->in[6 + br] + (size_t)l * 1024 * D, D, kb * 64, nb * 64, nullptr, NY, nb * 64, br * 1024, W8_SCALE, scr, lane, a1, a2, flush, nullptr, nullptr, nullptr, nullptr, A->ws + WS_WUP + l * SZ_WUP);
        return; }
    r -= 3 * I_UP;
    if (r < I_O) { constexpr int NB = D / 64; int kb, nb; conv_kn(r, NB, kb, nb);
        tr_item(A->in[9] + (size_t)l * D * D, D, kb * 64, nb * 64, nullptr, D, nb * 64, 0, 128.f, scr, lane, a1, a2, flush, nullptr, nullptr, nullptr, nullptr, A->ws + WS_WO + l * SZ_WO);
        return; }
    r -= I_O;
    if (r < I_F1) { constexpr int NB = DFF / 64; int kb, nb; conv_kn(r, NB, kb, nb);
        pg8::fx64* cf = (pg8::fx64*)((unsigned*)(A->ws + WS_CTL) + CW_CF1) + l * 2 * DFF;
        tr_item(A->in[12] + (size_t)l * D * DFF, DFF, kb * 64, nb * 64, (bf16*)(A->ws + WS_WF1 + l * SZ_WF), D, nb * 64, 0, 1.f, scr, lane, a1, a2, flush, A->in[10] + l * D, A->in[11] + l * D, cf, cf + DFF);
        return; }
    r -= I_F1;
    { constexpr int NB = D / 64; int kb, nb; conv_kn(r, NB, kb, nb);
        tr_item(A->in[13] + (size_t)l * DFF * D, D, kb * 64, nb * 64, (bf16*)(A->ws + WS_WF2 + l * SZ_WF), DFF, nb * 64, 0, 1.f, scr, lane, a1, a2, flush, nullptr, nullptr, nullptr, nullptr); }
}
__device__ __forceinline__ void p0_prologue(Frame& F, KArgs A_) {
    KArgs A = A_; OPQ_S(A);
    int tid = F.wave * 64 + lane_id(); OPQ_V(tid); const int lane = tid & 63;
    LAS float* scr = (LAS float*)(F.lds) + F.wave * (64 * 65);
    const int gw = F.vcu * NWAVES + F.wave, NGW = F.G * NWAVES;
#if defined(MIX_NAIVE)
    { f32x4 a1 = (f32x4){0.f, 0.f, 0.f, 0.f}, a2 = a1; for (int it = gw; it < DEPTH * I_LAYER; it += NGW) conv_item(A, it, scr, lane, a1, a2, true); }
#else
    { f32x4 a1 = (f32x4){0.f, 0.f, 0.f, 0.f}, a2 = a1; for (int it = gw; it < I_IN; it += NGW) conv_item(A, it, scr, lane, a1, a2, true); }
#endif
    const f32x4* xs = (const f32x4*)A->in[0];
    {
        const size_t n16 = (size_t)M * D / 16, st = (size_t)F.G * 512; size_t i = (size_t)(F.vcu * 512 + tid);
        v4u* xb2 = (v4u*)(A->ws + WS_XB); v4u* x6 = (v4u*)(A->ws + WS_A6);
#define X_CHUNK(ci, q0, q1, q2, q3) do { const f32x4 q_[4] = {q0, q1, q2, q3}; v4u o0, o1, o6; unsigned cd[16]; \
            o0.x = cvt_pk_bf16(q_[0][0], q_[0][1]); o0.y = cvt_pk_bf16(q_[0][2], q_[0][3]); o0.z = cvt_pk_bf16(q_[1][0], q_[1][1]); o0.w = cvt_pk_bf16(q_[1][2], q_[1][3]); \
            o1.x = cvt_pk_bf16(q_[2][0], q_[2][1]); o1.y = cvt_pk_bf16(q_[2][2], q_[2][3]); o1.z = cvt_pk_bf16(q_[3][0], q_[3][1]); o1.w = cvt_pk_bf16(q_[3][2], q_[3][3]); \
                        _Pragma("unroll") for (int e_ = 0; e_ < 16; ++e_) cd[e_] = q_e2m3(q_[e_ >> 2][e_ & 3] * pg8::A6_SCALE); \
            o6 = pack16_e2m3(cd); \
            xb2[2 * (ci)] = o0; xb2[2 * (ci) + 1] = o1; store_e2m3_group(e2m3_ktile((unsigned char*)x6, (int)((ci) >> 8), (int)(((ci) >> 3) & 31), false), (int)((ci) & 7), o6); } while (0)
#pragma unroll 1
        for (; i + st < n16; i += 2 * st) {
            f32x4 v[2][4];
#pragma unroll
            for (int u = 0; u < 2; ++u)
#pragma unroll
                for (int q = 0; q < 4; ++q) v[u][q] = __builtin_nontemporal_load(xs + (i + u * st) * 4 + q);
#pragma unroll
            for (int u = 0; u < 2; ++u) X_CHUNK(i + u * st, v[u][0], v[u][1], v[u][2], v[u][3]);
        }
#pragma unroll 1
        for (; i < n16; i += st) { const f32x4 v0 = xs[i * 4], v1 = xs[i * 4 + 1], v2 = xs[i * 4 + 2], v3 = xs[i * 4 + 3]; X_CHUNK(i, v0, v1, v2, v3); }
#undef X_CHUNK
    }
}

__device__ __forceinline__ void lnout_phase(Frame& F, const bf16* __restrict__ T, const pg8::fx64* __restrict__ st, const float* __restrict__ g, const float* __restrict__ b, float* __restrict__ xo) {
    int lane = lane_id(); OPQ_V(lane); int gw = F.vcu * NWAVES + F.wave; OPQ_S(gw); const int NGW = F.G * NWAVES;
    for (int row = gw; row < M; row += NGW) {
        const float s1 = (float)st[2 * (size_t)row] * (1.f / FX_S1), s2 = (float)st[2 * (size_t)row + 1] * (1.f / FX_S2);
        const float mean = s1 * (1.f / D), rstd = __builtin_amdgcn_rsqf(fmaxf(s2 * (1.f / D) - mean * mean, 0.f) + LN_EPS), rm = rstd * mean;
        const v4u* tr = (const v4u*)(T + (size_t)row * D) + lane;
#pragma unroll 2
        for (int j = 0; j < 8; ++j) { const int c0 = 8 * (lane + 64 * j); const v4u w = tr[64 * j];
            const f32x4 g0 = *(const f32x4*)(g + c0), g1 = *(const f32x4*)(g + c0 + 4), b0 = *(const f32x4*)(b + c0), b1 = *(const f32x4*)(b + c0 + 4);
            *(f32x4*)(xo + (size_t)row * D + c0) = ((f32x4){bf_lo(w.x), bf_hi(w.x), bf_lo(w.y), bf_hi(w.y)} * rstd - rm) * g0 + b0;
            *(f32x4*)(xo + (size_t)row * D + c0 + 4) = ((f32x4){bf_lo(w.z), bf_hi(w.z), bf_lo(w.w), bf_hi(w.w)} * rstd - rm) * g1 + b1; }
    }
}

__device__ __forceinline__ float log_sigmoid(float x) { return fminf(x, 0.f) - log1pf(expf(-fabsf(x))); }
__device__ __forceinline__ void scan_phase(Frame& F, KArgs A_, int l) {
    KArgs A = A_; OPQ_S(A);
    int lane = lane_id(); OPQ_V(lane); int gw = F.vcu * NWAVES + F.wave; OPQ_S(gw); const int NGW = F.G * NWAVES;
    const float* G = (const float*)(A->ws + WS_G); float* SC = (float*)(A->ws + WS_SC);
    for (int it = gw; it < 64; it += NGW) {
        const int fox = it >> 5, bh = it & 31, b = bh >> 3, h = bh & 7;
        const float* fp = G + (size_t)((fox ? 16 : 8) + h) * M + b * SEQ + 32 * lane;
        const float bf = fox ? A->in[4][l * 8 + h] : A->in[3][l * 8 + h];
        float Fv[32]; float run = 0.f;
#pragma unroll
        for (int j = 0; j < 32; ++j) { run += log_sigmoid(fp[j] + bf); Fv[j] = run; }
        float inc = run;
#pragma unroll
        for (int o = 1; o < 64; o <<= 1) { const float t = lane_get(inc, lane - o); if (lane >= o) inc += t; }
        const float excl = inc - run;
        const size_t ob = (size_t)bh * SEQ + 32 * lane;
        if (fox) {
#pragma unroll
            for (int j = 0; j < 32; ++j) SC[ob + j] = -(Fv[j] + excl) * LOG2E;
        } else {
            const float* ip = G + (size_t)h * M + b * SEQ + 32 * lane; const float bi = A->in[2][l * 8 + h];
            float av[32]; float rm = -3.0e38f;
#pragma unroll
            for (int j = 0; j < 32; ++j) { Fv[j] += excl; av[j] = (ip[j] + bi) - Fv[j]; rm = fmaxf(rm, av[j]); }
            float incm = rm;
#pragma unroll
            for (int o = 1; o < 64; o <<= 1) { const float t = lane_get(incm, lane - o); if (lane >= o) incm = fmaxf(incm, t); }
            float pre = lane_get(incm, lane - 1); if (lane == 0) pre = 0.f; pre = fmaxf(pre, 0.f);
            float rr = pre;
#pragma unroll
            for (int j = 0; j < 32; ++j) { rr = fmaxf(rr, av[j]); SC[(size_t)32 * SEQ + ob + j] = av[j] * LOG2E; SC[(size_t)64 * SEQ + ob + j] = rr * LOG2E; SC[(size_t)96 * SEQ + ob + j] = expf(-(Fv[j] + rr)); }
        }
    }
}

#if defined(MIX_NAIVE)
__device__ __forceinline__ float dot8(const v4u a, const v4u b) {
    return bf_lo(a.x) * bf_lo(b.x) + bf_hi(a.x) * bf_hi(b.x) + bf_lo(a.y) * bf_lo(b.y) + bf_hi(a.y) * bf_hi(b.y) + bf_lo(a.z) * bf_lo(b.z) + bf_hi(a.z) * bf_hi(b.z) + bf_lo(a.w) * bf_lo(b.w) + bf_hi(a.w) * bf_hi(b.w);
}
__device__ __forceinline__ void mixers_naive(Frame& F, KArgs A_, int l) {
    KArgs A = A_; OPQ_S(A);
    int lane = lane_id(); OPQ_V(lane); int gw = F.vcu * NWAVES + F.wave; OPQ_S(gw); const int NGW = F.G * NWAVES;
    const bf16* Z = (const bf16*)(A->ws + WS_Z); bf16* Y = (bf16*)(A->ws + WS_Y); const float* SC = (const float*)(A->ws + WS_SC);
    LAS float* sbuf = (LAS float*)(F.lds) + F.wave * 2048;
    for (int it = gw; it < M * 16; it += NGW) {
        const int hq = it & 15, row = it >> 4, t = row & (SEQ - 1), kvh = hq >> 3;
        const v4u* qp = (const v4u*)(Z + (size_t)row * NZ + ZC_AQ + hq * 64);
        v4u qv[8];
#pragma unroll
        for (int c = 0; c < 8; ++c) qv[c] = qp[c];
        const float slope = exp2f(-0.5f * (float)(hq + 1)) * LOG2E, sink = A->in[5][l * 16 + hq] * LOG2E;
        float sc[2];
#pragma unroll
        for (int kk = 0; kk < 2; ++kk) { const int s = t - 127 + lane + 64 * kk; float d = -__builtin_inff();
            if (s >= 0) { const v4u* kp = (const v4u*)(Z + (size_t)(row - t + s) * NZ + ZC_AK + kvh * 64); float a = 0.f;
#pragma unroll
                for (int c = 0; c < 8; ++c) a += dot8(qv[c], kp[c]);
                d = a - slope * (float)(t - s); }
            sc[kk] = d; }
        const float mx = fmaxf(wave_max(fmaxf(sc[0], sc[1]), lane), sink);
        const float p0 = __builtin_amdgcn_exp2f(sc[0] - mx), p1 = __builtin_amdgcn_exp2f(sc[1] - mx);
        const float den = wave_sum(p0 + p1, lane) + __builtin_amdgcn_exp2f(sink - mx);
        float acc = 0.f;
#pragma unroll
        for (int kk = 0; kk < 2; ++kk) { const float pk = kk ? p1 : p0;
#pragma unroll 8
            for (int j = 0; j < 64; ++j) { const int s = t - 127 + j + 64 * kk; const float pj = lane_get(pk, j);
                if (s >= 0) acc += pj * __uint_as_float((unsigned)Z[(size_t)(row - t + s) * NZ + ZC_AV + kvh * 64 + lane] << 16); } }
        const float o = acc / den; const unsigned ob = cvt_pk_bf16(o, o);
        Y[(size_t)row * NY + hq * 64 + lane] = (bf16)(ob & 0xffffu);
    }
    for (int it = gw; it < 2 * 32 * SEQ; it += NGW) {
        const int fox = it >= 32 * SEQ; const int i2 = fox ? it - 32 * SEQ : it; const int bh = i2 & 31, t = i2 >> 5, b = bh >> 3, h = bh & 7;
        const size_t row = (size_t)b * SEQ + t; const int nkb = (t >> 6) + 1;
        const int qc = fox ? ZC_CQ + h * 128 : ZC_MQ + h * 64, kc = fox ? ZC_CK + h * 128 : ZC_MK + h * 64, vc = fox ? ZC_CV + h * 128 : ZC_MV + h * 128;
        const int nch = fox ? 16 : 8;
        const v4u* qp = (const v4u*)(Z + row * NZ + qc);
        v4u qv[16];
#pragma unroll
        for (int c = 0; c < 16; ++c) qv[c] = (c < nch) ? qp[c] : (v4u){0u, 0u, 0u, 0u};
        const float* bias = SC + (size_t)(fox ? 0 : 32) * SEQ + (size_t)bh * SEQ;
        const float RL = fox ? 0.f : SC[(size_t)64 * SEQ + (size_t)bh * SEQ + t];
        float mx = -__builtin_inff();
        for (int kb = 0; kb < nkb; ++kb) { const int s = kb * 64 + lane; float val = fox ? -__builtin_inff() : 0.f;
            if (s <= t) { const v4u* kp = (const v4u*)(Z + ((size_t)b * SEQ + s) * NZ + kc); float a = 0.f;
#pragma unroll
                for (int c = 0; c < 16; ++c) if (c < nch) a += dot8(qv[c], kp[c]);
                val = fox ? a + bias[s] : a * __builtin_amdgcn_exp2f(bias[s] - RL); }
            sbuf[s] = val; mx = fmaxf(mx, val); }
        float den;
        if (fox) { mx = wave_max(mx, lane); float sum = 0.f;
            for (int kb = 0; kb < nkb; ++kb) { const int s = kb * 64 + lane; const float p = __builtin_amdgcn_exp2f(sbuf[s] - mx); sbuf[s] = p; sum += p; }
            den = wave_sum(sum, lane);
        } else { float sum = 0.f;
            for (int kb = 0; kb < nkb; ++kb) sum += sbuf[kb * 64 + lane];
            den = wave_sum(sum, lane); den = fmaxf(fabsf(den), SC[(size_t)96 * SEQ + (size_t)bh * SEQ + t]); }
        LDS_WAIT(); asm volatile("" ::: "memory");
        float a0 = 0.f, a1 = 0.f;
        const bf16* vp = Z + ((size_t)b * SEQ) * NZ + vc + 2 * lane;
#pragma unroll 8
        for (int s = 0; s <= t; ++s) { const float p = sbuf[s]; const unsigned w = *(const unsigned*)(vp + (size_t)s * NZ); a0 += p * bf_lo(w); a1 += p * bf_hi(w); }
        a0 /= den; a1 /= den;
        if (!fox) { const unsigned w = *(const unsigned*)(Z + row * NZ + ZC_MO + h * 128 + 2 * lane);
            a0 *= 1.f / (1.f + expf(-bf_lo(w))); a1 *= 1.f / (1.f + expf(-bf_hi(w))); }
        *(unsigned*)(Y + row * NY + (fox ? 2048 : 1024) + h * 128 + 2 * lane) = cvt_pk_bf16(a0, a1);
        LDS_WAIT(); asm volatile("" ::: "memory");
    }
}


#endif
typedef float f32x16 __attribute__((ext_vector_type(16)));
typedef short s16x8 __attribute__((ext_vector_type(8)));
typedef short s16x4 __attribute__((ext_vector_type(4)));
constexpr int MX_KB0 = 0, MX_KB1 = 64 * 272, MX_VB0 = 2 * 64 * 272, MX_VB1 = MX_VB0 + 64 * 320, MX_QW = MX_VB1 + 64 * 320;
constexpr int MX_SC_A = 77824, MX_SC_R = MX_SC_A + 8192, MX_SC_E = MX_SC_R + 1024, MX_SC_W = MX_SC_E + 1024;
static_assert(MX_QW <= MX_SC_A && MX_SC_W + 64 <= RING_BYTES, "mixer LDS");
static_assert(16.f * 128.f == 2048.f && W8_SCALE == 64.f && NZB == 10 * 256 && NZ8 == 68 * 256, "EpiRes::ascale == 1 / (MIX8_SCALE * WO8_SCALE); EpiZ constants");
constexpr float Y8_SCALE = 8.f, MIX8_SCALE = 16.f, WO8_SCALE = 128.f;
constexpr float MX_THR = 8.f;
__device__ __forceinline__ float swap32_max(float v) { auto rr = __builtin_amdgcn_permlane32_swap(__float_as_uint(v), __float_as_uint(v), false, false); return fmaxf(__uint_as_float(rr[0]), __uint_as_float(rr[1])); }
__device__ __forceinline__ float swap32_add(float v) { auto rr = __builtin_amdgcn_permlane32_swap(__float_as_uint(v), __float_as_uint(v), false, false); return __uint_as_float(rr[0]) + __uint_as_float(rr[1]); }
__device__ __forceinline__ s16x4 vtr(const LAS unsigned char* p) { return __builtin_bit_cast(s16x4, __builtin_amdgcn_ds_read_tr16_b64_v4i16((LAS s16x4*)p)); }

template <int MODE>
__device__ __forceinline__ void mixer_scan(LAS unsigned char* lds, const float* __restrict__ G, float bias_f, float bias_i, int b, int h, int qb, int wave, int lane) {
    LAS float* key = (LAS float*)(lds + MX_SC_A); LAS float* rl = (LAS float*)(lds + MX_SC_R); LAS float* em = (LAS float*)(lds + MX_SC_E); LAS float* wt = (LAS float*)(lds + MX_SC_W);
    const int tid = wave * 64 + lane, s0 = 4 * tid, nk = 256 * (qb + 1); const bool act = s0 < nk;
    f32x4 fv = (f32x4){0.f, 0.f, 0.f, 0.f}, iv = fv;
    if (act) { fv = *(const f32x4*)(G + (size_t)((MODE == 2 ? 16 : 8) + h) * M + (size_t)b * SEQ + s0); if (MODE == 1) iv = *(const f32x4*)(G + (size_t)h * M + (size_t)b * SEQ + s0); }
    float Fv[4]; float run = 0.f;
#pragma unroll
    for (int j = 0; j < 4; ++j) { run += act ? log_sigmoid(fv[j] + bias_f) : 0.f; Fv[j] = run; }
    float inc = run;
#pragma unroll
    for (int o = 1; o < 64; o <<= 1) { const float t = lane_get(inc, lane - o); if (lane >= o) inc += t; }
    if (lane == 63) wt[wave] = inc;
    __syncthreads();
    float off = inc - run;
#pragma unroll
    for (int w = 0; w < NWAVES; ++w) if (w < wave) off += wt[w];
    if (MODE == 2) {
        if (act) *(LAS f32x4*)(key + s0) = (f32x4){-(Fv[0] + off) * LOG2E, -(Fv[1] + off) * LOG2E, -(Fv[2] + off) * LOG2E, -(Fv[3] + off) * LOG2E};
    } else {
        float av[4], mv[4]; float rm = -3.0e38f;
#pragma unroll
        for (int j = 0; j < 4; ++j) { Fv[j] += off; av[j] = act ? (iv[j] + bias_i) - Fv[j] : -3.0e38f; rm = fmaxf(rm, av[j]); mv[j] = rm; }
        float incm = rm;
#pragma unroll
        for (int o = 1; o < 64; o <<= 1) { const float t = lane_get(incm, lane - o); if (lane >= o) incm = fmaxf(incm, t); }
        if (lane == 63) wt[8 + wave] = incm;
        float pre = lane_get(incm, lane - 1); if (lane == 0) pre = 0.f;
        __syncthreads();
        pre = fmaxf(pre, 0.f);
#pragma unroll
        for (int w = 0; w < NWAVES; ++w) if (w < wave) pre = fmaxf(pre, wt[8 + w]);
        if (act) { *(LAS f32x4*)(key + s0) = (f32x4){av[0] * LOG2E, av[1] * LOG2E, av[2] * LOG2E, av[3] * LOG2E};
            const int r0 = s0 - 256 * qb;
            if (r0 >= 0) {
#pragma unroll
                for (int j = 0; j < 4; ++j) { const float R = fmaxf(pre, mv[j]); rl[r0 + j] = R * LOG2E; em[r0 + j] = expf(-(Fv[j] + R)); } } }
    }
    __syncthreads();
}

template <int MODE>
__device__ __forceinline__ void mixer_unit(LAS unsigned char* lds, const bf16* __restrict__ Z, bf16* __restrict__ Y, const float* __restrict__ G, float gb_f, float gb_i, float sink_l2, int b, int h, int qb, int wave, int lane) {
    constexpr int DQK = (MODE == 2) ? 128 : 64, DV = (MODE == 0) ? 64 : 128;
    constexpr int KP = DQK * 2 + 16, VP = (DV == 128) ? 320 : 192;
    constexpr int NKD = DQK / 16, NDB = DV / 32, KCH = DQK / 8, VCH = DV / 8, KLD = 64 * KCH / 512, VLD = 64 * VCH / 512;
    const int c = lane & 31, hi = lane >> 5, tid = wave * 64 + lane;
    const int qc = (MODE == 0) ? ZC_AQ + h * 64 : (MODE == 1) ? ZC_MQ + h * 64 : ZC_CQ + h * 128;
    const int kc = (MODE == 0) ? ZC_AK + (h >> 3) * 64 : (MODE == 1) ? ZC_MK + h * 64 : ZC_CK + h * 128;
    const int vc = (MODE == 0) ? ZC_AV + (h >> 3) * 64 : (MODE == 1) ? ZC_MV + h * 128 : ZC_CV + h * 128;
    const int yc = (MODE == 0) ? h * 64 : (MODE == 1) ? 1024 + h * 128 : 2048 + h * 128;
    const size_t rowb = (size_t)b * SEQ;
    const int q0w = 256 * qb + 32 * wave, qabs = q0w + c;
    const int j_lo = (MODE == 0) ? (qb > 0 ? 4 * qb - 2 : 0) : 0, j_hi = 4 * qb + 4;
    if (MODE != 0) mixer_scan<MODE>(lds, G, gb_f, gb_i, b, h, qb, wave, lane);
    const LAS float* bias = (const LAS float*)(lds + MX_SC_A);
    s16x8 qf[NKD];
    { const bf16* qp = Z + (rowb + qabs) * NZ + qc + 8 * hi;
#pragma unroll
      for (int kd = 0; kd < NKD; ++kd) qf[kd] = *(const s16x8*)(qp + 16 * kd); }
    f32x16 O[NDB];
#pragma unroll
    for (int db = 0; db < NDB; ++db)
#pragma unroll
        for (int r = 0; r < 16; ++r) O[db][r] = 0.f;
    float m = (MODE == 0) ? sink_l2 : -1.0e30f, lsum = (MODE == 0 && hi == 0) ? 1.f : 0.f;
    const float RL = (MODE == 1) ? ((const LAS float*)(lds + MX_SC_R))[32 * wave + c] : 0.f;
    const float slope = (MODE == 0) ? exp2f(-0.5f * (float)(h + 1)) * LOG2E : 0.f;
    v4u kr0[KLD], vr0[VLD], kr1[KLD], vr1[VLD];
#define MX_LOADG(KR, VR, j) do { _Pragma("unroll") for (int i_ = 0; i_ < KLD; ++i_) { const int cid = tid + 512 * i_, row = cid / KCH, cc = cid % KCH; KR[i_] = *(const v4u*)(Z + (rowb + 64 * (j) + row) * NZ + kc + 8 * cc); } \
        _Pragma("unroll") for (int i_ = 0; i_ < VLD; ++i_) { const int cid = tid + 512 * i_, row = cid / VCH, cc = cid % VCH; VR[i_] = *(const v4u*)(Z + (rowb + 64 * (j) + row) * NZ + vc + 8 * cc); } } while (0)
#define MX_STORE(KR, VR, bufi) do { _Pragma("unroll") for (int i_ = 0; i_ < KLD; ++i_) { const int cid = tid + 512 * i_, row = cid / KCH, cc = cid % KCH; *(LAS v4u*)(lds + ((bufi) ? MX_KB1 : MX_KB0) + row * KP + 16 * cc) = KR[i_]; } \
        _Pragma("unroll") for (int i_ = 0; i_ < VLD; ++i_) { const int cid = tid + 512 * i_, row = cid / VCH, cc = cid % VCH; *(LAS v4u*)(lds + ((bufi) ? MX_VB1 : MX_VB0) + row * VP + 16 * cc) = VR[i_]; } } while (0)
    MX_LOADG(kr1, vr1, j_lo); MX_STORE(kr1, vr1, 0);
    MX_LOADG(kr1, vr1, j_lo + 1);
    __syncthreads();
#pragma unroll
    for (int kd = 0; kd < NKD; ++kd) asm volatile("" : "+v"(qf[kd]));
    const int kbase = c * KP + 16 * hi;
    const int vbase = (4 * hi + ((lane & 15) >> 2)) * VP + (16 * ((lane >> 4) & 1) + 4 * (lane & 3)) * 2;
    auto step = [&](const int j, v4u (&ka)[KLD], v4u (&va)[VLD], v4u (&kb_)[KLD], v4u (&vb_)[VLD]) __attribute__((always_inline)) {
        const int cur = (j - j_lo) & 1;
        { const int jn = (j + 2 < j_hi) ? j + 2 : j_hi - 1; MX_LOADG(ka, va, jn); }
        bool active = 64 * j <= q0w + 31;
        if (MODE == 0) active = active && (64 * j + 63 >= q0w - 127);
        if (active) {
            const LAS unsigned char* Kb = lds + (cur ? MX_KB1 : MX_KB0) + kbase;
            const LAS unsigned char* Vb = lds + (cur ? MX_VB1 : MX_VB0) + vbase;
            f32x16 p[2];
#pragma unroll
            for (int kb = 0; kb < 2; ++kb) {
#pragma unroll
                for (int r = 0; r < 16; ++r) p[kb][r] = 0.f;
                { s16x8 kf[NKD];
#pragma unroll
                  for (int kd = 0; kd < NKD; ++kd) kf[kd] = *(const LAS s16x8*)(Kb + (32 * kb) * KP + 32 * kd);
                  __builtin_amdgcn_sched_barrier(0);
#pragma unroll
                  for (int kd = 0; kd < NKD; ++kd) p[kb] = __builtin_amdgcn_mfma_f32_32x32x16_bf16(kf[kd], qf[kd], p[kb], 0, 0, 0); }
            }
            const bool need_mask = (64 * j + 63 > q0w) || (MODE == 0 && 64 * j < q0w + 31 - 127);
            const int krel = qabs - 64 * j - 4 * hi;
            float den_t = 0.f;
            if (MODE == 1) {
#pragma unroll
                for (int kb = 0; kb < 2; ++kb) { const LAS float* bp = bias + 64 * j + 32 * kb + 4 * hi;
#pragma unroll
                    for (int g = 0; g < 4; ++g) { const f32x4 a4 = *(const LAS f32x4*)(bp + 8 * g);
#pragma unroll
                        for (int e = 0; e < 4; ++e) { const int r = 4 * g + e; float v = p[kb][r] * __builtin_amdgcn_exp2f(a4[e] - RL);
                            if (need_mask && (32 * kb + 8 * g + e) > krel) v = 0.f;
                            den_t += v; p[kb][r] = v; } } }
                lsum += den_t;
            } else {
                float tmax = -__builtin_inff();
#pragma unroll
                for (int kb = 0; kb < 2; ++kb) {
                    f32x4 b4[4];
                    if (MODE == 2) { const LAS float* bp = bias + 64 * j + 32 * kb + 4 * hi;
#pragma unroll
                        for (int g = 0; g < 4; ++g) b4[g] = *(const LAS f32x4*)(bp + 8 * g); }
#pragma unroll
                    for (int r = 0; r < 16; ++r) { const int ko = 32 * kb + 8 * (r >> 2) + (r & 3);
                        float s = p[kb][r];
                        if (MODE == 2) { s += b4[r >> 2][r & 3]; if (need_mask && ko > krel) s = -__builtin_inff(); }
                        else { const int dist = krel - ko; s -= slope * (float)dist; if (need_mask && (unsigned)dist >= 128u) s = -__builtin_inff(); }
                        p[kb][r] = s; tmax = fmaxf(tmax, s); }
                }
                tmax = swap32_max(tmax);
                if (!__all(tmax <= m + MX_THR)) {
                    const float mn = fmaxf(m, tmax), alpha = __builtin_amdgcn_exp2f(m - mn); m = mn; lsum *= alpha;
#pragma unroll
                    for (int db = 0; db < NDB; ++db)
#pragma unroll
                        for (int r = 0; r < 16; ++r) O[db][r] *= alpha;
                }
#pragma unroll
                for (int kb = 0; kb < 2; ++kb)
#pragma unroll
                    for (int r = 0; r < 16; ++r) { const float e = __builtin_amdgcn_exp2f(p[kb][r] - m); den_t += e; p[kb][r] = e; }
                lsum += den_t;
            }
            s16x8 pb[2][2];
#pragma unroll
            for (int kb = 0; kb < 2; ++kb)
#pragma unroll
                for (int s = 0; s < 2; ++s) { v4u w; w.x = cvt_pk_bf16(p[kb][8 * s + 0], p[kb][8 * s + 1]); w.y = cvt_pk_bf16(p[kb][8 * s + 2], p[kb][8 * s + 3]); w.z = cvt_pk_bf16(p[kb][8 * s + 4], p[kb][8 * s + 5]); w.w = cvt_pk_bf16(p[kb][8 * s + 6], p[kb][8 * s + 7]);
                    pb[kb][s] = __builtin_bit_cast(s16x8, w); }
#pragma unroll
            for (int db = 0; db < NDB; ++db) { s16x4 vlo[2][2], vhi[2][2];
#pragma unroll
                for (int kb = 0; kb < 2; ++kb)
#pragma unroll
                    for (int s = 0; s < 2; ++s) { vlo[kb][s] = vtr(Vb + (32 * kb + 16 * s) * VP + 64 * db); vhi[kb][s] = vtr(Vb + (32 * kb + 16 * s + 8) * VP + 64 * db); }
                __builtin_amdgcn_sched_barrier(0);
#pragma unroll
                for (int kb = 0; kb < 2; ++kb)
#pragma unroll
                    for (int s = 0; s < 2; ++s) { const s16x4 lo = vlo[kb][s], hh = vhi[kb][s];
                        const s16x8 a = (s16x8){lo[0], lo[1], lo[2], lo[3], hh[0], hh[1], hh[2], hh[3]};
                        O[db] = __builtin_amdgcn_mfma_f32_32x32x16_bf16(a, pb[kb][s], O[db], 0, 0, 0); } }
        }
        MX_STORE(kb_, vb_, cur ^ 1);
        __syncthreads();
    };
    for (int j = j_lo; j < j_hi; j += 2) { step(j, kr0, vr0, kr1, vr1); step(j + 1, kr1, vr1, kr0, vr0); }
#undef MX_LOADG
#undef MX_STORE
    const float tot = swap32_add(lsum);
    float inv;
    if (MODE == 1) inv = 1.f / fmaxf(fabsf(tot), ((const LAS float*)(lds + MX_SC_E))[32 * wave + c]);
    else inv = 1.f / tot;
    unsigned char* yp = (unsigned char*)Y + (rowb + qabs) * NY + yc + 4 * hi;
    const bf16* op = Z + (rowb + qabs) * NZ + ZC_MO + h * 128 + 4 * hi;
#pragma unroll
    for (int db = 0; db < NDB; ++db)
#pragma unroll
        for (int g = 0; g < 4; ++g) { float o0 = O[db][4 * g] * inv, o1 = O[db][4 * g + 1] * inv, o2 = O[db][4 * g + 2] * inv, o3 = O[db][4 * g + 3] * inv;
            if (MODE == 1) { const v2u gw = *(const v2u*)(op + 32 * db + 8 * g);
                o0 *= __builtin_amdgcn_rcpf(1.f + __builtin_amdgcn_exp2f(-LOG2E * bf_lo(gw.x))); o1 *= __builtin_amdgcn_rcpf(1.f + __builtin_amdgcn_exp2f(-LOG2E * bf_hi(gw.x)));
                o2 *= __builtin_amdgcn_rcpf(1.f + __builtin_amdgcn_exp2f(-LOG2E * bf_lo(gw.y))); o3 *= __builtin_amdgcn_rcpf(1.f + __builtin_amdgcn_exp2f(-LOG2E * bf_hi(gw.y))); }
            *(int*)(yp + 32 * db + 8 * g) = pk4_e4m3(o0 * Y8_SCALE, o1 * Y8_SCALE, o2 * Y8_SCALE, o3 * Y8_SCALE); }
}

constexpr int CW_QUEUE = 8192;
constexpr int MX_UNITS = 512 + 512;
constexpr int CV_CHUNK = 64;
__device__ __forceinline__ void mixers_mfma(Frame& F, KArgs A_, int l) {
    KArgs A = A_; OPQ_S(A);
    int lane = lane_id(); OPQ_V(lane);
    const bf16* Z = (const bf16*)(A->ws + WS_Z); bf16* Y = (bf16*)(A->ws + WS_Y); const float* G = (const float*)(A->ws + WS_G);
    unsigned* qhead = (unsigned*)(A->ws + WS_CTL) + CW_QUEUE + 64 * l;
    volatile LAS unsigned* qw = F.MISC + 16;
    LAS float* scr = (LAS float*)(F.lds) + F.wave * (64 * 65);
    const int cv_lo = l ? I_LAYER + I_IN : I_IN, cv_n = ((l ? 2 * I_LAYER : I_LAYER + I_IN) - cv_lo) / CV_CHUNK;
    static_assert(I_IN % CV_CHUNK == 0 && I_LAYER % CV_CHUNK == 0 && (I_LAYER - I_IN) / CV_CHUNK <= MX_UNITS, "queue layout");
    const unsigned long long order = 0x081923A4B5C67DEFull;
    unsigned pend = 0u;
    if (F.wave == 0 && lane == 0) qw[0] = __hip_atomic_fetch_add(qhead, 1u, __ATOMIC_RELAXED, __HIP_MEMORY_SCOPE_AGENT);
    __syncthreads();
    for (;;) {
        const unsigned e = qw[0];
        if (e >= (unsigned)(MX_UNITS + cv_n)) break;
        OPQ_V(lane);
        if (F.wave == 0 && lane == 0) pend = __hip_atomic_fetch_add(qhead, 1u, __ATOMIC_RELAXED, __HIP_MEMORY_SCOPE_AGENT);
        int u = -1, c = -1;
        if (e < 2u * (unsigned)cv_n) { if (e & 1u) c = (int)(e >> 1); else u = (int)(e >> 1); } else u = (int)e - cv_n;
        if (c >= 0) {
            { f32x4 a1 = (f32x4){0.f, 0.f, 0.f, 0.f}, a2 = a1;
#pragma unroll 1
            for (int k = 0; k < CV_CHUNK / NWAVES; ++k) conv_item(A, cv_lo + c * CV_CHUNK + F.wave * (CV_CHUNK / NWAVES) + k, scr, lane, a1, a2, k == CV_CHUNK / NWAVES - 1); }
        } else if (u < 512) {
            const unsigned code = (unsigned)(order >> (4 * (u >> 5))) & 15u; const int bh = u & 31, qb = code & 7;
            if (code & 8u) mixer_unit<2>(F.lds, Z, Y, G, A->in[4][l * 8 + (bh & 7)], 0.f, 0.f, bh >> 3, bh & 7, qb, F.wave, lane);
            else mixer_unit<1>(F.lds, Z, Y, G, A->in[3][l * 8 + (bh & 7)], A->in[2][l * 8 + (bh & 7)], 0.f, bh >> 3, bh & 7, qb, F.wave, lane);
        } else {
            const unsigned v = (unsigned)u - 512u; const int qb = 7 - (int)(v >> 6), bh = v & 63;
            mixer_unit<0>(F.lds, Z, Y, G, 0.f, 0.f, A->in[5][l * 16 + (bh & 15)] * LOG2E, bh >> 4, bh & 15, qb, F.wave, lane);
        }
        __syncthreads();
        if (F.wave == 0 && lane == 0) qw[0] = pend;
        __syncthreads();
    }
}

constexpr int PH_PER_LAYER = 7, N_PHASES = 2 + DEPTH * PH_PER_LAYER;
__global__ void __launch_bounds__(NWAVES * 64, 2) hyb_fwd(Args args) {
    extern __shared__ __attribute__((aligned(16))) unsigned char lds[];
    Frame F;
    F.lds = (LAS unsigned char*)lds;
    F.MISC = (volatile LAS unsigned*)(F.lds + MISC_OFF);
    F.wave = __builtin_amdgcn_readfirstlane((int)threadIdx.x >> 6);
    F.G = gridDim.x; { const int bx = blockIdx.x; F.vcu = (F.G % 8 == 0) ? (bx % 8) * (F.G / 8) + bx / 8 : bx; }
    const KArgs ka = (KArgs)__builtin_amdgcn_kernarg_segment_ptr();
    F.ctl = (gu32*)(args.ws + WS_CTL);
    for (int u = threadIdx.x; u < (LDS_BYTES - LDSCTL_OFF) / 4; u += NWAVES * 64) ((LAS unsigned*)(F.lds + LDSCTL_OFF))[u] = 0u;
    __syncthreads();
    const int lo = args.ph_lo, hi = args.ph_hi;
    XcdBarrier bar; bar.bar = (unsigned*)(F.ctl + CW_BAR); bar.x = 0; bar.st = F.MISC + 8; bar.wave = F.wave;
    if (hi - lo > 1) { bar = xcd_barrier_post((unsigned*)(F.ctl + CW_BAR), F.MISC + 8); bar.wave = F.wave; }
#define IN(k) (lo <= (k) && (k) < hi)
#define SEAM(k) do { if (IN(k) && IN((k) + 1)) xcd_barrier(bar); } while (0)
#define PHASE_PTRS KArgs A = ka; OPQ_S(A); unsigned char* ws = A->ws; int bx = blockIdx.x; OPQ_S(bx); unsigned* ctlw = (unsigned*)(ws + WS_CTL)
#define FXP(word_off) ((pg8::fx64*)(ctlw + (word_off)))
#define STATP(layer, which) FXP(CW_STAT + ((layer) * 2 + (which)) * 4 * M)

    if (IN(0)) { p0_prologue(F, ka); } SEAM(0);

    for (int l = 0; l < DEPTH; ++l) {
        const int pb = 1 + l * PH_PER_LAYER;
        if (IN(pb + 0)) {
            PHASE_PTRS;
            pg8::Gemm g{(const pg8::bf16_t*)(ws + (l ? WS_TB : WS_XB)), (const pg8::bf16_t*)(ws + WS_WIN + l * SZ_WIN), M, NZB, D}; pg8::StaticOrder S; S.init(M, NZB, F.G, bx);
            pg8::EpiZ<false> E{(pg8::bf16_t*)(ws + WS_Z), (float*)(ws + WS_G), NZ, M, pg8::LnFold{STATP(l ? l - 1 : 0, 1), l ? (const float*)(ws + WS_SC) : (const float*)(ctlw + CW_ZERO), l ? (const float*)(ws + WS_SC) + NZP : (const float*)(ctlw + CW_ZERO), l}};
            pg8::gemm_phase<pg8::EpiZ<false>, pg8::StaticOrder, PG8_ALIGN, PG8_SP2>(F.lds + RING_OFF, g, S, E, F.wave);
        }
        if (IN(pb + 0) && fp6_layer(l)) {
            PHASE_PTRS;
            pg8::Gemm g{(const pg8::bf16_t*)(ws + WS_A6), (const pg8::bf16_t*)(ws + WS_WIN8 + l * SZ_WIN8), M, NZ8, D / 2}; pg8::ExtraOrder S; S.init(M, NZ8, F.G, bx);
            if (F.G == 256) { S.n_full = 7; S.n_extra = 2; S.c_min = 64; } else { S.n_full = (M / 256) * (NZ8 / 256) / F.G + 1; S.n_extra = 0; S.c_min = 0; }
            if (l == 0) { pg8::EpiZ<true, 0, 1> E{(pg8::bf16_t*)(ws + WS_Z), (float*)(ws + WS_G), NZ, M, pg8::LnFold{STATP(0, 1), (const float*)(ctlw + CW_ZERO), (const float*)(ctlw + CW_ZERO), 0}};
                pg8::gemm_phase_fp6d<pg8::EpiZ<true, 0, 1>, pg8::ExtraOrder, PG8_ALIGN>(F.lds + RING_OFF, g, S, E, F.wave); }
            else { pg8::EpiZ<true, 0, 2> E{(pg8::bf16_t*)(ws + WS_Z), (float*)(ws + WS_G), NZ, M, pg8::LnFold{STATP(l - 1, 1), (const float*)(ws + WS_SC), (const float*)(ws + WS_SC) + NZP, 1}};
                pg8::gemm_phase_fp6d<pg8::EpiZ<true, 0, 2>, pg8::ExtraOrder, PG8_ALIGN>(F.lds + RING_OFF, g, S, E, F.wave); }
        }
        if (IN(pb + 0) && !fp6_layer(l)) {
            PHASE_PTRS;
            pg8::Gemm g{(const pg8::bf16_t*)(ws + WS_A8), (const pg8::bf16_t*)(ws + WS_WIN8 + l * SZ_WIN8), M, NZ8, D / 2}; pg8::ExtraOrder S; S.init(M, NZ8, F.G, bx);
            if (F.G == 256) { S.n_full = 7; S.n_extra = 2; S.c_min = 64; } else { S.n_full = (M / 256) * (NZ8 / 256) / F.G + 1; S.n_extra = 0; S.c_min = 0; }
            pg8::EpiZ<true> E{(pg8::bf16_t*)(ws + WS_Z), (float*)(ws + WS_G), NZ, M, pg8::LnFold{STATP(l ? l - 1 : 0, 1), l ? (const float*)(ws + WS_SC) : (const float*)(ctlw + CW_ZERO), l ? (const float*)(ws + WS_SC) + NZP : (const float*)(ctlw + CW_ZERO), l}};
            pg8::gemm_phase<pg8::EpiZ<true>, pg8::ExtraOrder, PG8_ALIGN, PG8_SP2, true>(F.lds + RING_OFF, g, S, E, F.wave);
        }
        SEAM(pb + 0);
#if defined(MIX_NAIVE)
        if (IN(pb + 1)) { scan_phase(F, ka, l); }
        SEAM(pb + 1);
#endif
#if defined(MIX_NAIVE)
        if (IN(pb + 2)) { mixers_naive(F, ka, l); }
#else
        if (IN(pb + 2)) { mixers_mfma(F, ka, l); }
#endif
        SEAM(pb + 2);
        if (IN(pb + 3)) {
            PHASE_PTRS;
            {
                float* cf = (float*)(ws + WS_SC); int tl_ = F.wave * 64 + lane_id(); OPQ_V(tl_); const int t0 = bx * 512 + tl_, nt_ = F.G * 512;
                if (l == 0) for (int i = t0; i < 2 * NZP; i += nt_) cf[i] = (float)FXP(CW_CIN)[i] * (1.f / FX_C);
                for (int i = t0; i < 2 * DFF; i += nt_) cf[2 * NZP + l * 2 * DFF + i] = (float)(FXP(CW_CF1) + l * 2 * DFF)[i] * (1.f / FX_C);
            }
            pg8::Gemm g{(const pg8::bf16_t*)(ws + WS_Y), (const pg8::bf16_t*)(ws + WS_WUP + l * SZ_WUP), M, D, NY / 2}; pg8::StaticOrder S; S.init(M, D, F.G, bx);
            pg8::EpiMix<true> E{(const pg8::bf16_t*)(ws + WS_Z) + ZC_GA, (pg8::bf16_t*)(ws + WS_MIX), NZ, D, MIX8_SCALE / (Y8_SCALE * W8_SCALE)};
            pg8::gemm_phase<pg8::EpiMix<true>, pg8::StaticOrder, PG8_ALIGN, PG8_SP2, true>(F.lds + RING_OFF, g, S, E, F.wave);
        }
        SEAM(pb + 3);
        if (IN(pb + 4)) {
            PHASE_PTRS;
            pg8::Gemm g{(const pg8::bf16_t*)(ws + WS_MIX), (const pg8::bf16_t*)(ws + WS_WO + l * SZ_WO), M, D, D / 2}; pg8::StaticOrder S; S.init(M, D, F.G, bx);
            if (l == 0) { pg8::EpiRes<0, true> E{A->in[0], nullptr, nullptr, A->in[14], A->in[15], (pg8::bf16_t*)(ws + WS_TA), STATP(l, 0), nullptr, nullptr, D};
                pg8::gemm_phase<pg8::EpiRes<0, true>, pg8::StaticOrder, PG8_ALIGN, PG8_SP2, true>(F.lds + RING_OFF, g, S, E, F.wave); }
            else { pg8::EpiRes<1, true> E{nullptr, (const pg8::bf16_t*)(ws + WS_TB), STATP(l - 1, 1), A->in[14] + (l - 1) * D, A->in[15] + (l - 1) * D, (pg8::bf16_t*)(ws + WS_TA), STATP(l, 0), nullptr, nullptr, D};
                pg8::gemm_phase<pg8::EpiRes<1, true>, pg8::StaticOrder, PG8_ALIGN, PG8_SP2, true>(F.lds + RING_OFF, g, S, E, F.wave); }
        }
        SEAM(pb + 4);
        if (IN(pb + 5)) {
            PHASE_PTRS;
            pg8::Gemm g{(const pg8::bf16_t*)(ws + WS_TA), (const pg8::bf16_t*)(ws + WS_WF1 + l * SZ_WF), M, DFF, D}; pg8::StaticOrder S; S.init(M, DFF, F.G, bx);
            pg8::EpiRelu2 E{(pg8::bf16_t*)(ws + WS_Z), DFF, pg8::LnFold{STATP(l, 0), (const float*)(ws + WS_SC) + 2 * NZP + l * 2 * DFF, (const float*)(ws + WS_SC) + 2 * NZP + l * 2 * DFF + DFF, 1}};
            pg8::gemm_phase<pg8::EpiRelu2, pg8::StaticOrder, PG8_ALIGN, PG8_SP2>(F.lds + RING_OFF, g, S, E, F.wave);
        }
        SEAM(pb + 5);
        if (IN(pb + 6)) {
            PHASE_PTRS;
            pg8::Gemm g{(const pg8::bf16_t*)(ws + WS_Z), (const pg8::bf16_t*)(ws + WS_WF2 + l * SZ_WF), M, D, DFF}; pg8::StaticOrder S; S.init(M, D, F.G, bx);
            pg8::EpiRes<1, false> E{nullptr, (const pg8::bf16_t*)(ws + WS_TA), STATP(l, 0), A->in[10] + l * D, A->in[11] + l * D,
                             (pg8::bf16_t*)(ws + WS_TB), STATP(l, 1), nullptr, (l + 1 < DEPTH) ? ws + WS_A6 : nullptr, D};
            pg8::gemm_phase<pg8::EpiRes<1, false>, pg8::StaticOrder, PG8_ALIGN, PG8_SP2>(F.lds + RING_OFF, g, S, E, F.wave);
        }
        SEAM(pb + 6);
    }
    if (IN(N_PHASES - 1)) { PHASE_PTRS; (void)bx; lnout_phase(F, (const bf16*)(ws + WS_TB), STATP(DEPTH - 1, 1), A->in[14] + (DEPTH - 1) * D, A->in[15] + (DEPTH - 1) * D, A->out); }
#undef IN
#undef SEAM
#undef PHASE_PTRS
#undef FXP
#undef STATP
}

extern "C" void kernel_launch(void* const* d_in, const int* in_sizes, int n_in, void* d_out, int out_size, void* d_ws, size_t ws_size, hipStream_t stream) {
    static int grid = 0;
    if (grid == 0) {
        if (n_in != 16 || in_sizes[0] != M * D || out_size != M * D || ws_size < WS_END) { fprintf(stderr, "kernel_launch: unexpected shapes (n_in %d, in0 %d, out %d, ws %zu < %zu)\n", n_in, n_in > 0 ? in_sizes[0] : -1, out_size, ws_size, (size_t)WS_END); grid = -1; return; }
        int dev = 0, cus = 0, per_cu = 0;
        if (hipGetDevice(&dev) != hipSuccess || hipDeviceGetAttribute(&cus, hipDeviceAttributeMultiprocessorCount, dev) != hipSuccess) { grid = -1; return; }
        if (hipFuncSetAttribute((const void*)hyb_fwd, hipFuncAttributeMaxDynamicSharedMemorySize, LDS_BYTES) != hipSuccess) { fprintf(stderr, "kernel_launch: hipFuncSetAttribute failed\n"); grid = -1; return; }
        if (hipOccupancyMaxActiveBlocksPerMultiprocessor(&per_cu, (const void*)hyb_fwd, NWAVES * 64, LDS_BYTES) != hipSuccess || per_cu < 1) { fprintf(stderr, "kernel_launch: occupancy query says %d blocks per CU\n", per_cu); (void)hipGetLastError(); grid = -1; return; }
        grid = cus;
    }
    if (grid < 0) return;
    (void)hipMemsetAsync((char*)d_ws + WS_CTL, 0, CTL_ZERO_BYTES, stream);
    Args a{};
    for (int i = 0; i < 16; ++i) a.in[i] = (const float*)d_in[i];
    a.out = (float*)d_out; a.ws = (unsigned char*)d_ws;
#if MK_N_LAUNCHES == 1
    a.ph_lo = 0; a.ph_hi = N_PHASES;
    hipLaunchKernelGGL(hyb_fwd, dim3(grid), dim3(NWAVES * 64), LDS_BYTES, stream, a);
#else
    for (int p = 0; p < N_PHASES; ++p) { a.ph_lo = p; a.ph_hi = p + 1; hipLaunchKernelGGL(hyb_fwd, dim3(grid), dim3(NWAVES * 64), LDS_BYTES, stream, a); }
#endif
}
```

```cpp
#include <hip/hip_runtime.h>
#include <cstdio>
#include <cstdint>

#define OPQ_V(x) asm volatile("" : "+v"(x))
#define OPQ_S(x) asm volatile("" : "+s"(x))
__device__ __forceinline__ int lane_id() { unsigned z = 0u; asm volatile("" : "+v"(z)); return (int)__builtin_amdgcn_mbcnt_hi(~0u, __builtin_amdgcn_mbcnt_lo(~0u, z)); }
__device__ __forceinline__ int pk4_e4m3(float a, float b, float c, float d) {
    a = __builtin_amdgcn_fmed3f(a, -448.f, 448.f); b = __builtin_amdgcn_fmed3f(b, -448.f, 448.f); c = __builtin_amdgcn_fmed3f(c, -448.f, 448.f); d = __builtin_amdgcn_fmed3f(d, -448.f, 448.f);
    int p = __builtin_amdgcn_cvt_pk_fp8_f32(a, b, 0, false); return __builtin_amdgcn_cvt_pk_fp8_f32(c, d, p, true);
}
__device__ __forceinline__ unsigned q_e2m3(float x) {
    const float a = fminf(fabsf(x), 7.5f); const float s = a < 2.f ? 8.f : (a < 4.f ? 4.f : 2.f); const unsigned o = a < 2.f ? 0u : (a < 4.f ? 8u : 16u);
    return ((unsigned)(int)__builtin_rintf(a * s) + o) | (x < 0.f ? 32u : 0u);
}
__device__ __forceinline__ float v_e2m3(float x) {
    const float a = fminf(fabsf(x), 7.5f); const float s = a < 2.f ? 8.f : (a < 4.f ? 4.f : 2.f), si = a < 2.f ? 0.125f : (a < 4.f ? 0.25f : 0.5f);
    return __builtin_copysignf(__builtin_rintf(a * s) * si, x);
}
typedef unsigned pk6x4_t __attribute__((ext_vector_type(4)));
__device__ __forceinline__ pk6x4_t pack16_e2m3(const unsigned (&c)[16]) {
    pk6x4_t d;
    d.x = c[0] | (c[1] << 6) | (c[2] << 12) | (c[3] << 18) | (c[4] << 24) | (c[5] << 30);
    d.y = (c[5] >> 2) | (c[6] << 4) | (c[7] << 10) | (c[8] << 16) | (c[9] << 22) | (c[10] << 28);
    d.z = (c[10] >> 4) | (c[11] << 2) | (c[12] << 8) | (c[13] << 14) | (c[14] << 20) | (c[15] << 26);
    d.w = 0u; return d;
}
__device__ __forceinline__ unsigned char* e2m3_ktile(unsigned char* img, int row, int kt, bool perm) {
    int rin = row & 255; if (perm) { const int w = rin & 31; rin = (rin & ~31) + 16 * ((w >> 2) & 1) + 4 * (w >> 3) + (w & 3); }
    return img + ((size_t)((row >> 8) * 32 + kt) * 256 + rin) * 96;
}
__device__ __forceinline__ void store_e2m3_group(unsigned char* ktile, int c16, pk6x4_t d) { unsigned* p = (unsigned*)(ktile + 12 * c16); p[0] = d.x; p[1] = d.y; p[2] = d.z; }
#ifndef MK_N_LAUNCHES
#define MK_N_LAUNCHES 1
#endif

namespace pg8 {
#define PG8_LAS __attribute__((address_space(3)))
typedef unsigned short bf16_t;
typedef short bf16x8 __attribute__((ext_vector_type(8)));
typedef float f32x4 __attribute__((ext_vector_type(4)));
typedef unsigned u32x4 __attribute__((ext_vector_type(4)));
constexpr int BM = 256, BK = 64, HALF = 128, HTB = HALF * BK * 2, STAGE_BYTES = 8 * HTB, NXCD = 8, WGM = 8;

__host__ __device__ __forceinline__ int lds_byte(int r, int c) { const int st = (r >> 4) * 2 + (c >> 5), rr = r & 15, cc = c & 31, ob = rr * 64 + cc * 2; return st * 1024 + (ob ^ (((ob >> 9) & 1) << 5)); }
__host__ __device__ __forceinline__ void stage_rc(int b, int& R, int& C) { const int st = b / 1024, sb = b % 1024, swz = sb ^ (((sb >> 9) & 1) << 5); R = (st >> 1) * 16 + swz / 64; C = (st & 1) * 32 + (swz % 64) / 2; }
__host__ __device__ __forceinline__ int perm32(int rho) { const int n = rho >> 4, i = rho & 15; return 8 * (i >> 2) + 4 * n + (i & 3); }

struct Unit { int pm, pn; };
struct Gemm { const bf16_t* A; const bf16_t* Bt; int M, N, K; };

struct StaticOrder {
    int nM, nN, nwg, G, c;
    __host__ __device__ void init(int M, int N, int G_, int c_) { nM = M / BM; nN = N / BM; nwg = nM * nN; G = G_; c = c_; }
    __host__ __device__ bool next(int i, Unit& u) const {
        const long L = (long)i * G + c; if (L >= nwg) return false;
        int wgid = (int)L; { const int q = nwg / NXCD, r = nwg % NXCD, xcd = wgid % NXCD, off = wgid / NXCD; wgid = (xcd < r ? xcd * (q + 1) : r * (q + 1) + (xcd - r) * q) + off; }
        const int nig = WGM * nN, gid = wgid / nig, fm = gid * WGM, gsz = (nM - fm) < WGM ? (nM - fm) : WGM;
        u.pm = fm + ((wgid % nig) % gsz); u.pn = (wgid % nig) / gsz; return true;
    }
    __device__ __forceinline__ void a_ready(const Unit&) const {}
    __device__ __forceinline__ void done(const Unit&) const {}
};

struct ExtraOrder : StaticOrder {
    int n_full, n_extra, c_min;
    __host__ __device__ bool next(int i, Unit& u) const {
        long L;
        if (i < n_full) L = (long)i * G + c;
        else if (c >= c_min && i < n_full + n_extra) L = (long)n_full * G + (long)(i - n_full) * (G - c_min) + (c - c_min);
        else return false;
        if (L >= nwg) return false;
        int wgid = (int)L; { const int q = nwg / NXCD, r = nwg % NXCD, xcd = wgid % NXCD, off = wgid / NXCD; wgid = (xcd < r ? xcd * (q + 1) : r * (q + 1) + (xcd - r) * q) + off; }
        const int nig = WGM * nN, gid = wgid / nig, fm = gid * WGM, gsz = (nM - fm) < WGM ? (nM - fm) : WGM;
        u.pm = fm + ((wgid % nig) % gsz); u.pn = (wgid % nig) / gsz; return true;
    }
};

__device__ __forceinline__ unsigned cvt_pk_bf16(float lo, float hi) { unsigned r; asm volatile("v_cvt_pk_bf16_f32 %0, %1, %2" : "=v"(r) : "v"(lo), "v"(hi)); return r; }
__device__ __forceinline__ float bf_lo(unsigned w) { return __uint_as_float(w << 16); }
__device__ __forceinline__ float bf_hi(unsigned w) { return __uint_as_float(w & 0xffff0000u); }


typedef float f32x2 __attribute__((ext_vector_type(2)));
typedef long long fx64;
__device__ __forceinline__ void fx_add(fx64* p, float v, float scale) { __hip_atomic_fetch_add(p, (fx64)__float2ll_rn(v * scale), __ATOMIC_RELAXED, __HIP_MEMORY_SCOPE_AGENT); }
struct LnFold {
    const fx64* st; const float* c1; const float* c2; int on;
    static constexpr float INV_D = 1.f / 4096.f, EPS = 1e-5f;
    __device__ __forceinline__ void row(int r, float& rr, float& rm) const {
        if (on) { const fx64 a = st[2 * (size_t)r], b = st[2 * (size_t)r + 1]; const float mu = (float)a * (INV_D / 16777216.f), var = fmaxf((float)b * (INV_D / 1048576.f) - mu * mu, 0.f); rr = __builtin_amdgcn_rsqf(var + EPS); rm = rr * mu; }
        else { rr = 1.f; rm = 0.f; }
    }
    __device__ __forceinline__ void cols(int c0, f32x4 (&k1)[2][2], f32x4 (&k2)[2][2]) const {
#pragma unroll
        for (int bj = 0; bj < 2; ++bj)
#pragma unroll
            for (int n = 0; n < 2; ++n) { k1[bj][n] = *(const f32x4*)(c1 + c0 + bj * HALF + 4 * n); k2[bj][n] = *(const f32x4*)(c2 + c0 + bj * HALF + 4 * n); }
    }
};
constexpr float A6_SCALE = 2.f, A6_SCALE1 = 1.f, W6_SCALE = 128.f;
template <bool F8, int PN0 = 0, int F6 = 0> struct EpiZ {
    static constexpr bool PERM = true, AFTER_DRAIN = false, HAS_MID = false, WAIT_AFTER_EPI = !F8;
    bf16_t* Z; float* G; int ldz, Mrows; LnFold ln;
    static constexpr int gate_pn = F8 ? -1 : 9, seg_pn = F8 ? 4 : 9, off_lo = F8 ? 0 : 1024, off_hi = F8 ? 2304 : 1024, gate_coff = 19712 - 9 * 256; static constexpr float ascale = F6 == 1 ? 1.f / (A6_SCALE * W6_SCALE) : F6 == 2 ? 1.f / (A6_SCALE1 * W6_SCALE) : F8 ? 1.f / 64.f : 1.f;
    __device__ __forceinline__ void operator()(const f32x4 (&acc)[2][2][4][2], const Unit& u, int wr, int wc, int fr, int fq) const {
        OPQ_V(fr); OPQ_V(fq);
        const int pn = u.pn + PN0;
        const int row0 = u.pm * BM + wr * 64 + fr, col0 = pn * BM + wc * 32 + 8 * fq + (pn == gate_pn ? gate_coff : (pn < seg_pn ? off_lo : off_hi));
        f32x4 k1[2][2], k2[2][2]; ln.cols(col0, k1, k2);
        const float asc = F6 ? (F6 == 1 ? 1.f / A6_SCALE : 1.f / A6_SCALE1) * (pn < 4 ? 1.f / 512.f : pn < 8 ? 1.f / 128.f : pn < 12 ? 1.f / 1024.f : pn < 16 ? 1.f / 128.f : pn < 20 ? 1.f / 256.f : 1.f / 128.f) : ascale;
        if (pn == gate_pn) {
#pragma unroll
            for (int bj = 0; bj < 2; ++bj)
#pragma unroll
                for (int n = 0; n < 2; ++n) asm volatile("" :: "v"(k1[bj][n]), "v"(k2[bj][n]));
            if (wc == 0 && fq < 3) {
#pragma unroll
                for (int ai = 0; ai < 2; ++ai)
#pragma unroll
                    for (int m = 0; m < 4; ++m) { const int r = row0 + ai * HALF + m * 16; float rr, rm; ln.row(r, rr, rm); rr *= asc;
#pragma unroll
                        for (int n = 0; n < 2; ++n)
#pragma unroll
                            for (int j = 0; j < 4; ++j) G[(size_t)(8 * fq + 4 * n + j) * Mrows + r] = rr * acc[ai][0][m][n][j] - rm * k1[0][n][j] + k2[0][n][j]; }
            }
            return;
        }
#pragma unroll
        for (int ai = 0; ai < 2; ++ai)
#pragma unroll
            for (int m = 0; m < 4; ++m) { const int r = row0 + ai * HALF + m * 16; float rr, rm; ln.row(r, rr, rm); rr *= asc; bf16_t* rowp = Z + (size_t)r * ldz + col0;
#pragma unroll
                for (int bj = 0; bj < 2; ++bj) { f32x4 v0 = acc[ai][bj][m][0] * rr - k1[bj][0] * rm + k2[bj][0], v1 = acc[ai][bj][m][1] * rr - k1[bj][1] * rm + k2[bj][1];
                    if (F8 && pn >= 20) {
#pragma unroll
                        for (int j = 0; j < 4; ++j) { v0[j] = __builtin_amdgcn_exp2f(__builtin_amdgcn_fmed3f(v0[j], -40.f, 40.f) * -1.4426950408889634f); v1[j] = __builtin_amdgcn_exp2f(__builtin_amdgcn_fmed3f(v1[j], -40.f, 40.f) * -1.4426950408889634f); } }
                    u32x4 w; w.x = cvt_pk_bf16(v0[0], v0[1]); w.y = cvt_pk_bf16(v0[2], v0[3]); w.z = cvt_pk_bf16(v1[0], v1[1]); w.w = cvt_pk_bf16(v1[2], v1[3]);
                    *(u32x4*)(rowp + bj * HALF) = w; } }
    }
};
struct EpiRelu2 {
    static constexpr bool PERM = true, AFTER_DRAIN = false, HAS_MID = false, WAIT_AFTER_EPI = false;
    bf16_t* O; int ldc; LnFold ln;
    __device__ __forceinline__ void operator()(const f32x4 (&acc)[2][2][4][2], const Unit& u, int wr, int wc, int fr, int fq) const {
        OPQ_V(fr); OPQ_V(fq);
        const int row0 = u.pm * BM + wr * 64 + fr, col0 = u.pn * BM + wc * 32 + 8 * fq;
        f32x4 k1[2][2], k2[2][2]; ln.cols(col0, k1, k2);
#pragma unroll
        for (int ai = 0; ai < 2; ++ai)
#pragma unroll
            for (int m = 0; m < 4; ++m) { const int r = row0 + ai * HALF + m * 16; float rr, rm; ln.row(r, rr, rm); bf16_t* rowp = O + (size_t)r * ldc + col0;
#pragma unroll
                for (int bj = 0; bj < 2; ++bj) { f32x4 v0 = acc[ai][bj][m][0] * rr - k1[bj][0] * rm + k2[bj][0], v1 = acc[ai][bj][m][1] * rr - k1[bj][1] * rm + k2[bj][1];
#pragma unroll
                    for (int j = 0; j < 4; ++j) { const float a = fmaxf(v0[j], 0.f), b = fmaxf(v1[j], 0.f); v0[j] = a * a; v1[j] = b * b; }
                    u32x4 w; w.x = cvt_pk_bf16(v0[0], v0[1]); w.y = cvt_pk_bf16(v0[2], v0[3]); w.z = cvt_pk_bf16(v1[0], v1[1]); w.w = cvt_pk_bf16(v1[2], v1[3]);
                    *(u32x4*)(rowp + bj * HALF) = w; } }
    }
};
template <int mode, bool F8> struct EpiRes {
    static constexpr bool PERM = true, AFTER_DRAIN = false, HAS_MID = false, WAIT_AFTER_EPI = false;
    const float* X; const bf16_t* Tp; const fx64* stp; const float* g; const float* b; bf16_t* T; fx64* sto; unsigned char* T8; unsigned char* T6; PG8_LAS float* stx; int ldc; static constexpr float alpha = 1.41421356237309515f  , ascale = F8 ? 1.f / 2048.f : 1.f;
    __device__ __forceinline__ void operator()(const f32x4 (&acc)[2][2][4][2], const Unit& u, int wr, int wc, int fr, int fq) const {
        OPQ_V(fr); OPQ_V(fq);
        const int row0 = u.pm * BM + wr * 64 + fr, col0 = u.pn * BM + wc * 32 + 8 * fq;
        f32x4 gv[2][2], bv[2][2];
#pragma unroll
        for (int bj = 0; bj < 2; ++bj)
#pragma unroll
            for (int n = 0; n < 2; ++n) { if (mode) { gv[bj][n] = *(const f32x4*)(g + col0 + bj * HALF + 4 * n); bv[bj][n] = *(const f32x4*)(b + col0 + bj * HALF + 4 * n); } }
        LnFold lp{stp, nullptr, nullptr, mode};
        const int lane = fr + 16 * fq;
#pragma unroll
        for (int ai = 0; ai < 2; ++ai) {
            u32x4 tw[4][2];
            if (mode) {
#pragma unroll
                for (int m = 0; m < 4; ++m)
#pragma unroll
                    for (int bj = 0; bj < 2; ++bj) tw[m][bj] = *(const u32x4*)(Tp + (size_t)(row0 + ai * HALF + m * 16) * ldc + col0 + bj * HALF);
            }
#pragma unroll
            for (int mp = 0; mp < 2; ++mp) {
                f32x4 xf[2][2][2];
                if (!mode) {
#pragma unroll
                    for (int mm = 0; mm < 2; ++mm)
#pragma unroll
                        for (int bj = 0; bj < 2; ++bj)
#pragma unroll
                            for (int n = 0; n < 2; ++n) xf[mm][bj][n] = *(const f32x4*)(X + (size_t)(row0 + ai * HALF + (2 * mp + mm) * 16) * ldc + col0 + bj * HALF + 4 * n);
                }
#pragma unroll
                for (int mm = 0; mm < 2; ++mm) { const int m = 2 * mp + mm, r = row0 + ai * HALF + m * 16; bf16_t* rowp = T + (size_t)r * ldc + col0; float s1 = 0.f, s2 = 0.f;
                    float rr = 1.f, rm = 0.f; if (mode) lp.row(r, rr, rm);
                    unsigned p6lo[2], p6hi[2];
#pragma unroll
                    for (int bj = 0; bj < 2; ++bj) { f32x4 x0, x1;
                        if (mode) { const u32x4 w = tw[m][bj];
                            x0 = ((f32x4){bf_lo(w.x), bf_hi(w.x), bf_lo(w.y), bf_hi(w.y)} * rr - rm) * gv[bj][0] + bv[bj][0];
                            x1 = ((f32x4){bf_lo(w.z), bf_hi(w.z), bf_lo(w.w), bf_hi(w.w)} * rr - rm) * gv[bj][1] + bv[bj][1]; }
                        else { x0 = xf[mm][bj][0]; x1 = xf[mm][bj][1]; }
                        const f32x4 v0 = x0 * alpha + acc[ai][bj][m][0] * ascale, v1 = x1 * alpha + acc[ai][bj][m][1] * ascale;
                        u32x4 w; w.x = cvt_pk_bf16(v0[0], v0[1]); w.y = cvt_pk_bf16(v0[2], v0[3]); w.z = cvt_pk_bf16(v1[0], v1[1]); w.w = cvt_pk_bf16(v1[2], v1[3]);
                        *(u32x4*)(rowp + bj * HALF) = w;
                        if (T6) { unsigned cd[8];
#pragma unroll
                            for (int e = 0; e < 4; ++e) { cd[e] = q_e2m3(v0[e] * A6_SCALE1); cd[4 + e] = q_e2m3(v1[e] * A6_SCALE1); }
                            p6lo[bj] = cd[0] | (cd[1] << 6) | (cd[2] << 12) | (cd[3] << 18) | (cd[4] << 24) | (cd[5] << 30); p6hi[bj] = (cd[5] >> 2) | (cd[6] << 4) | (cd[7] << 10); }
#pragma unroll
                        for (int d = 0; d < 4; ++d) { const float a = bf_lo(w[d]), c = bf_hi(w[d]); s1 += a + c; s2 += a * a + c * c; } }
                    if (T6) {
                        const bool odd = (fq & 1) != 0;
                        const unsigned rlo = (unsigned)__builtin_amdgcn_ds_bpermute((lane ^ 16) << 2, (int)(odd ? p6lo[0] : p6lo[1])), rhi = (unsigned)__builtin_amdgcn_ds_bpermute((lane ^ 16) << 2, (int)(odd ? p6hi[0] : p6hi[1]));
                        const unsigned flo = odd ? rlo : p6lo[0], fhi = odd ? rhi : p6hi[0], slo = odd ? p6lo[1] : rlo, shi = odd ? p6hi[1] : rhi;
                        pk6x4_t d6; d6.x = flo; d6.y = fhi | (slo << 16); d6.z = (slo >> 16) | (shi << 16); d6.w = 0u;
                        store_e2m3_group(e2m3_ktile(T6, r, 2 * u.pn + (odd ? 1 : 0), false), 2 * wc + (fq >> 1), d6); }
                    s1 += __int_as_float(__builtin_amdgcn_ds_bpermute((lane ^ 16) << 2, __float_as_int(s1))); s2 += __int_as_float(__builtin_amdgcn_ds_bpermute((lane ^ 16) << 2, __float_as_int(s2)));
                    s1 += __int_as_float(__builtin_amdgcn_ds_bpermute((lane ^ 32) << 2, __float_as_int(s1))); s2 += __int_as_float(__builtin_amdgcn_ds_bpermute((lane ^ 32) << 2, __float_as_int(s2)));
                    if (fq == 0) { PG8_LAS float* sp_ = stx + (((wr * 4 + wc) * 128) + ai * 64 + m * 16 + fr) * 2; sp_[0] = s1; sp_[1] = s2; } }
                asm volatile("" ::: "memory");
            }
        }
        asm volatile("s_waitcnt lgkmcnt(0)" ::: "memory"); __builtin_amdgcn_s_barrier(); asm volatile("" ::: "memory");
        if (wc == 0) {
#pragma unroll
            for (int h = 0; h < 2; ++h) { const int rl = h * 64 + lane;
                float s1 = 0.f, s2 = 0.f;
#pragma unroll
                for (int w = 0; w < 4; ++w) { const PG8_LAS float* sp_ = stx + (((wr * 4 + w) * 128) + rl) * 2; s1 += sp_[0]; s2 += sp_[1]; }
                const size_t r = (size_t)u.pm * BM + (rl >> 6) * HALF + wr * 64 + (rl & 63);
                fx_add(sto + 2 * r, s1, 16777216.f); fx_add(sto + 2 * r + 1, s2, 1048576.f); } }
    }
};
template <bool F8> struct EpiMix {
    static constexpr bool PERM = true, AFTER_DRAIN = false, HAS_MID = true, WAIT_AFTER_EPI = false; static constexpr int MID_T = F8 ? 8 : 16;
    const bf16_t* Zg; bf16_t* O; int ldz, ldc; float ascale;
    static __device__ __forceinline__ float e_neg(float e) { return e; }
    __device__ __forceinline__ void mid(f32x4 (&acc)[2][2][4][2], const Unit& u, int wr, int wc, int fr, int fq, int seg) const {
        OPQ_V(fr); OPQ_V(fq);
        const int row0 = u.pm * BM + wr * 64 + fr, col0 = u.pn * BM + wc * 32 + 8 * fq;
#pragma unroll
        for (int ai = 0; ai < 2; ++ai) {
            u32x4 gx[4][2], gy[4][2];
#pragma unroll
            for (int m = 0; m < 4; ++m) { const bf16_t* zr = Zg + (size_t)(row0 + ai * HALF + m * 16) * ldz + col0 + seg * 4096;
#pragma unroll
                for (int bj = 0; bj < 2; ++bj) { gx[m][bj] = *(const u32x4*)(zr + bj * HALF); gy[m][bj] = *(const u32x4*)(zr + bj * HALF + 4096); } }
#pragma unroll
            for (int m = 0; m < 4; ++m)
#pragma unroll
                for (int bj = 0; bj < 2; ++bj)
#pragma unroll
                    for (int d = 0; d < 4; ++d) { const int n = d >> 1, j = (d & 1) * 2;
                        const float r0 = (1.f + e_neg(bf_lo(gy[m][bj][d]))) * __builtin_amdgcn_rcpf(1.f + e_neg(bf_lo(gx[m][bj][d])));
                        const float r1 = (1.f + e_neg(bf_hi(gy[m][bj][d]))) * __builtin_amdgcn_rcpf(1.f + e_neg(bf_hi(gx[m][bj][d])));
                        acc[ai][bj][m][n][j] *= r0; acc[ai][bj][m][n][j + 1] *= r1; }
            asm volatile("" ::: "memory"); }
    }
    __device__ __forceinline__ void operator()(const f32x4 (&acc)[2][2][4][2], const Unit& u, int wr, int wc, int fr, int fq) const {
        OPQ_V(fr); OPQ_V(fq);
        const int row0 = u.pm * BM + wr * 64 + fr, col0 = u.pn * BM + wc * 32 + 8 * fq;
#pragma unroll
        for (int ai = 0; ai < 2; ++ai) {
            u32x4 gcv[4][2];
#pragma unroll
            for (int m = 0; m < 4; ++m) { const bf16_t* zr = Zg + (size_t)(row0 + ai * HALF + m * 16) * ldz + col0 + 8192; gcv[m][0] = *(const u32x4*)(zr); gcv[m][1] = *(const u32x4*)(zr + HALF); }
#pragma unroll
            for (int m = 0; m < 4; ++m) { bf16_t* rowp = O + (size_t)(row0 + ai * HALF + m * 16) * ldc + col0;
#pragma unroll
                for (int bj = 0; bj < 2; ++bj) { const u32x4 gc = gcv[m][bj]; const f32x4 v0 = acc[ai][bj][m][0], v1 = acc[ai][bj][m][1]; float o[8];
                    o[0] = v0[0] * __builtin_amdgcn_rcpf(1.f + e_neg(bf_lo(gc[0]))); o[1] = v0[1] * __builtin_amdgcn_rcpf(1.f + e_neg(bf_hi(gc[0])));
                    o[2] = v0[2] * __builtin_amdgcn_rcpf(1.f + e_neg(bf_lo(gc[1]))); o[3] = v0[3] * __builtin_amdgcn_rcpf(1.f + e_neg(bf_hi(gc[1])));
                    o[4] = v1[0] * __builtin_amdgcn_rcpf(1.f + e_neg(bf_lo(gc[2]))); o[5] = v1[1] * __builtin_amdgcn_rcpf(1.f + e_neg(bf_hi(gc[2])));
                    o[6] = v1[2] * __builtin_amdgcn_rcpf(1.f + e_neg(bf_lo(gc[3]))); o[7] = v1[3] * __builtin_amdgcn_rcpf(1.f + e_neg(bf_hi(gc[3])));
                    if constexpr (F8) {
#pragma unroll
                        for (int e = 0; e < 8; ++e) o[e] *= ascale;
                        const int p0 = pk4_e4m3(o[0], o[1], o[2], o[3]), p1 = pk4_e4m3(o[4], o[5], o[6], o[7]);
                        typedef int v2i_t __attribute__((ext_vector_type(2))); *(v2i_t*)((unsigned char*)O + (size_t)(row0 + ai * HALF + m * 16) * ldc + col0 + bj * HALF) = (v2i_t){p0, p1};
                    } else {
                    u32x4 w; w.x = cvt_pk_bf16(o[0], o[1]); w.y = cvt_pk_bf16(o[2], o[3]); w.z = cvt_pk_bf16(o[4], o[5]); w.w = cvt_pk_bf16(o[6], o[7]);
                    *(u32x4*)(rowp + bj * HALF) = w; } } }
            asm volatile("" ::: "memory"); }
    }
};

typedef int v4i_t __attribute__((ext_vector_type(4)));
typedef int v8i_t __attribute__((ext_vector_type(8)));
typedef int v6i_t __attribute__((ext_vector_type(6)));
template <class Epi, class Sched, bool ALIGN_EPI = false, bool SP2 = false, bool FP8 = false, bool FP6 = false>
__device__ __forceinline__ void gemm_phase(PG8_LAS unsigned char* lds, const Gemm g, const Sched& S, const Epi& E, int wave) {
    int tid_ = wave * 64 + lane_id(); OPQ_V(tid_);
    const int tid = tid_, wid = __builtin_amdgcn_readfirstlane(tid >> 6), lane = tid & 63, wr = wid >> 2, wc = wid & 3, fr = lane & 15, fq = lane >> 4;
    int K_ = g.K; OPQ_S(K_); const int K = K_, nt = K / BK;
    unsigned voffA[2], voffB[2];
#pragma unroll
    for (int i = 0; i < 2; ++i) { int R, C; stage_rc(tid * 16 + i * 8192, R, C); const int Rb = Epi::PERM ? ((R & ~31) + perm32(R & 31)) : R;
        voffA[i] = (unsigned)(R * K + C) * 2u; voffB[i] = (unsigned)(Rb * K + C) * 2u; }
    const size_t kstep = (size_t)(BK * 2);
    const size_t hstep = (size_t)HALF * K * 2;
    const size_t tstep = 2 * hstep;
    const unsigned ldsw = (unsigned)wid * 1024u;
    const int aoff = lds_byte(wr * 64 + fr, fq * 8), boff = lds_byte(wc * 32 + fr, fq * 8);
#define PG8_SA(b, h) (((b) * 2 + (h)) * HTB)
#define PG8_SB(b, h) ((4 + (b) * 2 + (h)) * HTB)
#define PG8_STAGE(bufoff, gbase, voff) do { _Pragma("unroll") for (int _i = 0; _i < 2; ++_i) \
        __builtin_amdgcn_global_load_lds((const unsigned*)((const char*)(gbase) + (voff)[_i]), (PG8_LAS unsigned*)(lds + (bufoff) + ldsw + _i * 8192), 16, 0, 0); } while (0)
#define PG8_LDF(p) ([&](const PG8_LAS unsigned char* p_, int k_) -> bf16x8 { if constexpr (FP6) { if (k_ == 1) { typedef short s4_t __attribute__((ext_vector_type(4))); const s4_t h_ = *(const volatile PG8_LAS s4_t*)p_;   return __builtin_shufflevector(h_, h_, 0, 1, 2, 3, -1, -1, -1, -1); } } return *(const PG8_LAS bf16x8*)p_; })
#define PG8_LDA(dst, b, h) do { _Pragma("unroll") for (int m = 0; m < 4; ++m) _Pragma("unroll") for (int k = 0; k < 2; ++k) dst[m][k] = PG8_LDF(0)(lds + PG8_SA(b, h) + aoff + m * 2048 + k * 1024, k); } while (0)
#define PG8_LDB(dst, b, h) do { _Pragma("unroll") for (int n = 0; n < 2; ++n) _Pragma("unroll") for (int k = 0; k < 2; ++k) dst[n][k] = PG8_LDF(0)(lds + PG8_SB(b, h) + boff + n * 2048 + k * 1024, k); } while (0)
#define PG8_CAT(x) __builtin_shufflevector(__builtin_bit_cast(v4i_t, (x)[0]), __builtin_bit_cast(v4i_t, (x)[1]), 0, 1, 2, 3, 4, 5, 6, 7)
#define PG8_CAT6(x) __builtin_shufflevector(__builtin_bit_cast(v4i_t, (x)[0]), __builtin_bit_cast(v4i_t, (x)[1]), 0, 1, 2, 3, 4, 5)
#define PG8_MMA(ai, bj, At, Bt) do { __builtin_amdgcn_s_setprio(1); if constexpr (FP6) { v6i_t a6_[4], b6_[2]; _Pragma("unroll") for (int m = 0; m < 4; ++m) a6_[m] = PG8_CAT6(At[m]); _Pragma("unroll") for (int n = 0; n < 2; ++n) b6_[n] = PG8_CAT6(Bt[n]); \
        _Pragma("unroll") for (int m = 0; m < 4; ++m) _Pragma("unroll") for (int n = 0; n < 2; ++n) \
        asm volatile("v_mfma_f32_16x16x128_f8f6f4 %0, %1, %2, %0 cbsz:2 blgp:2" : "+v"(acc[ai][bj][m][n]) : "v"(b6_[n]), "v"(a6_[m])); } \
        else if constexpr (FP8) { _Pragma("unroll") for (int m = 0; m < 4; ++m) _Pragma("unroll") for (int n = 0; n < 2; ++n) \
        asm volatile("v_mfma_f32_16x16x128_f8f6f4 %0, %1, %2, %0" : "+v"(acc[ai][bj][m][n]) : "v"(PG8_CAT(Bt[n])), "v"(PG8_CAT(At[m]))); } \
        else { _Pragma("unroll") for (int m = 0; m < 4; ++m) _Pragma("unroll") for (int n = 0; n < 2; ++n) _Pragma("unroll") for (int k = 0; k < 2; ++k) \
        acc[ai][bj][m][n] = __builtin_amdgcn_mfma_f32_16x16x32_bf16(Bt[n][k], At[m][k], acc[ai][bj][m][n], 0, 0, 0); } __builtin_amdgcn_s_setprio(0); } while (0)
#define PG8_WAIT_V(n) asm volatile("s_waitcnt vmcnt(" #n ")" ::: "memory")
#define PG8_WAIT_L(n) asm volatile("s_waitcnt lgkmcnt(" #n ")" ::: "memory")
#define PG8_BAR __builtin_amdgcn_s_barrier()
#define PG8_SCHED __builtin_amdgcn_sched_barrier(0)
    Unit cur, nxt; int ui = 0;
    __builtin_amdgcn_s_waitcnt(0x0F70);
    if (!S.next(0, cur)) return;
    f32x4 acc[2][2][4][2];
#pragma unroll
    for (int a = 0; a < 2; ++a)
#pragma unroll
        for (int b = 0; b < 2; ++b)
#pragma unroll
            for (int m = 0; m < 4; ++m)
#pragma unroll
                for (int n = 0; n < 2; ++n) acc[a][b][m][n] = (f32x4){0.f, 0.f, 0.f, 0.f};
    bf16x8 At[4][2], B0[2][2], B1[2][2];
    const char* cA = (const char*)g.A + (size_t)cur.pm * tstep; const char* cB = (const char*)g.Bt + (size_t)cur.pn * tstep;
    S.a_ready(cur);
    if constexpr (SP2) {
        PG8_STAGE(PG8_SB(0, 0), cB, voffB); PG8_STAGE(PG8_SB(0, 1), cB + hstep, voffB); PG8_STAGE(PG8_SA(0, 0), cA, voffA); PG8_STAGE(PG8_SA(0, 1), cA + hstep, voffA);
        if (wr == 1) PG8_BAR;
        PG8_WAIT_V(2); PG8_BAR;
        PG8_STAGE(PG8_SB(1, 0), cB + kstep, voffB); PG8_STAGE(PG8_SA(1, 0), cA + kstep, voffA); PG8_STAGE(PG8_SB(1, 1), cB + hstep + kstep, voffB);
        PG8_WAIT_V(6); PG8_BAR;
    } else {
        PG8_STAGE(PG8_SB(0, 0), cB, voffB); PG8_STAGE(PG8_SA(0, 0), cA, voffA); PG8_STAGE(PG8_SB(0, 1), cB + hstep, voffB); PG8_STAGE(PG8_SA(0, 1), cA + hstep, voffA);
        if (wr == 1) PG8_BAR;
        PG8_WAIT_V(4); PG8_BAR;
        PG8_STAGE(PG8_SB(1, 0), cB + kstep, voffB); PG8_STAGE(PG8_SA(1, 0), cA + kstep, voffA); PG8_STAGE(PG8_SB(1, 1), cB + hstep + kstep, voffB);
        PG8_WAIT_V(6); PG8_BAR;
    }
    for (;;) {
        const bool has_next = S.next(ui + 1, nxt);
        const char* nA = has_next ? (const char*)g.A + (size_t)nxt.pm * tstep : cA; const char* nB = has_next ? (const char*)g.Bt + (size_t)nxt.pn * tstep : cB;
        for (int t = 0; t < nt; t += 2) {
            const bool last = (t == nt - 2);
            const char* a1 = cA + (size_t)(t + 1) * kstep;
            const char* a2 = last ? nA : cA + (size_t)(t + 2) * kstep; const char* b2 = last ? nB : cB + (size_t)(t + 2) * kstep;
            const char* a3 = a2 + kstep; const char* b3 = b2 + kstep;
            if (last && has_next) S.a_ready(nxt);
            if constexpr (Epi::HAS_MID) { if (t == Epi::MID_T || t == 2 * Epi::MID_T) E.mid(acc, cur, wr, wc, fr, fq, t / Epi::MID_T - 1); }
            if constexpr (SP2) {
            PG8_LDB(B0, 0, 0); PG8_LDB(B1, 0, 1); PG8_SCHED; PG8_LDA(At, 0, 0); PG8_STAGE(PG8_SA(1, 1), a1 + hstep, voffA);
            PG8_WAIT_V(8); PG8_WAIT_L(0); __builtin_amdgcn_s_setprio(1); PG8_BAR; PG8_MMA(0, 0, At, B0); PG8_MMA(0, 1, At, B1); PG8_BAR; PG8_SCHED;
            PG8_LDA(At, 0, 1); PG8_STAGE(PG8_SB(0, 0), b2, voffB); PG8_STAGE(PG8_SB(0, 1), b2 + hstep, voffB); PG8_STAGE(PG8_SA(0, 0), a2, voffA);
            PG8_WAIT_V(8); PG8_WAIT_L(0); __builtin_amdgcn_s_setprio(1); PG8_BAR; PG8_MMA(1, 0, At, B0); PG8_MMA(1, 1, At, B1); PG8_BAR; PG8_SCHED;
            PG8_LDB(B0, 1, 0); PG8_LDB(B1, 1, 1); PG8_SCHED; PG8_LDA(At, 1, 0); PG8_STAGE(PG8_SA(0, 1), a2 + hstep, voffA);
            PG8_WAIT_V(8); PG8_WAIT_L(0); __builtin_amdgcn_s_setprio(1); PG8_BAR; PG8_MMA(0, 0, At, B0); PG8_MMA(0, 1, At, B1); PG8_BAR; PG8_SCHED;
            PG8_LDA(At, 1, 1); PG8_STAGE(PG8_SB(1, 0), b3, voffB); PG8_STAGE(PG8_SB(1, 1), b3 + hstep, voffB); PG8_STAGE(PG8_SA(1, 0), a3, voffA);
            PG8_WAIT_V(8); PG8_WAIT_L(0); __builtin_amdgcn_s_setprio(1); PG8_BAR; PG8_MMA(1, 0, At, B0); PG8_MMA(1, 1, At, B1); PG8_BAR; PG8_SCHED;
            } else {
            PG8_LDB(B0, 0, 0); PG8_SCHED; PG8_LDA(At, 0, 0); PG8_STAGE(PG8_SA(1, 1), a1 + hstep, voffA);
            PG8_WAIT_L(8); PG8_BAR; PG8_WAIT_L(0); PG8_MMA(0, 0, At, B0); PG8_BAR; PG8_SCHED;
            PG8_LDB(B1, 0, 1); PG8_STAGE(PG8_SB(0, 0), b2, voffB);
            PG8_BAR; PG8_WAIT_L(0); PG8_MMA(0, 1, At, B1); PG8_BAR;
            PG8_LDA(At, 0, 1); PG8_STAGE(PG8_SA(0, 0), a2, voffA);
            PG8_BAR; PG8_WAIT_L(0); PG8_MMA(1, 0, At, B0); PG8_BAR; PG8_SCHED;
            PG8_STAGE(PG8_SB(0, 1), b2 + hstep, voffB);
            PG8_WAIT_V(6); PG8_BAR; PG8_MMA(1, 1, At, B1); PG8_BAR;
            PG8_LDB(B0, 1, 0); PG8_SCHED; PG8_LDA(At, 1, 0); PG8_STAGE(PG8_SA(0, 1), a2 + hstep, voffA);
            PG8_WAIT_L(8); PG8_BAR; PG8_WAIT_L(0); PG8_MMA(0, 0, At, B0); PG8_BAR; PG8_SCHED;
            PG8_LDB(B1, 1, 1); PG8_STAGE(PG8_SB(1, 0), b3, voffB);
            PG8_BAR; PG8_WAIT_L(0); PG8_MMA(0, 1, At, B1); PG8_BAR;
            PG8_LDA(At, 1, 1); PG8_STAGE(PG8_SA(1, 0), a3, voffA);
            PG8_BAR; PG8_WAIT_L(0); PG8_MMA(1, 0, At, B0); PG8_BAR; PG8_SCHED;
            PG8_STAGE(PG8_SB(1, 1), b3 + hstep, voffB);
            PG8_WAIT_V(6); PG8_BAR; PG8_MMA(1, 1, At, B1); PG8_BAR;
            }
        }
        if constexpr (ALIGN_EPI) { if (wr == 0) PG8_BAR; }
        E(acc, cur, wr, wc, fr, fq); S.done(cur);
        if constexpr (Epi::WAIT_AFTER_EPI) __builtin_amdgcn_s_waitcnt(0x0F70);
        if (!has_next) break;
#pragma unroll
        for (int a = 0; a < 2; ++a)
#pragma unroll
            for (int b = 0; b < 2; ++b)
#pragma unroll
                for (int m = 0; m < 4; ++m)
#pragma unroll
                    for (int n = 0; n < 2; ++n) acc[a][b][m][n] = (f32x4){0.f, 0.f, 0.f, 0.f};
        cur = nxt; cA = nA; cB = nB; ++ui;
        if constexpr (ALIGN_EPI) { if (wr == 1) PG8_BAR; }
    }
    PG8_WAIT_V(0);
    if constexpr (!ALIGN_EPI) { if (wr == 0) PG8_BAR; }
    PG8_BAR;
#undef PG8_SA
#undef PG8_SB
#undef PG8_STAGE
#undef PG8_LDA
#undef PG8_LDF
#undef PG8_LDB
#undef PG8_MMA
#undef PG8_CAT
#undef PG8_CAT6
#undef PG8_WAIT_V
#undef PG8_WAIT_L
#undef PG8_BAR
#undef PG8_SCHED
}

template <class Epi, class Sched, bool ALIGN_EPI>
__device__ __forceinline__ void gemm_phase_fp6d(PG8_LAS unsigned char* lds, const Gemm g, const Sched& S, const Epi& E, int wave) {
    int tid_ = wave * 64 + lane_id(); OPQ_V(tid_);
    const int tid = tid_, wid = __builtin_amdgcn_readfirstlane(tid >> 6), lane = tid & 63, wr = wid >> 2, wc = wid & 3, fr = lane & 15, fq = lane >> 4;
    int K_ = g.K; OPQ_S(K_); const int K = K_, nt = K / BK;
    const size_t tstep = (size_t)nt * 24576;
    constexpr int SLOT = 49152, BOFF = 24576, KT = 96, KTG = 24576;
    unsigned voffA[3], voffB[3];
#pragma unroll
    for (int i = 0; i < 3; ++i) { voffA[i] = (unsigned)(i * 512 + tid) * 16u; voffB[i] = voffA[i]; }
    const unsigned ldsw = (unsigned)wid * 1024u;
    const int aoff = (wr * 64 + fr) * KT + 24 * fq, boff = BOFF + (wc * 32 + fr) * KT + 24 * fq;
    typedef int v2i_t __attribute__((ext_vector_type(2)));
    typedef int v4a8_t __attribute__((ext_vector_type(4), aligned(8)));
#define F6_STAGE(slot, pa, pb) do { _Pragma("unroll") for (int _i = 0; _i < 3; ++_i) { \
        __builtin_amdgcn_global_load_lds((const unsigned*)((pa) + voffA[_i]), (PG8_LAS unsigned*)(lds + (slot) * SLOT + ldsw + _i * 8192), 16, 0, 0); \
        __builtin_amdgcn_global_load_lds((const unsigned*)((pb) + voffB[_i]), (PG8_LAS unsigned*)(lds + (slot) * SLOT + BOFF + ldsw + _i * 8192), 16, 0, 0); } } while (0)
#define F6_LD(dst, p) do { const PG8_LAS unsigned char* p_ = (p); const v2i_t a_ = *(const volatile PG8_LAS v2i_t*)p_, b_ = *(const volatile PG8_LAS v2i_t*)(p_ + 8), c_ = *(const volatile PG8_LAS v2i_t*)(p_ + 16); \
        dst = __builtin_shufflevector(__builtin_shufflevector(a_, b_, 0, 1, 2, 3), __builtin_shufflevector(c_, c_, 0, 1, -1, -1), 0, 1, 2, 3, 4, 5); } while (0)
#define F6_WAIT_V(n) asm volatile("s_waitcnt vmcnt(" #n ")" ::: "memory")
#define F6_WAIT_L0 asm volatile("s_waitcnt lgkmcnt(0)" ::: "memory")
#define F6_BAR __builtin_amdgcn_s_barrier()
    Unit cur, nxt; int ui = 0;
    __builtin_amdgcn_s_waitcnt(0x0F70);
    if (!S.next(0, cur)) return;
    f32x4 acc[2][2][4][2];
#pragma unroll
    for (int a = 0; a < 2; ++a)
#pragma unroll
        for (int b = 0; b < 2; ++b)
#pragma unroll
            for (int m = 0; m < 4; ++m)
#pragma unroll
                for (int n = 0; n < 2; ++n) acc[a][b][m][n] = (f32x4){0.f, 0.f, 0.f, 0.f};
    const char* cA = (const char*)g.A + (size_t)cur.pm * tstep; const char* cB = (const char*)g.Bt + (size_t)cur.pn * tstep;
    F6_STAGE(0, cA, cB); F6_STAGE(1, cA + KTG, cB + KTG);
    F6_WAIT_V(0); F6_BAR;
    if (wr == 1) F6_BAR;
    int sr = 0;
    for (;;) {
        const bool has_next = S.next(ui + 1, nxt);
        const char* nA = has_next ? (const char*)g.A + (size_t)nxt.pm * tstep : cA; const char* nB = has_next ? (const char*)g.Bt + (size_t)nxt.pn * tstep : cB;
#pragma unroll 1
        for (int t = 0; t < nt; ++t) {
            const int t2 = t + 2; const char* ta = t2 < nt ? cA + (size_t)t2 * KTG : nA + (size_t)(t2 - nt) * KTG; const char* tb = t2 < nt ? cB + (size_t)t2 * KTG : nB + (size_t)(t2 - nt) * KTG;
            int sw = sr + 2; if (sw >= 3) sw -= 3;
            F6_STAGE(sw, ta, tb);
            v6i_t A6[2][4], B6[2][2];
            const PG8_LAS unsigned char* sp = lds + sr * SLOT;
#pragma unroll
            for (int bj = 0; bj < 2; ++bj)
#pragma unroll
                for (int n = 0; n < 2; ++n) F6_LD(B6[bj][n], sp + boff + (bj * 128 + n * 16) * KT);
#pragma unroll
            for (int ai = 0; ai < 2; ++ai)
#pragma unroll
                for (int m = 0; m < 4; ++m) F6_LD(A6[ai][m], sp + aoff + (ai * 128 + m * 16) * KT);
            if (wr == 1) F6_WAIT_V(6);
            F6_WAIT_L0; F6_BAR;
            __builtin_amdgcn_s_setprio(1);
#pragma unroll
            for (int ai = 0; ai < 2; ++ai)
#pragma unroll
                for (int bj = 0; bj < 2; ++bj)
#pragma unroll
                    for (int m = 0; m < 4; ++m)
#pragma unroll
                        for (int n = 0; n < 2; ++n) asm volatile("v_mfma_f32_16x16x128_f8f6f4 %0, %1, %2, %0 cbsz:2 blgp:2" : "+v"(acc[ai][bj][m][n]) : "v"(B6[bj][n]), "v"(A6[ai][m]));
            __builtin_amdgcn_s_setprio(0);
            if (wr == 0) F6_WAIT_V(6);
            F6_BAR; __builtin_amdgcn_sched_barrier(0);
            sr = sr == 2 ? 0 : sr + 1;
        }
        if constexpr (ALIGN_EPI) { if (wr == 0) F6_BAR; }
        E(acc, cur, wr, wc, fr, fq); S.done(cur);
        if constexpr (Epi::WAIT_AFTER_EPI) __builtin_amdgcn_s_waitcnt(0x0F70);
        if (!has_next) break;
#pragma unroll
        for (int a = 0; a < 2; ++a)
#pragma unroll
            for (int b = 0; b < 2; ++b)
#pragma unroll
                for (int m = 0; m < 4; ++m)
#pragma unroll
                    for (int n = 0; n < 2; ++n) acc[a][b][m][n] = (f32x4){0.f, 0.f, 0.f, 0.f};
        cur = nxt; cA = nA; cB = nB; ++ui;
        if constexpr (ALIGN_EPI) { if (wr == 1) F6_BAR; }
    }
    F6_WAIT_V(0);
    if constexpr (!ALIGN_EPI) { if (wr == 0) F6_BAR; }
    F6_BAR;
#undef F6_STAGE
#undef F6_LD
#undef F6_WAIT_V
#undef F6_WAIT_L0
#undef F6_BAR
}
}

#ifndef PG8_SP2
#define PG8_SP2 true
#endif
#ifndef PG8_ALIGN
#define PG8_ALIGN true
#endif

constexpr int NWAVES = 8;
constexpr int BATCH = 4, SEQ = 2048, D = 4096, DEPTH = 2, M = BATCH * SEQ;
constexpr int DIN = 19736;
constexpr int NZ = 19712;
constexpr int NZP = 19968;
constexpr int GATE_PN = 77;
constexpr int DFF = 16384, NY = 3072;
constexpr int ZC_AQ = 0, ZC_AK = 1024, ZC_AV = 1152, ZC_MQ = 1280, ZC_MK = 1792, ZC_MV = 2304, ZC_MO = 3328, ZC_CQ = 4352, ZC_CK = 5376, ZC_CV = 6400, ZC_GA = 7424;
constexpr float LN_EPS = 1e-5f, DN_ALPHA = 1.41421356237309515f, LOG2E = 1.4426950408889634f;

constexpr size_t MiB = 1u << 20;
constexpr size_t WS_CTL = 0, CTL_ZERO_BYTES = 2 * MiB;
constexpr int NZB = 2560, NZ8 = 17408;
__host__ __device__ constexpr bool z_is_fp8(int n0) { return n0 < 1024 || (n0 >= 3328 && n0 < 19712); }
__host__ __device__ constexpr int z_row(int n0) { return n0 < 1024 ? n0 : n0 < 3328 ? n0 - 1024 : n0 < 19712 ? n0 - 2304 : n0 - 19712 + 2304; }
__host__ __device__ constexpr bool fp6_layer(int l) { return l >= 0; }
__host__ __device__ constexpr float w6_scale(int n0) { return n0 < 1024 ? 512.f : n0 < 4352 ? 128.f : n0 < 5376 ? 1024.f : n0 < 6400 ? 128.f : n0 < 7424 ? 256.f : 128.f; }
constexpr float W8_SCALE = 64.f;
constexpr size_t SZ_WIN = (size_t)NZB * D * 2, SZ_WIN8 = (size_t)NZ8 * D, SZ_WUP = (size_t)D * NY * 2, SZ_WO = (size_t)D * D * 2, SZ_WF = (size_t)DFF * D * 2;
constexpr size_t WS_WIN = 2 * MiB;
constexpr size_t WS_WIN8 = WS_WIN + 2 * SZ_WIN;
constexpr size_t WS_A8 = WS_WIN8 + 2 * SZ_WIN8;
constexpr size_t WS_WUP = WS_A8 + (size_t)M * D;
constexpr size_t WS_WO = WS_WUP + 2 * SZ_WUP;
constexpr size_t WS_WF1 = WS_WO + 2 * SZ_WO;
constexpr size_t WS_WF2 = WS_WF1 + 2 * SZ_WF;
constexpr size_t WS_XB = WS_WF2 + 2 * SZ_WF;
constexpr size_t WS_TA = WS_XB + (size_t)M * D * 2;
constexpr size_t WS_TB = WS_TA + (size_t)M * D * 2;
constexpr size_t WS_Z = WS_TB + (size_t)M * D * 2;
constexpr size_t WS_G = WS_Z + (size_t)M * NZ * 2;
constexpr size_t WS_SC = WS_G + 1 * MiB;
constexpr size_t WS_Y = WS_SC + 1 * MiB;
constexpr size_t WS_MIX = WS_Y + (size_t)M * NY * 2;
constexpr size_t WS_A6 = WS_MIX + (size_t)M * D * 2;
constexpr size_t WS_END = WS_A6 + (size_t)M * D;
static_assert(WS_WIN % 256 == 0 && WS_Z % 256 == 0 && WS_G % 256 == 0 && WS_Y % 256 == 0, "alignment");
constexpr int CW_TMO = 0, CW_BAR = 4096;
constexpr int CW_STAT = 16384, CW_CF1 = CW_STAT + 4 * M * 2 * 2, CW_CIN = CW_CF1 + 2 * 2 * DFF * 2, CW_ZERO = CW_CIN + 2 * NZP * 2, CW_END = CW_ZERO + NZP * 2;
constexpr float FX_S1 = 16777216.f, FX_S2 = 1048576.f, FX_C = 4294967296.f;
static_assert((size_t)CW_END * 4 <= CTL_ZERO_BYTES, "control region");

constexpr int RING_OFF = 0, RING_BYTES = 131072;
constexpr int SCR_BYTES = NWAVES * 64 * 65 * 4;
constexpr int LDSCTL_OFF = 147456, MISC_OFF = LDSCTL_OFF + 320;
constexpr int STX_OFF = 151552;
constexpr int LDS_BYTES = 159744;
static_assert(SCR_BYTES <= LDSCTL_OFF && MISC_OFF + 128 <= LDS_BYTES, "LDS map");

#define GAS __attribute__((address_space(1)))
#define LAS __attribute__((address_space(3)))
typedef unsigned short bf16;
typedef unsigned v4u __attribute__((ext_vector_type(4)));
typedef unsigned v2u __attribute__((ext_vector_type(2)));
typedef float f32x4 __attribute__((ext_vector_type(4)));
typedef GAS unsigned gu32;
#define RLX_AGENT __ATOMIC_RELAXED, __HIP_MEMORY_SCOPE_AGENT
#define LDS_WAIT() asm volatile("s_waitcnt lgkmcnt(0)" ::: "memory")
#define VM_WAIT() asm volatile("s_waitcnt vmcnt(0)" ::: "memory")
using pg8::cvt_pk_bf16; using pg8::bf_lo; using pg8::bf_hi;

#define XB_TMO      128
#define XB_XCNT(j)  (256  + 64 * (j))
#define XB_XSUB(j)  (1280 + 64 * (j))
#define XB_XGEN(j)  (2304 + 64 * (j))
#define XB_TOP      3328
#define XB_TOPGEN   3392
#define XCD_BAR_WORDS 3456
#define XB_SPIN_CAP (1u << 18)

__device__ __forceinline__ unsigned xb_ld(unsigned* p)              { return __hip_atomic_load(p, __ATOMIC_RELAXED, __HIP_MEMORY_SCOPE_AGENT); }
__device__ __forceinline__ unsigned xb_add(unsigned* p, unsigned v) { return __hip_atomic_fetch_add(p, v, __ATOMIC_RELAXED, __HIP_MEMORY_SCOPE_AGENT); }
__device__ __forceinline__ unsigned xb_xcc_id() { return (unsigned)__builtin_amdgcn_s_getreg((3 << 11) | 20) & 0xFu; }
#define XB_SPIN(cond, bar) do { unsigned _sp = 0; while (cond) { __builtin_amdgcn_s_sleep(1); \
    if ((++_sp & 255u) == 0u) { if (xb_ld(&(bar)[XB_TMO])) break; if (_sp > XB_SPIN_CAP) { atomicAdd(&(bar)[XB_TMO], 1u); break; } } } } while (0)

struct XcdBarrier { unsigned* bar; unsigned x; volatile LAS unsigned* st; int wave; };

__device__ __forceinline__ XcdBarrier xcd_barrier_post(unsigned* bar, volatile LAS unsigned* st) {
    XcdBarrier b; b.bar = bar; b.x = xb_xcc_id(); b.st = st; b.wave = 0;
    if (threadIdx.x == 0) (void)xb_add(&bar[XB_XCNT(b.x)], 1u);
    return b;
}
__device__ __forceinline__ void xcd_barrier_complete(unsigned* bar, unsigned x, unsigned& nloc, unsigned& nx) {
    const unsigned G = gridDim.x * gridDim.y * gridDim.z;
    unsigned sum, cnt, mine, sp = 0u;
    for (;;) {
        sum = 0u; cnt = 0u; mine = 0u;
#pragma unroll
        for (unsigned j = 0; j < 16; ++j) { const unsigned c = xb_ld(&bar[XB_XCNT(j)]); sum += c; cnt += (c > 0u) ? 1u : 0u; mine = (j == x) ? c : mine; }
        if (sum == G) break;
        __builtin_amdgcn_s_sleep(1);
        if ((++sp & 255u) == 0u) { if (xb_ld(&bar[XB_TMO])) break; if (sp > XB_SPIN_CAP) { atomicAdd(&bar[XB_TMO], 1u); break; } }
    }
    nloc = mine > 0u ? mine : 1u; nx = cnt > 0u ? cnt : 1u;
}
__device__ __forceinline__ void xcd_barrier(const XcdBarrier& b) {
    asm volatile("s_waitcnt vmcnt(0)" ::: "memory");
    __syncthreads();
    if (b.wave == 0 && lane_id() == 0) {
        unsigned* bar = b.bar; OPQ_S(bar);
        __builtin_amdgcn_s_waitcnt(0);
        unsigned nloc = b.st[0], nx = b.st[1];
        if (nloc == 0u) { xcd_barrier_complete(bar, b.x, nloc, nx); b.st[0] = nloc; b.st[1] = nx; }
        const unsigned old = xb_add(&bar[XB_XSUB(b.x)], 1u);
        const unsigned gen = old / nloc;
        if (old + 1u == (gen + 1u) * nloc) {
            __builtin_amdgcn_fence(__ATOMIC_RELEASE, "agent");
            asm volatile("s_waitcnt vmcnt(0)" ::: "memory");
            const unsigned og = xb_add(&bar[XB_TOP], 1u);
            const unsigned tg = og / nx;
            if (og + 1u == (tg + 1u) * nx) xb_add(&bar[XB_TOPGEN], 1u);
            else XB_SPIN(xb_ld(&bar[XB_TOPGEN]) == tg, bar);
            __builtin_amdgcn_fence(__ATOMIC_ACQUIRE, "agent");
            xb_add(&bar[XB_XGEN(b.x)], 1u);
            asm volatile("s_waitcnt vmcnt(0)" ::: "memory");
        } else {
            XB_SPIN(xb_ld(&bar[XB_XGEN(b.x)]) == gen, bar);
            __builtin_amdgcn_fence(__ATOMIC_ACQUIRE, "agent");
            asm volatile("s_waitcnt vmcnt(0)" ::: "memory");
        }
    }
    __syncthreads();
}

struct Frame {
    LAS unsigned char* lds;
    volatile LAS unsigned* MISC;
    gu32* ctl;
    int wave;
    int vcu, G;
};

__device__ __forceinline__ float lane_get(float v, int src_lane) { return __int_as_float(__builtin_amdgcn_ds_bpermute(src_lane << 2, __float_as_int(v))); }
__device__ __forceinline__ float wave_sum(float v, int lane) {
#pragma unroll
    for (int o = 1; o < 64; o <<= 1) v += lane_get(v, lane ^ o);
    return v;
}
__device__ __forceinline__ float wave_max(float v, int lane) {
#pragma unroll
    for (int o = 1; o < 64; o <<= 1) v = fmaxf(v, lane_get(v, lane ^ o));
    return v;
}

__device__ __forceinline__ float rbf(float x) { return bf_lo(cvt_pk_bf16(x, x)); }
__device__ __forceinline__ void tr_item(const float* __restrict__ W, int ldw, int k0, int srccol, bf16* __restrict__ WT, size_t ldt, int n0, int kdst, float scale, LAS float* scr, int lane, f32x4& a1, f32x4& a2, bool flush,
                                        const float* __restrict__ gk, const float* __restrict__ bk, pg8::fx64* c1, pg8::fx64* c2, unsigned char* __restrict__ WT8 = nullptr, bool fp6 = false, float wsc = W8_SCALE) {
    const int i = lane & 15, kr = lane >> 4;
    const float c1s = WT8 ? 1.f / wsc : 1.f;
    if (srccol >= 0) {
        f32x4 v[16];
#pragma unroll
        for (int r = 0; r < 16; ++r) v[r] = __builtin_nontemporal_load((const f32x4*)(W + (size_t)(k0 + 4 * r + kr) * ldw + srccol + 4 * i));
#pragma unroll
        for (int r = 0; r < 16; ++r) { LAS float* s = scr + (4 * r + kr) * 65 + 4 * i; float gs = scale, bs = 0.f;
            if (gk) { gs *= gk[k0 + 4 * r + kr]; bs = bk[k0 + 4 * r + kr] * scale; }
#pragma unroll
            for (int j = 0; j < 4; ++j) { const float w = WT8 ? (fp6 ? v_e2m3(v[r][j] * gs) : __builtin_amdgcn_cvt_f32_fp8(__builtin_amdgcn_cvt_pk_fp8_f32(__builtin_amdgcn_fmed3f(v[r][j] * gs, -448.f, 448.f), 0.f, 0, false), 0)) : rbf(v[r][j] * gs); s[j] = w; a1[j] += w; a2[j] += v[r][j] * bs; } }
    } else {
#pragma unroll
        for (int r = 0; r < 16; ++r) { LAS float* s = scr + (4 * r + kr) * 65 + 4 * i; float gs = scale, bs = 0.f;
            if (gk) { gs *= gk[k0 + 4 * r + kr]; bs = bk[k0 + 4 * r + kr] * scale; }
#pragma unroll
            for (int j = 0; j < 4; ++j) { const int cc = 4 * i + j; float val = 0.f;
                if (srccol == -2 && cc < 24) { const int sc = cc < 16 ? 3328 + cc : 7440 + (cc - 16); val = W[(size_t)(k0 + 4 * r + kr) * ldw + sc]; }
                const float w = rbf(val * gs); s[j] = w; a1[j] += w; a2[j] += val * bs; } }
    }
    if (gk && flush) {
#pragma unroll
        for (int j = 0; j < 4; ++j) { a1[j] += lane_get(a1[j], lane ^ 16); a2[j] += lane_get(a2[j], lane ^ 16); a1[j] += lane_get(a1[j], lane ^ 32); a2[j] += lane_get(a2[j], lane ^ 32); }
        if (kr == 0) {
#pragma unroll
            for (int j = 0; j < 4; ++j) { pg8::fx_add(c1 + n0 + 4 * i + j, a1[j] * c1s, FX_C); pg8::fx_add(c2 + n0 + 4 * i + j, a2[j] * c1s, FX_C); } }
        a1 = (f32x4){0.f, 0.f, 0.f, 0.f}; a2 = a1;
    }
    LDS_WAIT(); asm volatile("" ::: "memory");
    if (WT8) {
        const int c = lane & 3, nn = lane >> 2;
#pragma unroll
        for (int jj = 0; jj < 4; ++jj) { const int n = nn + 16 * jj; const LAS float* s = scr + (16 * c) * 65 + n; v4u o;
            if (fp6) { unsigned cd[16];
#pragma unroll
                for (int e = 0; e < 16; ++e) cd[e] = q_e2m3(s[e * 65]);
                store_e2m3_group(e2m3_ktile(WT8, n0 + n, k0 >> 7, true), ((k0 & 64) >> 4) + c, pack16_e2m3(cd)); continue; }
#pragma unroll
            for (int d = 0; d < 4; ++d) { int p = __builtin_amdgcn_cvt_pk_fp8_f32(s[(4 * d) * 65], s[(4 * d + 1) * 65], 0, false); p = __builtin_amdgcn_cvt_pk_fp8_f32(s[(4 * d + 2) * 65], s[(4 * d + 3) * 65], p, true); o[d] = (unsigned)p; }
            __builtin_nontemporal_store(o, (v4u*)(WT8 + (size_t)(n0 + n) * ldt + kdst + k0 + 16 * c)); }
        LDS_WAIT(); asm volatile("" ::: "memory");
        return;
    }
    const int c = lane & 7, nn = lane >> 3;
#pragma unroll
    for (int jj = 0; jj < 8; ++jj) { const int n = nn + 8 * jj; const LAS float* s = scr + (8 * c) * 65 + n;
        v4u o; o.x = cvt_pk_bf16(s[0 * 65], s[1 * 65]); o.y = cvt_pk_bf16(s[2 * 65], s[3 * 65]); o.z = cvt_pk_bf16(s[4 * 65], s[5 * 65]); o.w = cvt_pk_bf16(s[6 * 65], s[7 * 65]);
        __builtin_nontemporal_store(o, (v4u*)(WT + (size_t)(n0 + n) * ldt + kdst + k0 + 8 * c)); }
    LDS_WAIT(); asm volatile("" ::: "memory");
}

struct Args {
    const float* in[16]; float* out; unsigned char* ws; int ph_lo, ph_hi;
};
typedef const __attribute__((address_space(4))) Args* KArgs;

constexpr int I_IN = (D / 64) * (NZP / 64), I_UP = (1024 / 64) * (D / 64), I_O = (D / 64) * (D / 64), I_F1 = (D / 64) * (DFF / 64), I_F2 = (DFF / 64) * (D / 64);
constexpr int I_LAYER = I_IN + 3 * I_UP + I_O + I_F1 + I_F2;
__device__ __forceinline__ void conv_kn(int r, int NB, int& kb, int& nb) { const int kg = r / (8 * NB), q = r - kg * (8 * NB); nb = q >> 3; kb = 8 * kg + (q & 7); }
__device__ __forceinline__ void conv_item(KArgs A, int it, LAS float* scr, int lane, f32x4& a1, f32x4& a2, bool flush) {
    const int l = it / I_LAYER; int r = it - l * I_LAYER;
    if (r < I_IN) {
        constexpr int NB = NZP / 64; int kb, nb; conv_kn(r, NB, kb, nb); const int n0 = nb * 64;
        int srccol; float scale = 1.f;
        if (n0 < 3328) { srccol = n0; if (n0 < 1024) scale = 0.125f * LOG2E; else if (n0 >= ZC_MK && n0 < ZC_MV) scale = 0.125f; }
        else if (n0 < 7424) { srccol = n0 + 16; if (n0 >= ZC_CQ && n0 < ZC_CK) scale = 0.08838834764831845f * LOG2E; }
        else if (n0 < NZ) srccol = n0 + 24;
        else if (n0 == NZ) srccol = -2;
        else srccol = -1;
        pg8::fx64* cf = (pg8::fx64*)((unsigned*)(A->ws + WS_CTL) + CW_CIN);
        if (z_is_fp8(n0)) {
            const int nd = z_row(n0); const float wsc = w6_scale(n0);
            tr_item(A->in[1] + (size_t)l * D * DIN, DIN, kb * 64, srccol, nullptr, D, nd, 0, scale * wsc, scr, lane, a1, a2, flush,
                    l ? A->in[14] : nullptr, l ? A->in[15] : nullptr, cf + (n0 - nd), cf + NZP + (n0 - nd), A->ws + WS_WIN8 + l * SZ_WIN8, true, wsc);
        } else {
            const int nd = z_row(n0);
            tr_item(A->in[1] + (size_t)l * D * DIN, DIN, kb * 64, srccol, (bf16*)(A->ws + WS_WIN + l * SZ_WIN), D, nd, 0, scale, scr, lane, a1, a2, flush,
                    l ? A->in[14] : nullptr, l ? A->in[15] : nullptr, cf + (n0 - nd), cf + NZP + (n0 - nd));
        }
        return;
    }
    r -= I_IN;
    if (r < 3 * I_UP) { const int br = r / I_UP; r -= br * I_UP; constexpr int NB = D / 64; int kb, nb; conv_kn(r, NB, kb, nb);
        tr_item(A->in[6 + br] + (size_t)l * 1024 * D, D, kb * 64, nb * 64, nullptr, NY, nb * 64, br * 1024, W8_SCALE, scr, lane, a1, a2, flush, nullptr, nullptr, nullptr, nullptr, A->ws + WS_WUP + l * SZ_WUP);
        return; }
    r -= 3 * I_UP;
    if (r < I_O) { constexpr int NB = D / 64; int kb, nb; conv_kn(r, NB, kb, nb);
        tr_item(A->in[9] + (size_t)l * D * D, D, kb * 64, nb * 64, nullptr, D, nb * 64, 0, 128.f, scr, lane, a1, a2, flush, nullptr, nullptr, nullptr, nullptr, A->ws + WS_WO + l * SZ_WO);
        return; }
    r -= I_O;
    if (r < I_F1) { constexpr int NB = DFF / 64; int kb, nb; conv_kn(r, NB, kb, nb);
        pg8::fx64* cf = (pg8::fx64*)((unsigned*)(A->ws + WS_CTL) + CW_CF1) + l * 2 * DFF;
        tr_item(A->in[12] + (size_t)l * D * DFF, DFF, kb * 64, nb * 64, (bf16*)(A->ws + WS_WF1 + l * SZ_WF), D, nb * 64, 0, 1.f, scr, lane, a1, a2, flush, A->in[10] + l * D, A->in[11] + l * D, cf, cf + DFF);
        return; }
    r -= I_F1;
    { constexpr int NB = D / 64; int kb, nb; conv_kn(r, NB, kb, nb);
        tr_item(A->in[13] + (size_t)l * DFF * D, D, kb * 64, nb * 64, (bf16*)(A->ws + WS_WF2 + l * SZ_WF), DFF, nb * 64, 0, 1.f, scr, lane, a1, a2, flush, nullptr, nullptr, nullptr, nullptr); }
}
__device__ __forceinline__ void p0_prologue(Frame& F, KArgs A_) {
    KArgs A = A_; OPQ_S(A);
    int tid = F.wave * 64 + lane_id(); OPQ_V(tid); const int lane = tid & 63;
    LAS float* scr = (LAS float*)(F.lds) + F.wave * (64 * 65);
    const int gw = F.vcu * NWAVES + F.wave, NGW = F.G * NWAVES;
#if defined(MIX_NAIVE)
    { f32x4 a1 = (f32x4){0.f, 0.f, 0.f, 0.f}, a2 = a1; for (int it = gw; it < DEPTH * I_LAYER; it += NGW) conv_item(A, it, scr, lane, a1, a2, true); }
#else
    { f32x4 a1 = (f32x4){0.f, 0.f, 0.f, 0.f}, a2 = a1; for (int it = gw; it < I_IN; it += NGW) conv_item(A, it, scr, lane, a1, a2, true); }
#endif
    const f32x4* xs = (const f32x4*)A->in[0];
    {
        const size_t n16 = (size_t)M * D / 16, st = (size_t)F.G * 512; size_t i = (size_t)(F.vcu * 512 + tid);
        v4u* xb2 = (v4u*)(A->ws + WS_XB); v4u* x6 = (v4u*)(A->ws + WS_A6);
#define X_CHUNK(ci, q0, q1, q2, q3) do { const f32x4 q_[4] = {q0, q1, q2, q3}; v4u o0, o1, o6; unsigned cd[16]; \
            o0.x = cvt_pk_bf16(q_[0][0], q_[0][1]); o0.y = cvt_pk_bf16(q_[0][2], q_[0][3]); o0.z = cvt_pk_bf16(q_[1][0], q_[1][1]); o0.w = cvt_pk_bf16(q_[1][2], q_[1][3]); \
            o1.x = cvt_pk_bf16(q_[2][0], q_[2][1]); o1.y = cvt_pk_bf16(q_[2][2], q_[2][3]); o1.z = cvt_pk_bf16(q_[3][0], q_[3][1]); o1.w = cvt_pk_bf16(q_[3][2], q_[3][3]); \
                        _Pragma("unroll") for (int e_ = 0; e_ < 16; ++e_) cd[e_] = q_e2m3(q_[e_ >> 2][e_ & 3] * pg8::A6_SCALE); \
            o6 = pack16_e2m3(cd); \
            xb2[2 * (ci)] = o0; xb2[2 * (ci) + 1] = o1; store_e2m3_group(e2m3_ktile((unsigned char*)x6, (int)((ci) >> 8), (int)(((ci) >> 3) & 31), false), (int)((ci) & 7), o6); } while (0)
#pragma unroll 1
        for (; i + st < n16; i += 2 * st) {
            f32x4 v[2][4];
#pragma unroll
            for (int u = 0; u < 2; ++u)
#pragma unroll
                for (int q = 0; q < 4; ++q) v[u][q] = __builtin_nontemporal_load(xs + (i + u * st) * 4 + q);
#pragma unroll
            for (int u = 0; u < 2; ++u) X_CHUNK(i + u * st, v[u][0], v[u][1], v[u][2], v[u][3]);
        }
#pragma unroll 1
        for (; i < n16; i += st) { const f32x4 v0 = xs[i * 4], v1 = xs[i * 4 + 1], v2 = xs[i * 4 + 2], v3 = xs[i * 4 + 3]; X_CHUNK(i, v0, v1, v2, v3); }
#undef X_CHUNK
    }
}

__device__ __forceinline__ void lnout_phase(Frame& F, const bf16* __restrict__ T, const pg8::fx64* __restrict__ st, const float* __restrict__ g, const float* __restrict__ b, float* __restrict__ xo) {
    int lane = lane_id(); OPQ_V(lane); int gw = F.vcu * NWAVES + F.wave; OPQ_S(gw); const int NGW = F.G * NWAVES;
    for (int row = gw; row < M; row += NGW) {
        const float s1 = (float)st[2 * (size_t)row] * (1.f / FX_S1), s2 = (float)st[2 * (size_t)row + 1] * (1.f / FX_S2);
        const float mean = s1 * (1.f / D), rstd = __builtin_amdgcn_rsqf(fmaxf(s2 * (1.f / D) - mean * mean, 0.f) + LN_EPS), rm = rstd * mean;
        const v4u* tr = (const v4u*)(T + (size_t)row * D) + lane;
#pragma unroll 2
        for (int j = 0; j < 8; ++j) { const int c0 = 8 * (lane + 64 * j); const v4u w = tr[64 * j];
            const f32x4 g0 = *(const f32x4*)(g + c0), g1 = *(const f32x4*)(g + c0 + 4), b0 = *(const f32x4*)(b + c0), b1 = *(const f32x4*)(b + c0 + 4);
            *(f32x4*)(xo + (size_t)row * D + c0) = ((f32x4){bf_lo(w.x), bf_hi(w.x), bf_lo(w.y), bf_hi(w.y)} * rstd - rm) * g0 + b0;
            *(f32x4*)(xo + (size_t)row * D + c0 + 4) = ((f32x4){bf_lo(w.z), bf_hi(w.z), bf_lo(w.w), bf_hi(w.w)} * rstd - rm) * g1 + b1; }
    }
}

__device__ __forceinline__ float log_sigmoid(float x) { return fminf(x, 0.f) - log1pf(expf(-fabsf(x))); }
__device__ __forceinline__ void scan_phase(Frame& F, KArgs A_, int l) {
    KArgs A = A_; OPQ_S(A);
    int lane = lane_id(); OPQ_V(lane); int gw = F.vcu * NWAVES + F.wave; OPQ_S(gw); const int NGW = F.G * NWAVES;
    const float* G = (const float*)(A->ws + WS_G); float* SC = (float*)(A->ws + WS_SC);
    for (int it = gw; it < 64; it += NGW) {
        const int fox = it >> 5, bh = it & 31, b = bh >> 3, h = bh & 7;
        const float* fp = G + (size_t)((fox ? 16 : 8) + h) * M + b * SEQ + 32 * lane;
        const float bf = fox ? A->in[4][l * 8 + h] : A->in[3][l * 8 + h];
        float Fv[32]; float run = 0.f;
#pragma unroll
        for (int j = 0; j < 32; ++j) { run += log_sigmoid(fp[j] + bf); Fv[j] = run; }
        float inc = run;
#pragma unroll
        for (int o = 1; o < 64; o <<= 1) { const float t = lane_get(inc, lane - o); if (lane >= o) inc += t; }
        const float excl = inc - run;
        const size_t ob = (size_t)bh * SEQ + 32 * lane;
        if (fox) {
#pragma unroll
            for (int j = 0; j < 32; ++j) SC[ob + j] = -(Fv[j] + excl) * LOG2E;
        } else {
            const float* ip = G + (size_t)h * M + b * SEQ + 32 * lane; const float bi = A->in[2][l * 8 + h];
            float av[32]; float rm = -3.0e38f;
#pragma unroll
            for (int j = 0; j < 32; ++j) { Fv[j] += excl; av[j] = (ip[j] + bi) - Fv[j]; rm = fmaxf(rm, av[j]); }
            float incm = rm;
#pragma unroll
            for (int o = 1; o < 64; o <<= 1) { const float t = lane_get(incm, lane - o); if (lane >= o) incm = fmaxf(incm, t); }
            float pre = lane_get(incm, lane - 1); if (lane == 0) pre = 0.f; pre = fmaxf(pre, 0.f);
            float rr = pre;
#pragma unroll
            for (int j = 0; j < 32; ++j) { rr = fmaxf(rr, av[j]); SC[(size_t)32 * SEQ + ob + j] = av[j] * LOG2E; SC[(size_t)64 * SEQ + ob + j] = rr * LOG2E; SC[(size_t)96 * SEQ + ob + j] = expf(-(Fv[j] + rr)); }
        }
    }
}

#if defined(MIX_NAIVE)
__device__ __forceinline__ float dot8(const v4u a, const v4u b) {
    return bf_lo(a.x) * bf_lo(b.x) + bf_hi(a.x) * bf_hi(b.x) + bf_lo(a.y) * bf_lo(b.y) + bf_hi(a.y) * bf_hi(b.y) + bf_lo(a.z) * bf_lo(b.z) + bf_hi(a.z) * bf_hi(b.z) + bf_lo(a.w) * bf_lo(b.w) + bf_hi(a.w) * bf_hi(b.w);
}
__device__ __forceinline__ void mixers_naive(Frame& F, KArgs A_, int l) {
    KArgs A = A_; OPQ_S(A);
    int lane = lane_id(); OPQ_V(lane); int gw = F.vcu * NWAVES + F.wave; OPQ_S(gw); const int NGW = F.G * NWAVES;
    const bf16* Z = (const bf16*)(A->ws + WS_Z); bf16* Y = (bf16*)(A->ws + WS_Y); const float* SC = (const float*)(A->ws + WS_SC);
    LAS float* sbuf = (LAS float*)(F.lds) + F.wave * 2048;
    for (int it = gw; it < M * 16; it += NGW) {
        const int hq = it & 15, row = it >> 4, t = row & (SEQ - 1), kvh = hq >> 3;
        const v4u* qp = (const v4u*)(Z + (size_t)row * NZ + ZC_AQ + hq * 64);
        v4u qv[8];
#pragma unroll
        for (int c = 0; c < 8; ++c) qv[c] = qp[c];
        const float slope = exp2f(-0.5f * (float)(hq + 1)) * LOG2E, sink = A->in[5][l * 16 + hq] * LOG2E;
        float sc[2];
#pragma unroll
        for (int kk = 0; kk < 2; ++kk) { const int s = t - 127 + lane + 64 * kk; float d = -__builtin_inff();
            if (s >= 0) { const v4u* kp = (const v4u*)(Z + (size_t)(row - t + s) * NZ + ZC_AK + kvh * 64); float a = 0.f;
#pragma unroll
                for (int c = 0; c < 8; ++c) a += dot8(qv[c], kp[c]);
                d = a - slope * (float)(t - s); }
            sc[kk] = d; }
        const float mx = fmaxf(wave_max(fmaxf(sc[0], sc[1]), lane), sink);
        const float p0 = __builtin_amdgcn_exp2f(sc[0] - mx), p1 = __builtin_amdgcn_exp2f(sc[1] - mx);
        const float den = wave_sum(p0 + p1, lane) + __builtin_amdgcn_exp2f(sink - mx);
        float acc = 0.f;
#pragma unroll
        for (int kk = 0; kk < 2; ++kk) { const float pk = kk ? p1 : p0;
#pragma unroll 8
            for (int j = 0; j < 64; ++j) { const int s = t - 127 + j + 64 * kk; const float pj = lane_get(pk, j);
                if (s >= 0) acc += pj * __uint_as_float((unsigned)Z[(size_t)(row - t + s) * NZ + ZC_AV + kvh * 64 + lane] << 16); } }
        const float o = acc / den; const unsigned ob = cvt_pk_bf16(o, o);
        Y[(size_t)row * NY + hq * 64 + lane] = (bf16)(ob & 0xffffu);
    }
    for (int it = gw; it < 2 * 32 * SEQ; it += NGW) {
        const int fox = it >= 32 * SEQ; const int i2 = fox ? it - 32 * SEQ : it; const int bh = i2 & 31, t = i2 >> 5, b = bh >> 3, h = bh & 7;
        const size_t row = (size_t)b * SEQ + t; const int nkb = (t >> 6) + 1;
        const int qc = fox ? ZC_CQ + h * 128 : ZC_MQ + h * 64, kc = fox ? ZC_CK + h * 128 : ZC_MK + h * 64, vc = fox ? ZC_CV + h * 128 : ZC_MV + h * 128;
        const int nch = fox ? 16 : 8;
        const v4u* qp = (const v4u*)(Z + row * NZ + qc);
        v4u qv[16];
#pragma unroll
        for (int c = 0; c < 16; ++c) qv[c] = (c < nch) ? qp[c] : (v4u){0u, 0u, 0u, 0u};
        const float* bias = SC + (size_t)(fox ? 0 : 32) * SEQ + (size_t)bh * SEQ;
        const float RL = fox ? 0.f : SC[(size_t)64 * SEQ + (size_t)bh * SEQ + t];
        float mx = -__builtin_inff();
        for (int kb = 0; kb < nkb; ++kb) { const int s = kb * 64 + lane; float val = fox ? -__builtin_inff() : 0.f;
            if (s <= t) { const v4u* kp = (const v4u*)(Z + ((size_t)b * SEQ + s) * NZ + kc); float a = 0.f;
#pragma unroll
                for (int c = 0; c < 16; ++c) if (c < nch) a += dot8(qv[c], kp[c]);
                val = fox ? a + bias[s] : a * __builtin_amdgcn_exp2f(bias[s] - RL); }
            sbuf[s] = val; mx = fmaxf(mx, val); }
        float den;
        if (fox) { mx = wave_max(mx, lane); float sum = 0.f;
            for (int kb = 0; kb < nkb; ++kb) { const int s = kb * 64 + lane; const float p = __builtin_amdgcn_exp2f(sbuf[s] - mx); sbuf[s] = p; sum += p; }
            den = wave_sum(sum, lane);
        } else { float sum = 0.f;
            for (int kb = 0; kb < nkb; ++kb) sum += sbuf[kb * 64 + lane];
            den = wave_sum(sum, lane); den = fmaxf(fabsf(den), SC[(size_t)96 * SEQ + (size_t)bh * SEQ + t]); }
        LDS_WAIT(); asm volatile("" ::: "memory");
        float a0 = 0.f, a1 = 0.f;
        const bf16* vp = Z + ((size_t)b * SEQ) * NZ + vc + 2 * lane;
#pragma unroll 8
        for (int s = 0; s <= t; ++s) { const float p = sbuf[s]; const unsigned w = *(const unsigned*)(vp + (size_t)s * NZ); a0 += p * bf_lo(w); a1 += p * bf_hi(w); }
        a0 /= den; a1 /= den;
        if (!fox) { const unsigned w = *(const unsigned*)(Z + row * NZ + ZC_MO + h * 128 + 2 * lane);
            a0 *= 1.f / (1.f + expf(-bf_lo(w))); a1 *= 1.f / (1.f + expf(-bf_hi(w))); }
        *(unsigned*)(Y + row * NY + (fox ? 2048 : 1024) + h * 128 + 2 * lane) = cvt_pk_bf16(a0, a1);
        LDS_WAIT(); asm volatile("" ::: "memory");
    }
}


#endif
typedef float f32x16 __attribute__((ext_vector_type(16)));
typedef short s16x8 __attribute__((ext_vector_type(8)));
typedef short s16x4 __attribute__((ext_vector_type(4)));
constexpr int MX_KB0 = 0, MX_KB1 = 64 * 272, MX_VB0 = 2 * 64 * 272, MX_VB1 = MX_VB0 + 64 * 320, MX_QW = MX_VB1 + 64 * 320;
constexpr int MX_SC_A = 77824, MX_SC_R = MX_SC_A + 8192, MX_SC_E = MX_SC_R + 1024, MX_SC_W = MX_SC_E + 1024;
static_assert(MX_QW <= MX_SC_A && MX_SC_W + 64 <= RING_BYTES, "mixer LDS");
static_assert(16.f * 128.f == 2048.f && W8_SCALE == 64.f && NZB == 10 * 256 && NZ8 == 68 * 256, "EpiRes::ascale == 1 / (MIX8_SCALE * WO8_SCALE); EpiZ constants");
constexpr float Y8_SCALE = 8.f, MIX8_SCALE = 16.f, WO8_SCALE = 128.f;
constexpr float MX_THR = 8.f;
__device__ __forceinline__ float swap32_max(float v) { auto rr = __builtin_amdgcn_permlane32_swap(__float_as_uint(v), __float_as_uint(v), false, false); return fmaxf(__uint_as_float(rr[0]), __uint_as_float(rr[1])); }
__device__ __forceinline__ float swap32_add(float v) { auto rr = __builtin_amdgcn_permlane32_swap(__float_as_uint(v), __float_as_uint(v), false, false); return __uint_as_float(rr[0]) + __uint_as_float(rr[1]); }
__device__ __forceinline__ s16x4 vtr(const LAS unsigned char* p) { return __builtin_bit_cast(s16x4, __builtin_amdgcn_ds_read_tr16_b64_v4i16((LAS s16x4*)p)); }

template <int MODE>
__device__ __forceinline__ void mixer_scan(LAS unsigned char* lds, const float* __restrict__ G, float bias_f, float bias_i, int b, int h, int qb, int wave, int lane) {
    LAS float* key = (LAS float*)(lds + MX_SC_A); LAS float* rl = (LAS float*)(lds + MX_SC_R); LAS float* em = (LAS float*)(lds + MX_SC_E); LAS float* wt = (LAS float*)(lds + MX_SC_W);
    const int tid = wave * 64 + lane, s0 = 4 * tid, nk = 256 * (qb + 1); const bool act = s0 < nk;
    f32x4 fv = (f32x4){0.f, 0.f, 0.f, 0.f}, iv = fv;
    if (act) { fv = *(const f32x4*)(G + (size_t)((MODE == 2 ? 16 : 8) + h) * M + (size_t)b * SEQ + s0); if (MODE == 1) iv = *(const f32x4*)(G + (size_t)h * M + (size_t)b * SEQ + s0); }
    float Fv[4]; float run = 0.f;
#pragma unroll
    for (int j = 0; j < 4; ++j) { run += act ? log_sigmoid(fv[j] + bias_f) : 0.f; Fv[j] = run; }
    float inc = run;
#pragma unroll
    for (int o = 1; o < 64; o <<= 1) { const float t = lane_get(inc, lane - o); if (lane >= o) inc += t; }
    if (lane == 63) wt[wave] = inc;
    __syncthreads();
    float off = inc - run;
#pragma unroll
    for (int w = 0; w < NWAVES; ++w) if (w < wave) off += wt[w];
    if (MODE == 2) {
        if (act) *(LAS f32x4*)(key + s0) = (f32x4){-(Fv[0] + off) * LOG2E, -(Fv[1] + off) * LOG2E, -(Fv[2] + off) * LOG2E, -(Fv[3] + off) * LOG2E};
    } else {
        float av[4], mv[4]; float rm = -3.0e38f;
#pragma unroll
        for (int j = 0; j < 4; ++j) { Fv[j] += off; av[j] = act ? (iv[j] + bias_i) - Fv[j] : -3.0e38f; rm = fmaxf(rm, av[j]); mv[j] = rm; }
        float incm = rm;
#pragma unroll
        for (int o = 1; o < 64; o <<= 1) { const float t = lane_get(incm, lane - o); if (lane >= o) incm = fmaxf(incm, t); }
        if (lane == 63) wt[8 + wave] = incm;
        float pre = lane_get(incm, lane - 1); if (lane == 0) pre = 0.f;
        __syncthreads();
        pre = fmaxf(pre, 0.f);
#pragma unroll
        for (int w = 0; w < NWAVES; ++w) if (w < wave) pre = fmaxf(pre, wt[8 + w]);
        if (act) { *(LAS f32x4*)(key + s0) = (f32x4){av[0] * LOG2E, av[1] * LOG2E, av[2] * LOG2E, av[3] * LOG2E};
            const int r0 = s0 - 256 * qb;
            if (r0 >= 0) {
#pragma unroll
                for (int j = 0; j < 4; ++j) { const float R = fmaxf(pre, mv[j]); rl[r0 + j] = R * LOG2E; em[r0 + j] = expf(-(Fv[j] + R)); } } }
    }
    __syncthreads();
}

template <int MODE>
__device__ __forceinline__ void mixer_unit(LAS unsigned char* lds, const bf16* __restrict__ Z, bf16* __restrict__ Y, const float* __restrict__ G, float gb_f, float gb_i, float sink_l2, int b, int h, int qb, int wave, int lane) {
    constexpr int DQK = (MODE == 2) ? 128 : 64, DV = (MODE == 0) ? 64 : 128;
    constexpr int KP = DQK * 2 + 16, VP = (DV == 128) ? 320 : 192;
    constexpr int NKD = DQK / 16, NDB = DV / 32, KCH = DQK / 8, VCH = DV / 8, KLD = 64 * KCH / 512, VLD = 64 * VCH / 512;
    const int c = lane & 31, hi = lane >> 5, tid = wave * 64 + lane;
    const int qc = (MODE == 0) ? ZC_AQ + h * 64 : (MODE == 1) ? ZC_MQ + h * 64 : ZC_CQ + h * 128;
    const int kc = (MODE == 0) ? ZC_AK + (h >> 3) * 64 : (MODE == 1) ? ZC_MK + h * 64 : ZC_CK + h * 128;
    const int vc = (MODE == 0) ? ZC_AV + (h >> 3) * 64 : (MODE == 1) ? ZC_MV + h * 128 : ZC_CV + h * 128;
    const int yc = (MODE == 0) ? h * 64 : (MODE == 1) ? 1024 + h * 128 : 2048 + h * 128;
    const size_t rowb = (size_t)b * SEQ;
    const int q0w = 256 * qb + 32 * wave, qabs = q0w + c;
    const int j_lo = (MODE == 0) ? (qb > 0 ? 4 * qb - 2 : 0) : 0, j_hi = 4 * qb + 4;
    if (MODE != 0) mixer_scan<MODE>(lds, G, gb_f, gb_i, b, h, qb, wave, lane);
    const LAS float* bias = (const LAS float*)(lds + MX_SC_A);
    s16x8 qf[NKD];
    { const bf16* qp = Z + (rowb + qabs) * NZ + qc + 8 * hi;
#pragma unroll
      for (int kd = 0; kd < NKD; ++kd) qf[kd] = *(const s16x8*)(qp + 16 * kd); }
    f32x16 O[NDB];
#pragma unroll
    for (int db = 0; db < NDB; ++db)
#pragma unroll
        for (int r = 0; r < 16; ++r) O[db][r] = 0.f;
    float m = (MODE == 0) ? sink_l2 : -1.0e30f, lsum = (MODE == 0 && hi == 0) ? 1.f : 0.f;
    const float RL = (MODE == 1) ? ((const LAS float*)(lds + MX_SC_R))[32 * wave + c] : 0.f;
    const float slope = (MODE == 0) ? exp2f(-0.5f * (float)(h + 1)) * LOG2E : 0.f;
    v4u kr0[KLD], vr0[VLD], kr1[KLD], vr1[VLD];
#define MX_LOADG(KR, VR, j) do { _Pragma("unroll") for (int i_ = 0; i_ < KLD; ++i_) { const int cid = tid + 512 * i_, row = cid / KCH, cc = cid % KCH; KR[i_] = *(const v4u*)(Z + (rowb + 64 * (j) + row) * NZ + kc + 8 * cc); } \
        _Pragma("unroll") for (int i_ = 0; i_ < VLD; ++i_) { const int cid = tid + 512 * i_, row = cid / VCH, cc = cid % VCH; VR[i_] = *(const v4u*)(Z + (rowb + 64 * (j) + row) * NZ + vc + 8 * cc); } } while (0)
#define MX_STORE(KR, VR, bufi) do { _Pragma("unroll") for (int i_ = 0; i_ < KLD; ++i_) { const int cid = tid + 512 * i_, row = cid / KCH, cc = cid % KCH; *(LAS v4u*)(lds + ((bufi) ? MX_KB1 : MX_KB0) + row * KP + 16 * cc) = KR[i_]; } \
        _Pragma("unroll") for (int i_ = 0; i_ < VLD; ++i_) { const int cid = tid + 512 * i_, row = cid / VCH, cc = cid % VCH; *(LAS v4u*)(lds + ((bufi) ? MX_VB1 : MX_VB0) + row * VP + 16 * cc) = VR[i_]; } } while (0)
    MX_LOADG(kr1, vr1, j_lo); MX_STORE(kr1, vr1, 0);
    MX_LOADG(kr1, vr1, j_lo + 1);
    __syncthreads();
#pragma unroll
    for (int kd = 0; kd < NKD; ++kd) asm volatile("" : "+v"(qf[kd]));
    const int kbase = c * KP + 16 * hi;
    const int vbase = (4 * hi + ((lane & 15) >> 2)) * VP + (16 * ((lane >> 4) & 1) + 4 * (lane & 3)) * 2;
    auto step = [&](const int j, v4u (&ka)[KLD], v4u (&va)[VLD], v4u (&kb_)[KLD], v4u (&vb_)[VLD]) __attribute__((always_inline)) {
        const int cur = (j - j_lo) & 1;
        { const int jn = (j + 2 < j_hi) ? j + 2 : j_hi - 1; MX_LOADG(ka, va, jn); }
        bool active = 64 * j <= q0w + 31;
        if (MODE == 0) active = active && (64 * j + 63 >= q0w - 127);
        if (active) {
            const LAS unsigned char* Kb = lds + (cur ? MX_KB1 : MX_KB0) + kbase;
            const LAS unsigned char* Vb = lds + (cur ? MX_VB1 : MX_VB0) + vbase;
            f32x16 p[2];
#pragma unroll
            for (int kb = 0; kb < 2; ++kb) {
#pragma unroll
                for (int r = 0; r < 16; ++r) p[kb][r] = 0.f;
                { s16x8 kf[NKD];
#pragma unroll
                  for (int kd = 0; kd < NKD; ++kd) kf[kd] = *(const LAS s16x8*)(Kb + (32 * kb) * KP + 32 * kd);
                  __builtin_amdgcn_sched_barrier(0);
#pragma unroll
                  for (int kd = 0; kd < NKD; ++kd) p[kb] = __builtin_amdgcn_mfma_f32_32x32x16_bf16(kf[kd], qf[kd], p[kb], 0, 0, 0); }
            }
            const bool need_mask = (64 * j + 63 > q0w) || (MODE == 0 && 64 * j < q0w + 31 - 127);
            const int krel = qabs - 64 * j - 4 * hi;
            float den_t = 0.f;
            if (MODE == 1) {
#pragma unroll
                for (int kb = 0; kb < 2; ++kb) { const LAS float* bp = bias + 64 * j + 32 * kb + 4 * hi;
#pragma unroll
                    for (int g = 0; g < 4; ++g) { const f32x4 a4 = *(const LAS f32x4*)(bp + 8 * g);
#pragma unroll
                        for (int e = 0; e < 4; ++e) { const int r = 4 * g + e; float v = p[kb][r] * __builtin_amdgcn_exp2f(a4[e] - RL);
                            if (need_mask && (32 * kb + 8 * g + e) > krel) v = 0.f;
                            den_t += v; p[kb][r] = v; } } }
                lsum += den_t;
            } else {
                float tmax = -__builtin_inff();
#pragma unroll
                for (int kb = 0; kb < 2; ++kb) {
                    f32x4 b4[4];
                    if (MODE == 2) { const LAS float* bp = bias + 64 * j + 32 * kb + 4 * hi;
#pragma unroll
                        for (int g = 0; g < 4; ++g) b4[g] = *(const LAS f32x4*)(bp + 8 * g); }
#pragma unroll
                    for (int r = 0; r < 16; ++r) { const int ko = 32 * kb + 8 * (r >> 2) + (r & 3);
                        float s = p[kb][r];
                        if (MODE == 2) { s += b4[r >> 2][r & 3]; if (need_mask && ko > krel) s = -__builtin_inff(); }
                        else { const int dist = krel - ko; s -= slope * (float)dist; if (need_mask && (unsigned)dist >= 128u) s = -__builtin_inff(); }
                        p[kb][r] = s; tmax = fmaxf(tmax, s); }
                }
                tmax = swap32_max(tmax);
                if (!__all(tmax <= m + MX_THR)) {
                    const float mn = fmaxf(m, tmax), alpha = __builtin_amdgcn_exp2f(m - mn); m = mn; lsum *= alpha;
#pragma unroll
                    for (int db = 0; db < NDB; ++db)
#pragma unroll
                        for (int r = 0; r < 16; ++r) O[db][r] *= alpha;
                }
#pragma unroll
                for (int kb = 0; kb < 2; ++kb)
#pragma unroll
                    for (int r = 0; r < 16; ++r) { const float e = __builtin_amdgcn_exp2f(p[kb][r] - m); den_t += e; p[kb][r] = e; }
                lsum += den_t;
            }
            s16x8 pb[2][2];
#pragma unroll
            for (int kb = 0; kb < 2; ++kb)
#pragma unroll
                for (int s = 0; s < 2; ++s) { v4u w; w.x = cvt_pk_bf16(p[kb][8 * s + 0], p[kb][8 * s + 1]); w.y = cvt_pk_bf16(p[kb][8 * s + 2], p[kb][8 * s + 3]); w.z = cvt_pk_bf16(p[kb][8 * s + 4], p[kb][8 * s + 5]); w.w = cvt_pk_bf16(p[kb][8 * s + 6], p[kb][8 * s + 7]);
                    pb[kb][s] = __builtin_bit_cast(s16x8, w); }
#pragma unroll
            for (int db = 0; db < NDB; ++db) { s16x4 vlo[2][2], vhi[2][2];
#pragma unroll
                for (int kb = 0; kb < 2; ++kb)
#pragma unroll
                    for (int s = 0; s < 2; ++s) { vlo[kb][s] = vtr(Vb + (32 * kb + 16 * s) * VP + 64 * db); vhi[kb][s] = vtr(Vb + (32 * kb + 16 * s + 8) * VP + 64 * db); }
                __builtin_amdgcn_sched_barrier(0);
#pragma unroll
                for (int kb = 0; kb < 2; ++kb)
#pragma unroll
                    for (int s = 0; s < 2; ++s) { const s16x4 lo = vlo[kb][s], hh = vhi[kb][s];
                        const s16x8 a = (s16x8){lo[0], lo[1], lo[2], lo[3], hh[0], hh[1], hh[2], hh[3]};
                        O[db] = __builtin_amdgcn_mfma_f32_32x32x16_bf16(a, pb[kb][s], O[db], 0, 0, 0); } }
        }
        MX_STORE(kb_, vb_, cur ^ 1);
        __syncthreads();
    };
    for (int j = j_lo; j < j_hi; j += 2) { step(j, kr0, vr0, kr1, vr1); step(j + 1, kr1, vr1, kr0, vr0); }
#undef MX_LOADG
#undef MX_STORE
    const float tot = swap32_add(lsum);
    float inv;
    if (MODE == 1) inv = 1.f / fmaxf(fabsf(tot), ((const LAS float*)(lds + MX_SC_E))[32 * wave + c]);
    else inv = 1.f / tot;
    unsigned char* yp = (unsigned char*)Y + (rowb + qabs) * NY + yc + 4 * hi;
    const bf16* op = Z + (rowb + qabs) * NZ + ZC_MO + h * 128 + 4 * hi;
#pragma unroll
    for (int db = 0; db < NDB; ++db)
#pragma unroll
        for (int g = 0; g < 4; ++g) { float o0 = O[db][4 * g] * inv, o1 = O[db][4 * g + 1] * inv, o2 = O[db][4 * g + 2] * inv, o3 = O[db][4 * g + 3] * inv;
            if (MODE == 1) { const v2u gw = *(const v2u*)(op + 32 * db + 8 * g);
                o0 *= __builtin_amdgcn_rcpf(1.f + __builtin_amdgcn_exp2f(-LOG2E * bf_lo(gw.x))); o1 *= __builtin_amdgcn_rcpf(1.f + __builtin_amdgcn_exp2f(-LOG2E * bf_hi(gw.x)));
                o2 *= __builtin_amdgcn_rcpf(1.f + __builtin_amdgcn_exp2f(-LOG2E * bf_lo(gw.y))); o3 *= __builtin_amdgcn_rcpf(1.f + __builtin_amdgcn_exp2f(-LOG2E * bf_hi(gw.y))); }
            *(int*)(yp + 32 * db + 8 * g) = pk4_e4m3(o0 * Y8_SCALE, o1 * Y8_SCALE, o2 * Y8_SCALE, o3 * Y8_SCALE); }
}

constexpr int CW_QUEUE = 8192;
constexpr int MX_UNITS = 512 + 512;
constexpr int CV_CHUNK = 64;
__device__ __forceinline__ void mixers_mfma(Frame& F, KArgs A_, int l) {
    KArgs A = A_; OPQ_S(A);
    int lane = lane_id(); OPQ_V(lane);
    const bf16* Z = (const bf16*)(A->ws + WS_Z); bf16* Y = (bf16*)(A->ws + WS_Y); const float* G = (const float*)(A->ws + WS_G);
    unsigned* qhead = (unsigned*)(A->ws + WS_CTL) + CW_QUEUE + 64 * l;
    volatile LAS unsigned* qw = F.MISC + 16;
    LAS float* scr = (LAS float*)(F.lds) + F.wave * (64 * 65);
    const int cv_lo = l ? I_LAYER + I_IN : I_IN, cv_n = ((l ? 2 * I_LAYER : I_LAYER + I_IN) - cv_lo) / CV_CHUNK;
    static_assert(I_IN % CV_CHUNK == 0 && I_LAYER % CV_CHUNK == 0 && (I_LAYER - I_IN) / CV_CHUNK <= MX_UNITS, "queue layout");
    const unsigned long long order = 0x081923A4B5C67DEFull;
    unsigned pend = 0u;
    if (F.wave == 0 && lane == 0) qw[0] = __hip_atomic_fetch_add(qhead, 1u, __ATOMIC_RELAXED, __HIP_MEMORY_SCOPE_AGENT);
    __syncthreads();
    for (;;) {
        const unsigned e = qw[0];
        if (e >= (unsigned)(MX_UNITS + cv_n)) break;
        OPQ_V(lane);
        if (F.wave == 0 && lane == 0) pend = __hip_atomic_fetch_add(qhead, 1u, __ATOMIC_RELAXED, __HIP_MEMORY_SCOPE_AGENT);
        int u = -1, c = -1;
        if (e < 2u * (unsigned)cv_n) { if (e & 1u) c = (int)(e >> 1); else u = (int)(e >> 1); } else u = (int)e - cv_n;
        if (c >= 0) {
            { f32x4 a1 = (f32x4){0.f, 0.f, 0.f, 0.f}, a2 = a1;
#pragma unroll 1
            for (int k = 0; k < CV_CHUNK / NWAVES; ++k) conv_item(A, cv_lo + c * CV_CHUNK + F.wave * (CV_CHUNK / NWAVES) + k, scr, lane, a1, a2, k == CV_CHUNK / NWAVES - 1); }
        } else if (u < 512) {
            const unsigned code = (unsigned)(order >> (4 * (u >> 5))) & 15u; const int bh = u & 31, qb = code & 7;
            if (code & 8u) mixer_unit<2>(F.lds, Z, Y, G, A->in[4][l * 8 + (bh & 7)], 0.f, 0.f, bh >> 3, bh & 7, qb, F.wave, lane);
            else mixer_unit<1>(F.lds, Z, Y, G, A->in[3][l * 8 + (bh & 7)], A->in[2][l * 8 + (bh & 7)], 0.f, bh >> 3, bh & 7, qb, F.wave, lane);
        } else {
            const unsigned v = (unsigned)u - 512u; const int qb = 7 - (int)(v >> 6), bh = v & 63;
            mixer_unit<0>(F.lds, Z, Y, G, 0.f, 0.f, A->in[5][l * 16 + (bh & 15)] * LOG2E, bh >> 4, bh & 15, qb, F.wave, lane);
        }
        __syncthreads();
        if (F.wave == 0 && lane == 0) qw[0] = pend;
        __syncthreads();
    }
}

constexpr int PH_PER_LAYER = 7, N_PHASES = 2 + DEPTH * PH_PER_LAYER;
__global__ void __launch_bounds__(NWAVES * 64, 2) hyb_fwd(Args args) {
    extern __shared__ __attribute__((aligned(16))) unsigned char lds[];
    Frame F;
    F.lds = (LAS unsigned char*)lds;
    F.MISC = (volatile LAS unsigned*)(F.lds + MISC_OFF);
    F.wave = __builtin_amdgcn_readfirstlane((int)threadIdx.x >> 6);
    F.G = gridDim.x; { const int bx = blockIdx.x; F.vcu = (F.G % 8 == 0) ? (bx % 8) * (F.G / 8) + bx / 8 : bx; }
    const KArgs ka = (KArgs)__builtin_amdgcn_kernarg_segment_ptr();
    F.ctl = (gu32*)(args.ws + WS_CTL);
    for (int u = threadIdx.x; u < (LDS_BYTES - LDSCTL_OFF) / 4; u += NWAVES * 64) ((LAS unsigned*)(F.lds + LDSCTL_OFF))[u] = 0u;
    __syncthreads();
    const int lo = args.ph_lo, hi = args.ph_hi;
    XcdBarrier bar; bar.bar = (unsigned*)(F.ctl + CW_BAR); bar.x = 0; bar.st = F.MISC + 8; bar.wave = F.wave;
    if (hi - lo > 1) { bar = xcd_barrier_post((unsigned*)(F.ctl + CW_BAR), F.MISC + 8); bar.wave = F.wave; }
#define IN(k) (lo <= (k) && (k) < hi)
#define SEAM(k) do { if (IN(k) && IN((k) + 1)) xcd_barrier(bar); } while (0)
#define PHASE_PTRS KArgs A = ka; OPQ_S(A); unsigned char* ws = A->ws; int bx = blockIdx.x; OPQ_S(bx); unsigned* ctlw = (unsigned*)(ws + WS_CTL)
#define FXP(word_off) ((pg8::fx64*)(ctlw + (word_off)))
#define STATP(layer, which) FXP(CW_STAT + ((layer) * 2 + (which)) * 4 * M)

    if (IN(0)) { p0_prologue(F, ka); } SEAM(0);

    for (int l = 0; l < DEPTH; ++l) {
        const int pb = 1 + l * PH_PER_LAYER;
        if (IN(pb + 0)) {
            PHASE_PTRS;
            pg8::Gemm g{(const pg8::bf16_t*)(ws + (l ? WS_TB : WS_XB)), (const pg8::bf16_t*)(ws + WS_WIN + l * SZ_WIN), M, NZB, D}; pg8::StaticOrder S; S.init(M, NZB, F.G, bx);
            pg8::EpiZ<false> E{(pg8::bf16_t*)(ws + WS_Z), (float*)(ws + WS_G), NZ, M, pg8::LnFold{STATP(l ? l - 1 : 0, 1), l ? (const float*)(ws + WS_SC) : (const float*)(ctlw + CW_ZERO), l ? (const float*)(ws + WS_SC) + NZP : (const float*)(ctlw + CW_ZERO), l}};
            pg8::gemm_phase<pg8::EpiZ<false>, pg8::StaticOrder, PG8_ALIGN, PG8_SP2>(F.lds + RING_OFF, g, S, E, F.wave);
        }
        if (IN(pb + 0) && fp6_layer(l)) {
            PHASE_PTRS;
            pg8::Gemm g{(const pg8::bf16_t*)(ws + WS_A6), (const pg8::bf16_t*)(ws + WS_WIN8 + l * SZ_WIN8), M, NZ8, D / 2}; pg8::ExtraOrder S; S.init(M, NZ8, F.G, bx);
            if (F.G == 256) { S.n_full = 7; S.n_extra = 2; S.c_min = 64; } else { S.n_full = (M / 256) * (NZ8 / 256) / F.G + 1; S.n_extra = 0; S.c_min = 0; }
            if (l == 0) { pg8::EpiZ<true, 0, 1> E{(pg8::bf16_t*)(ws + WS_Z), (float*)(ws + WS_G), NZ, M, pg8::LnFold{STATP(0, 1), (const float*)(ctlw + CW_ZERO), (const float*)(ctlw + CW_ZERO), 0}};
                pg8::gemm_phase_fp6d<pg8::EpiZ<true, 0, 1>, pg8::ExtraOrder, PG8_ALIGN>(F.lds + RING_OFF, g, S, E, F.wave); }
            else { pg8::EpiZ<true, 0, 2> E{(pg8::bf16_t*)(ws + WS_Z), (float*)(ws + WS_G), NZ, M, pg8::LnFold{STATP(l - 1, 1), (const float*)(ws + WS_SC), (const float*)(ws + WS_SC) + NZP, 1}};
                pg8::gemm_phase_fp6d<pg8::EpiZ<true, 0, 2>, pg8::ExtraOrder, PG8_ALIGN>(F.lds + RING_OFF, g, S, E, F.wave); }
        }
        if (IN(pb + 0) && !fp6_layer(l)) {
            PHASE_PTRS;
            pg8::Gemm g{(const pg8::bf16_t*)(ws + WS_A8), (const pg8::bf16_t*)(ws + WS_WIN8 + l * SZ_WIN8), M, NZ8, D / 2}; pg8::ExtraOrder S; S.init(M, NZ8, F.G, bx);
            if (F.G == 256) { S.n_full = 7; S.n_extra = 2; S.c_min = 64; } else { S.n_full = (M / 256) * (NZ8 / 256) / F.G + 1; S.n_extra = 0; S.c_min = 0; }
            pg8::EpiZ<true> E{(pg8::bf16_t*)(ws + WS_Z), (float*)(ws + WS_G), NZ, M, pg8::LnFold{STATP(l ? l - 1 : 0, 1), l ? (const float*)(ws + WS_SC) : (const float*)(ctlw + CW_ZERO), l ? (const float*)(ws + WS_SC) + NZP : (const float*)(ctlw + CW_ZERO), l}};
            pg8::gemm_phase<pg8::EpiZ<true>, pg8::ExtraOrder, PG8_ALIGN, PG8_SP2, true>(F.lds + RING_OFF, g, S, E, F.wave);
        }
        SEAM(pb + 0);
#if defined(MIX_NAIVE)
        if (IN(pb + 1)) { scan_phase(F, ka, l); }
        SEAM(pb + 1);
#endif
#if defined(MIX_NAIVE)
        if (IN(pb + 2)) { mixers_naive(F, ka, l); }
#else
        if (IN(pb + 2)) { mixers_mfma(F, ka, l); }
#endif
        SEAM(pb + 2);
        if (IN(pb + 3)) {
            PHASE_PTRS;
            {
                float* cf = (float*)(ws + WS_SC); int tl_ = F.wave * 64 + lane_id(); OPQ_V(tl_); const int t0 = bx * 512 + tl_, nt_ = F.G * 512;
                if (l == 0) for (int i = t0; i < 2 * NZP; i += nt_) cf[i] = (float)FXP(CW_CIN)[i] * (1.f / FX_C);
                for (int i = t0; i < 2 * DFF; i += nt_) cf[2 * NZP + l * 2 * DFF + i] = (float)(FXP(CW_CF1) + l * 2 * DFF)[i] * (1.f / FX_C);
            }
            pg8::Gemm g{(const pg8::bf16_t*)(ws + WS_Y), (const pg8::bf16_t*)(ws + WS_WUP + l * SZ_WUP), M, D, NY / 2}; pg8::StaticOrder S; S.init(M, D, F.G, bx);
            pg8::EpiMix<true> E{(const pg8::bf16_t*)(ws + WS_Z) + ZC_GA, (pg8::bf16_t*)(ws + WS_MIX), NZ, D, MIX8_SCALE / (Y8_SCALE * W8_SCALE)};
            pg8::gemm_phase<pg8::EpiMix<true>, pg8::StaticOrder, PG8_ALIGN, PG8_SP2, true>(F.lds + RING_OFF, g, S, E, F.wave);
        }
        SEAM(pb + 3);
        if (IN(pb + 4)) {
            PHASE_PTRS;
            pg8::Gemm g{(const pg8::bf16_t*)(ws + WS_MIX), (const pg8::bf16_t*)(ws + WS_WO + l * SZ_WO), M, D, D / 2}; pg8::StaticOrder S; S.init(M, D, F.G, bx);
            if (l == 0) { pg8::EpiRes<0, true> E{A->in[0], nullptr, nullptr, A->in[14], A->in[15], (pg8::bf16_t*)(ws + WS_TA), STATP(l, 0), nullptr, nullptr, (LAS float*)(F.lds + STX_OFF), D};
                pg8::gemm_phase<pg8::EpiRes<0, true>, pg8::StaticOrder, PG8_ALIGN, PG8_SP2, true>(F.lds + RING_OFF, g, S, E, F.wave); }
            else { pg8::EpiRes<1, true> E{nullptr, (const pg8::bf16_t*)(ws + WS_TB), STATP(l - 1, 1), A->in[14] + (l - 1) * D, A->in[15] + (l - 1) * D, (pg8::bf16_t*)(ws + WS_TA), STATP(l, 0), nullptr, nullptr, (LAS float*)(F.lds + STX_OFF), D};
                pg8::gemm_phase<pg8::EpiRes<1, true>, pg8::StaticOrder, PG8_ALIGN, PG8_SP2, true>(F.lds + RING_OFF, g, S, E, F.wave); }
        }
        SEAM(pb + 4);
        if (IN(pb + 5)) {
            PHASE_PTRS;
            pg8::Gemm g{(const pg8::bf16_t*)(ws + WS_TA), (const pg8::bf16_t*)(ws + WS_WF1 + l * SZ_WF), M, DFF, D}; pg8::StaticOrder S; S.init(M, DFF, F.G, bx);
            pg8::EpiRelu2 E{(pg8::bf16_t*)(ws + WS_Z), DFF, pg8::LnFold{STATP(l, 0), (const float*)(ws + WS_SC) + 2 * NZP + l * 2 * DFF, (const float*)(ws + WS_SC) + 2 * NZP + l * 2 * DFF + DFF, 1}};
            pg8::gemm_phase<pg8::EpiRelu2, pg8::StaticOrder, PG8_ALIGN, PG8_SP2>(F.lds + RING_OFF, g, S, E, F.wave);
        }
        SEAM(pb + 5);
        if (IN(pb + 6)) {
            PHASE_PTRS;
            pg8::Gemm g{(const pg8::bf16_t*)(ws + WS_Z), (const pg8::bf16_t*)(ws + WS_WF2 + l * SZ_WF), M, D, DFF}; pg8::StaticOrder S; S.init(M, D, F.G, bx);
            pg8::EpiRes<1, false> E{nullptr, (const pg8::bf16_t*)(ws + WS_TA), STATP(l, 0), A->in[10] + l * D, A->in[11] + l * D,
                             (pg8::bf16_t*)(ws + WS_TB), STATP(l, 1), nullptr, (l + 1 < DEPTH) ? ws + WS_A6 : nullptr, (LAS float*)(F.lds + STX_OFF), D};
            pg8::gemm_phase<pg8::EpiRes<1, false>, pg8::StaticOrder, PG8_ALIGN, PG8_SP2>(F.lds + RING_OFF, g, S, E, F.wave);
        }
        SEAM(pb + 6);
    }
    if (IN(N_PHASES - 1)) { PHASE_PTRS; (void)bx; lnout_phase(F, (const bf16*)(ws + WS_TB), STATP(DEPTH - 1, 1), A->in[14] + (DEPTH - 1) * D, A->in[15] + (DEPTH - 1) * D, A->out); }
#undef IN
#undef SEAM
#undef PHASE_PTRS
#undef FXP
#undef STATP
}

extern "C" void kernel_launch(void* const* d_in, const int* in_sizes, int n_in, void* d_out, int out_size, void* d_ws, size_t ws_size, hipStream_t stream) {
    static int grid = 0;
    if (grid == 0) {
        if (n_in != 16 || in_sizes[0] != M * D || out_size != M * D || ws_size < WS_END) { fprintf(stderr, "kernel_launch: unexpected shapes (n_in %d, in0 %d, out %d, ws %zu < %zu)\n", n_in, n_in > 0 ? in_sizes[0] : -1, out_size, ws_size, (size_t)WS_END); grid = -1; return; }
        int dev = 0, cus = 0, per_cu = 0;
        if (hipGetDevice(&dev) != hipSuccess || hipDeviceGetAttribute(&cus, hipDeviceAttributeMultiprocessorCount, dev) != hipSuccess) { grid = -1; return; }
        if (hipFuncSetAttribute((const void*)hyb_fwd, hipFuncAttributeMaxDynamicSharedMemorySize, LDS_BYTES) != hipSuccess) { fprintf(stderr, "kernel_launch: hipFuncSetAttribute failed\n"); grid = -1; return; }
        if (hipOccupancyMaxActiveBlocksPerMultiprocessor(&per_cu, (const void*)hyb_fwd, NWAVES * 64, LDS_BYTES) != hipSuccess || per_cu < 1) { fprintf(stderr, "kernel_launch: occupancy query says %d blocks per CU\n", per_cu); (void)hipGetLastError(); grid = -1; return; }
        grid = cus;
    }
    if (grid < 0) return;
    (void)hipMemsetAsync((char*)d_ws + WS_CTL, 0, CTL_ZERO_BYTES, stream);
    Args a{};
    for (int i = 0; i < 16; ++i) a.in[i] = (const float*)d_in[i];
    a.out = (float*)d_out; a.ws = (unsigned char*)d_ws;
#if MK_N_LAUNCHES == 1
    a.ph_lo = 0; a.ph_hi = N_PHASES;
    hipLaunchKernelGGL(hyb_fwd, dim3(grid), dim3(NWAVES * 64), LDS_BYTES, stream, a);
#else
    for (int p = 0; p < N_PHASES; ++p) { a.ph_lo = p; a.ph_hi = p + 1; hipLaunchKernelGGL(hyb_fwd, dim3(grid), dim3(NWAVES * 64), LDS_BYTES, stream, a); }
#endif
}
```
